# Optimizing an MI355X kernel written in HIP

```python
import jax, jax.numpy as jnp
from jax import lax
import numpy as np

D_MODEL = 1024
BATCH = 2
SEQ = 8192
DEPTH = 4
DEC_BATCH = 128
DEC_SEQ = 1
PAST_LEN = 8192
PAGE_SIZE = 128

N_A_LAYERS = DEPTH // 2
N_B_LAYERS = DEPTH - N_A_LAYERS
MIX_WIDTH = D_MODEL
XATTN_HEADS = 4
XATTN_WIDTH = MIX_WIDTH // 4
XATTN_HEAD_DIM = XATTN_WIDTH // XATTN_HEADS
N_MEM = 256
HGRN_WIDTH = MIX_WIDTH - XATTN_WIDTH
HGRN_HEAD_DIM = 128
HGRN_HEADS = HGRN_WIDTH // HGRN_HEAD_DIM
HGRN_CHUNK = 64
SWA_HEAD_DIM = 64
SWA_WIDTH = MIX_WIDTH - XATTN_WIDTH
SWA_HEADS = SWA_WIDTH // SWA_HEAD_DIM
SWA_KV_HEADS = 4
SWA_GROUP = SWA_HEADS // SWA_KV_HEADS
SWA_KV_WIDTH = SWA_KV_HEADS * SWA_HEAD_DIM
WINDOW = 128
ROPE_THETA = 10000.0
D_FF = 4 * D_MODEL
EPS = 1e-6

kernel_name = 'yoco_hgrn2_swa_sink_memxattn_step'


def rms_norm(x, gain):
    xf = x.astype(jnp.float32)
    y = xf * lax.rsqrt(jnp.mean(xf * xf, axis=-1, keepdims=True) + EPS)
    return (y * gain.astype(jnp.float32)).astype(x.dtype)


def rope(x, pos):
    half = x.shape[-1] // 2
    inv = ROPE_THETA ** (-jnp.arange(half, dtype=jnp.float32) / half)
    ang = pos.astype(jnp.float32)[:, None] * inv[None, :]
    cos = jnp.cos(ang)[None, :, None, :]
    sin = jnp.sin(ang)[None, :, None, :]
    xf = x.astype(jnp.float32)
    x1, x2 = xf[..., :half], xf[..., half:]
    return jnp.concatenate([x1 * cos - x2 * sin, x2 * cos + x1 * sin], axis=-1).astype(x.dtype)


def hgrn2_scan(q, k, v, log_f, s0):
    B, L, H, _ = q.shape
    C = min(HGRN_CHUNK, L)
    n = -(-L // C)
    pad = n * C - L

    def prep(a):
        a = jnp.pad(a.astype(jnp.float32), ((0, 0), (0, pad), (0, 0), (0, 0)))
        return a.reshape(B, n, C, H, a.shape[-1]).transpose(1, 0, 3, 2, 4)

    qc, kc, vc, gc = prep(q), prep(k), prep(v), prep(log_f)
    causal = jnp.tril(jnp.ones((C, C), dtype=bool))[:, :, None]

    def step(S, inp):
        qi, ki, vi, gi = inp
        b = jnp.cumsum(gi, axis=2)
        o_inter = jnp.einsum('bhtk,bhkv->bhtv', qi * jnp.exp(b), S)
        diff = b[:, :, :, None, :] - b[:, :, None, :, :]
        decay = jnp.exp(jnp.where(causal, diff, -jnp.inf))
        scores = jnp.einsum('bhtk,bhsk,bhtsk->bhts', qi, ki, decay)
        o = o_inter + jnp.einsum('bhts,bhsv->bhtv', scores, vi)
        b_last = b[:, :, -1:, :]
        S_new = jnp.exp(b_last[:, :, 0, :])[..., None] * S + jnp.einsum(
            'bhsk,bhsv->bhkv', ki * jnp.exp(b_last - b), vi)
        return S_new, o

    S_fin, o = lax.scan(step, s0.astype(jnp.float32), (qc, kc, vc, gc))
    o = o.transpose(1, 0, 3, 2, 4).reshape(B, n * C, H, -1)[:, :L]
    return o, S_fin.astype(s0.dtype)


def hgrn2_mix(proj, lb, g_gain, s0):
    B, L, _ = proj.shape
    q, f_logit, i_in, g = jnp.split(proj, 4, axis=-1)
    shp = (B, L, HGRN_HEADS, HGRN_HEAD_DIM)
    q = jax.nn.silu(q).reshape(shp)
    z = f_logit.astype(jnp.float32).reshape(shp)
    lbh = lb.astype(jnp.float32).reshape(HGRN_HEADS, HGRN_HEAD_DIM)
    log_f = jnp.log(lbh + (1.0 - lbh) * jax.nn.sigmoid(z))
    k = (1.0 - lbh) * jax.nn.sigmoid(-z)
    o, S = hgrn2_scan(q, k, i_in.reshape(shp), log_f, s0)
    o = rms_norm(o, g_gain.reshape(HGRN_HEADS, HGRN_HEAD_DIM)).reshape(B, L, HGRN_WIDTH)
    return (o * jax.nn.silu(g.astype(jnp.float32))).astype(proj.dtype), S


def swa_attend(q, k_ext, v_ext, sinks, base):
    B, L, H, d = q.shape
    QB = min(WINDOW, L)
    n = -(-L // QB)
    pad = n * QB - L
    padw = ((0, 0), (0, pad), (0, 0), (0, 0))
    q = jnp.pad(q, padw)
    k_ext = jnp.pad(k_ext, padw)
    v_ext = jnp.pad(v_ext, padw)
    kidx = jnp.arange(n)[:, None] * QB + jnp.arange(WINDOW + QB)[None, :]
    kb = k_ext[:, kidx]
    vb = v_ext[:, kidx]
    qb = q.reshape(B, n, QB, SWA_KV_HEADS, SWA_GROUP, d)
    qpos = base + jnp.arange(n * QB).reshape(n, QB)
    kpos = base - WINDOW + kidx
    rel = qpos[:, :, None] - kpos[:, None, :]
    mask = (rel >= 0) & (rel < WINDOW) & (kpos[:, None, :] >= 0)
    s = jnp.einsum('bnqhgd,bnkhd->bnhgqk', qb, kb,
                   preferred_element_type=jnp.float32) * (d ** -0.5)
    s = jnp.where(mask[None, :, None, None], s, -jnp.inf)
    sink = sinks.astype(jnp.float32).reshape(SWA_KV_HEADS, SWA_GROUP)[None, None, :, :, None, None]
    m = jnp.maximum(jnp.max(s, axis=-1, keepdims=True), sink)
    p = jnp.exp(s - m)
    den = jnp.sum(p, axis=-1, keepdims=True) + jnp.exp(sink - m)
    o = jnp.einsum('bnhgqk,bnkhd->bnqhgd', (p / den).astype(vb.dtype), vb)
    return o.reshape(B, n * QB, H, d)[:, :L]


def mem_attend(q, mk, mv):
    s = jnp.einsum('blhd,bmhd->bhlm', q, mk, preferred_element_type=jnp.float32) * (q.shape[-1] ** -0.5)
    p = jax.nn.softmax(s, axis=-1).astype(mv.dtype)
    return jnp.einsum('bhlm,bmhd->blhd', p, mv)


def lower_bounds(lb_logits):
    c = jnp.cumsum(jax.nn.softmax(lb_logits.astype(jnp.float32), axis=0), axis=0)
    return c - c[0:1]


def trunk(x, base, mem_k, mem_v, hgrn_s0, swa_k_past, swa_v_past,
          w_in_a, lb_logits, hgrn_norm, w_in_b, sinks, kv_norm, w_kv,
          w_out, norm_pre_mix, norm_post_mix, norm_pre_mlp, norm_post_mlp, w_up, w_down):
    B, L, _ = x.shape
    pos = base + jnp.arange(L)
    lbs = lower_bounds(lb_logits)
    h = x
    new_hgrn = []
    k_ext = swa_k_past
    v_ext = swa_v_past
    for l in range(DEPTH):
        if l == N_A_LAYERS:
            kv = rms_norm(h, kv_norm) @ w_kv
            k_new = rope(kv[..., :SWA_KV_WIDTH].reshape(B, L, SWA_KV_HEADS, SWA_HEAD_DIM), pos)
            v_new = kv[..., SWA_KV_WIDTH:].reshape(B, L, SWA_KV_HEADS, SWA_HEAD_DIM)
            k_ext = jnp.concatenate([swa_k_past, k_new.astype(swa_k_past.dtype)], axis=1)
            v_ext = jnp.concatenate([swa_v_past, v_new.astype(swa_v_past.dtype)], axis=1)
        hn = rms_norm(h, norm_pre_mix[l])
        if l < N_A_LAYERS:
            proj = hn @ w_in_a[l]
            tok_out, s_fin = hgrn2_mix(proj[..., :4 * HGRN_WIDTH], lbs[l], hgrn_norm[l], hgrn_s0[l])
            new_hgrn.append(s_fin)
            cq = proj[..., 4 * HGRN_WIDTH:]
        else:
            j = l - N_A_LAYERS
            proj = hn @ w_in_b[j]
            q = rope(proj[..., :SWA_WIDTH].reshape(B, L, SWA_HEADS, SWA_HEAD_DIM), pos)
            tok_out = swa_attend(q, k_ext.astype(q.dtype), v_ext.astype(q.dtype), sinks[j], base).reshape(B, L, SWA_WIDTH)
            cq = proj[..., SWA_WIDTH:]
        x_out = mem_attend(cq.reshape(B, L, XATTN_HEADS, XATTN_HEAD_DIM),
                           mem_k[l].astype(cq.dtype), mem_v[l].astype(cq.dtype)).reshape(B, L, XATTN_WIDTH)
        mix = jnp.concatenate([tok_out, x_out], axis=-1) @ w_out[l]
        h = h + rms_norm(mix, norm_post_mix[l])
        u = jnp.square(jax.nn.relu(rms_norm(h, norm_pre_mlp[l]) @ w_up[l]))
        h = h + rms_norm(u @ w_down[l], norm_post_mlp[l])
    return h, jnp.stack(new_hgrn), k_ext[:, -WINDOW:], v_ext[:, -WINDOW:]


def setup_inputs(seed: int = 0) -> dict:
    key = jax.random.key(seed)
    ks = iter(jax.random.split(key, 32))

    def nrm(shape, scale):
        return jax.random.normal(next(ks), shape, jnp.float32) * scale

    def gain(shape):
        return 1.0 + 0.05 * jax.random.normal(next(ks), shape, jnp.float32)

    mem_shape_c = (DEPTH, DEC_BATCH, N_MEM, XATTN_HEADS, XATTN_HEAD_DIM)
    swa_shape_c = (DEC_BATCH, WINDOW, SWA_KV_HEADS, SWA_HEAD_DIM)
    return {
        'x_prompt': nrm((BATCH, SEQ, D_MODEL), 1.0),
        'x_sample': nrm((DEC_BATCH, DEC_SEQ, D_MODEL), 1.0),
        'cache_mem_k': nrm(mem_shape_c, 1.0),
        'cache_mem_v': nrm(mem_shape_c, 1.0),
        'state_hgrn': nrm((N_A_LAYERS, DEC_BATCH, HGRN_HEADS, HGRN_HEAD_DIM, HGRN_HEAD_DIM), 0.5),
        'state_swa_k': nrm(swa_shape_c, 1.0),
        'state_swa_v': nrm(swa_shape_c, 1.0),
        'mem_prompt': nrm((BATCH, N_MEM, D_MODEL), 1.0),
        'mem_norm': gain((DEPTH, D_MODEL)),
        'w_mem_kv': nrm((DEPTH, D_MODEL, 2 * XATTN_WIDTH), D_MODEL ** -0.5),
        'w_in_a': nrm((N_A_LAYERS, D_MODEL, 4 * HGRN_WIDTH + XATTN_WIDTH), D_MODEL ** -0.5),
        'lb_logits': nrm((N_A_LAYERS, HGRN_WIDTH), 1.0),
        'hgrn_norm': gain((N_A_LAYERS, HGRN_WIDTH)),
        'w_in_b': nrm((N_B_LAYERS, D_MODEL, SWA_WIDTH + XATTN_WIDTH), D_MODEL ** -0.5),
        'sinks': nrm((N_B_LAYERS, SWA_HEADS), 0.5),
        'kv_norm': gain((D_MODEL,)),
        'w_kv': nrm((D_MODEL, 2 * SWA_KV_WIDTH), D_MODEL ** -0.5),
        'w_out': nrm((DEPTH, MIX_WIDTH, D_MODEL), MIX_WIDTH ** -0.5),
        'norm_pre_mix': gain((DEPTH, D_MODEL)),
        'norm_post_mix': gain((DEPTH, D_MODEL)),
        'norm_pre_mlp': gain((DEPTH, D_MODEL)),
        'norm_post_mlp': gain((DEPTH, D_MODEL)),
        'w_up': nrm((DEPTH, D_MODEL, D_FF), D_MODEL ** -0.5),
        'w_down': nrm((DEPTH, D_FF, D_MODEL), D_FF ** -0.5),
    }


def reference(x_prompt, x_sample, cache_mem_k, cache_mem_v, state_hgrn, state_swa_k, state_swa_v,
              mem_prompt, mem_norm, w_mem_kv, w_in_a, lb_logits, hgrn_norm, w_in_b, sinks,
              kv_norm, w_kv, w_out, norm_pre_mix, norm_post_mix, norm_pre_mlp, norm_post_mlp,
              w_up, w_down):
    Bp = x_prompt.shape[0]
    mk_list, mv_list = [], []
    for l in range(DEPTH):
        kv = rms_norm(mem_prompt, mem_norm[l]) @ w_mem_kv[l]
        mk_list.append(kv[..., :XATTN_WIDTH].reshape(Bp, N_MEM, XATTN_HEADS, XATTN_HEAD_DIM))
        mv_list.append(kv[..., XATTN_WIDTH:].reshape(Bp, N_MEM, XATTN_HEADS, XATTN_HEAD_DIM))
    mem_k_prompt = jnp.stack(mk_list)
    mem_v_prompt = jnp.stack(mv_list)

    hgrn0 = jnp.zeros((N_A_LAYERS, Bp, HGRN_HEADS, HGRN_HEAD_DIM, HGRN_HEAD_DIM), x_prompt.dtype)
    swa0 = jnp.zeros((Bp, WINDOW, SWA_KV_HEADS, SWA_HEAD_DIM), x_prompt.dtype)
    weights = (w_in_a, lb_logits, hgrn_norm, w_in_b, sinks, kv_norm, w_kv, w_out,
               norm_pre_mix, norm_post_mix, norm_pre_mlp, norm_post_mlp, w_up, w_down)

    y_prompt, hgrn_prompt, swa_k_prompt, swa_v_prompt = trunk(
        x_prompt, 0, mem_k_prompt, mem_v_prompt, hgrn0, swa0, swa0, *weights)
    y_sample, hgrn_sample, swa_k_sample, swa_v_sample = trunk(
        x_sample, PAST_LEN, cache_mem_k, cache_mem_v, state_hgrn, state_swa_k, state_swa_v, *weights)
    return (y_prompt, y_sample, mem_k_prompt, mem_v_prompt, hgrn_prompt, swa_k_prompt, swa_v_prompt,
            hgrn_sample, swa_k_sample, swa_v_sample)
```

```cpp
#include <hip/hip_runtime.h>
#include <cstdio>
#include <cstdint>

#define LAS __attribute__((address_space(3)))
#define GAS __attribute__((address_space(1)))
typedef unsigned short bf16_t;
typedef short bf16x8 __attribute__((ext_vector_type(8)));
typedef short s16x4 __attribute__((ext_vector_type(4)));
typedef float f32x4 __attribute__((ext_vector_type(4)));
typedef float f32x2 __attribute__((ext_vector_type(2)));
typedef unsigned u32x4 __attribute__((ext_vector_type(4)));
typedef unsigned u32x2 __attribute__((ext_vector_type(2)));
typedef __bf16 bf16x2_t __attribute__((ext_vector_type(2)));

constexpr int D = 1024, SEQ = 8192, BP = 2, MP = BP * SEQ, BS = 128, MT = 16640  ;
constexpr int FF = 4096, NA = 3328, HW = 768, XW = 256, NMEM = 256;
constexpr int KVP = 128 + SEQ + 32;
constexpr float QSCALE = 0.18033688011112042f;
constexpr float LOG2E = 1.4426950408889634f;
constexpr float EPS = 1e-6f;
constexpr int NWAVES = 8, NTHR = 512;

constexpr size_t O_YP = 0, O_YS = O_YP + (size_t)MP * D, O_MK = O_YS + (size_t)BS * D, O_MV = O_MK + 524288, O_HP = O_MV + 524288,
                 O_SKP = O_HP + 393216, O_SVP = O_SKP + 65536, O_HS = O_SVP + 65536, O_SKS = O_HS + 25165824, O_SVS = O_SKS + 4194304, O_END = O_SVS + 4194304;

constexpr size_t al256(size_t x) { return (x + 255) & ~(size_t)255; }
constexpr size_t WS_CTL = 0, CTL_BYTES = 1u << 20;
constexpr size_t WS_WMEM = WS_CTL + CTL_BYTES;
constexpr size_t WS_WINA = WS_WMEM + (size_t)2048 * 1024 * 2;
constexpr size_t SZ_WINA = (size_t)NA * 1024 * 2;
constexpr size_t WS_WINB0 = WS_WINA + 2 * SZ_WINA;
constexpr size_t WS_WINB1 = WS_WINB0 + (size_t)1536 * 1024 * 2;
constexpr size_t WS_WOUT = WS_WINB1 + (size_t)1024 * 1024 * 2;
constexpr size_t WS_WUP = WS_WOUT + (size_t)4 * 1024 * 1024 * 2;
constexpr size_t WS_WDN = WS_WUP + (size_t)4 * 4096 * 1024 * 2;
constexpr size_t WS_H = WS_WDN + (size_t)4 * 4096 * 1024 * 2;
constexpr size_t WS_XN = WS_H + (size_t)MT * D * 4;
constexpr size_t WS_MN = WS_XN + (size_t)MT * D * 2;
constexpr size_t WS_ROPE = WS_MN + (size_t)512 * D * 2;
constexpr size_t WS_MKB = al256(WS_ROPE + (size_t)8193 * 32 * 8);
constexpr size_t WS_MVT = WS_MKB + (size_t)4 * 2 * 4 * 256 * 64 * 2;
constexpr size_t WS_KR = WS_MVT + (size_t)4 * 2 * 4 * 256 * 64 * 2;
constexpr size_t WS_VT = WS_KR + (size_t)2 * 4 * KVP * 64 * 2;
constexpr size_t WS_KSN = WS_VT + (size_t)2 * 4 * KVP * 64 * 2;
constexpr size_t WS_VSN = WS_KSN + (size_t)128 * 256 * 4;
constexpr size_t WS_AC = WS_VSN + (size_t)128 * 256 * 4;
constexpr size_t WS_LBS = WS_AC + (size_t)12 * 128 * 128 * 4;
constexpr size_t WS_OV = al256(WS_LBS + (size_t)2 * 768 * 4);
constexpr size_t WS_MIX = WS_OV;
constexpr size_t WS_Y = WS_MIX + (size_t)MT * D * 2;
constexpr size_t WS_HB = WS_Y + (size_t)MT * D * 4;
constexpr size_t WS_QS = WS_MIX + (size_t)MT * D * 2;
constexpr size_t SZ_P768 = (size_t)MT * HW * 2;
constexpr size_t WS_KK = WS_QS + SZ_P768, WS_VV = WS_KK + SZ_P768, WS_GG = WS_VV + SZ_P768;
constexpr size_t WS_LF = WS_GG + SZ_P768;
constexpr size_t WS_CQ = WS_LF + (size_t)MT * HW * 4;
constexpr size_t WS_UT = WS_CQ + (size_t)MT * XW * 2;
constexpr size_t WS_ST = WS_UT + (size_t)12 * 128 * 128 * 128 * 4;
constexpr size_t WS_END_A = WS_ST + (size_t)12 * 128 * 128 * 128 * 2;
constexpr size_t WS_END_B = WS_HB + (size_t)MT * FF * 2;
constexpr size_t WS_END = WS_END_A > WS_END_B ? WS_END_A : WS_END_B;

constexpr int RING_BYTES = 131072, LDSCTL_OFF = RING_BYTES, MISC_OFF = LDSCTL_OFF + 320, LDS_BYTES = 147456;

__device__ __forceinline__ unsigned cvtpk(float lo, float hi) { f32x2 v = {lo, hi}; bf16x2_t b = __builtin_convertvector(v, bf16x2_t); return __builtin_bit_cast(unsigned, b); }
__device__ __forceinline__ bf16_t f2bf(float f) { return (bf16_t)(cvtpk(f, 0.f) & 0xffffu); }
__device__ __forceinline__ float bf2f(bf16_t x) { return __uint_as_float((unsigned)x << 16); }
__device__ __forceinline__ float bflo(unsigned w) { return __uint_as_float(w << 16); }
__device__ __forceinline__ float bfhi(unsigned w) { return __uint_as_float(w & 0xffff0000u); }
__device__ __forceinline__ float wave_sum(float v) {
#pragma unroll
    for (int o = 1; o < 64; o <<= 1) v += __shfl_xor(v, o);
    return v;
}
__device__ __forceinline__ float fexp(float x) { return __builtin_amdgcn_exp2f(x * 1.4426950408889634f); }
__device__ __forceinline__ float flog(float x) { return __builtin_amdgcn_logf(x) * 0.6931471805599453f; }
__device__ __forceinline__ float fsigmoid(float x) { return __builtin_amdgcn_rcpf(1.0f + fexp(-x)); }
__device__ __forceinline__ float fsilu(float x) { return x * __builtin_amdgcn_rcpf(1.0f + fexp(-x)); }
#define LDS_WAIT() asm volatile("s_waitcnt lgkmcnt(0)" ::: "memory")
#define VM_WAIT() asm volatile("s_waitcnt vmcnt(0)" ::: "memory")

struct Args { const float* in[24]; float* out; unsigned char* ws; };
typedef const float* cfptr_t;
__device__ __forceinline__ const float* in_ptr(int i) { return ((const __attribute__((address_space(4))) cfptr_t*)__builtin_amdgcn_kernarg_segment_ptr())[i]; }

namespace pg8 {
constexpr int BM = 256, BK = 64, HALF = 128, HTB = HALF * BK * 2, STAGE_BYTES = 8 * HTB, NXCD = 8, WGM = 8;
__host__ __device__ __forceinline__ int lds_byte(int r, int c) { const int st = (r >> 4) * 2 + (c >> 5), rr = r & 15, cc = c & 31, ob = rr * 64 + cc * 2; return st * 1024 + (ob ^ (((ob >> 9) & 1) << 5)); }
__host__ __device__ __forceinline__ void stage_rc(int b, int& R, int& C) { const int st = b / 1024, sb = b % 1024, swz = sb ^ (((sb >> 9) & 1) << 5); R = (st >> 1) * 16 + swz / 64; C = (st & 1) * 32 + (swz % 64) / 2; }
__host__ __device__ __forceinline__ int perm32(int rho) { const int n = rho >> 4, i = rho & 15; return 8 * (i >> 2) + 4 * n + (i & 3); }
struct Unit { int pm, pn; };
struct Gemm { const bf16_t* A; const bf16_t* Bt; int M, N, K; };
struct StaticOrder {
    int nM, nN, nwg, G, c;
    __device__ void init(int M, int N, int G_, int c_) { nM = M / BM; nN = N / BM; nwg = nM * nN; G = G_; c = c_; }
    __device__ bool next(int i, Unit& u) const {
        const long L = (long)i * G + c; if (L >= nwg) return false;
        int wgid = (int)L; { const int q = nwg / NXCD, r = nwg % NXCD, xcd = wgid % NXCD, off = wgid / NXCD; wgid = (xcd < r ? xcd * (q + 1) : r * (q + 1) + (xcd - r) * q) + off; }
        const int nig = WGM * nN, gid = wgid / nig, fm = gid * WGM, gsz = (nM - fm) < WGM ? (nM - fm) : WGM;
        u.pm = fm + ((wgid % nig) % gsz); u.pn = (wgid % nig) / gsz; return true;
    }
};

template <class Epi>
__device__ __forceinline__ void gemm_phase(LAS unsigned char* lds, const Gemm g, const StaticOrder& S, const Epi& E, const int tid) {
    const int wid = __builtin_amdgcn_readfirstlane(tid >> 6), lane = tid & 63, wr = wid >> 2, wc = wid & 3, fr = lane & 15, fq = lane >> 4;
    const int K = g.K, nt = K / BK;
    unsigned voffA[2], voffB[2];
#pragma unroll
    for (int i = 0; i < 2; ++i) { int R, C; stage_rc(tid * 16 + i * 8192, R, C); const int Rb = (R & ~31) + perm32(R & 31);
        voffA[i] = (unsigned)(R * K + C) * 2u; voffB[i] = (unsigned)(Rb * K + C) * 2u; }
    const size_t kstep = (size_t)(BK * 2);
    const size_t hstep = (size_t)HALF * K * 2;
    const size_t tstep = 2 * hstep;
    const unsigned ldsw = (unsigned)wid * 1024u;
    const int aoff = lds_byte(wr * 64 + fr, fq * 8), boff = lds_byte(wc * 32 + fr, fq * 8);
#define PG8_SA(b, h) (((b) * 2 + (h)) * HTB)
#define PG8_SB(b, h) ((4 + (b) * 2 + (h)) * HTB)
#define PG8_STAGE(bufoff, gbase, voff) do { _Pragma("unroll") for (int _i = 0; _i < 2; ++_i) \
        __builtin_amdgcn_global_load_lds((const unsigned*)((const char*)(gbase) + (voff)[_i]), (LAS unsigned*)(lds + (bufoff) + ldsw + _i * 8192), 16, 0, 0); } while (0)
#define PG8_LDA(dst, b, h) do { _Pragma("unroll") for (int m = 0; m < 4; ++m) _Pragma("unroll") for (int k = 0; k < 2; ++k) dst[m][k] = *(const LAS bf16x8*)(lds + PG8_SA(b, h) + aoff + m * 2048 + k * 1024); } while (0)
#define PG8_LDB(dst, b, h) do { _Pragma("unroll") for (int n = 0; n < 2; ++n) _Pragma("unroll") for (int k = 0; k < 2; ++k) dst[n][k] = *(const LAS bf16x8*)(lds + PG8_SB(b, h) + boff + n * 2048 + k * 1024); } while (0)
#define PG8_MMA(ai, bj, At, Bt) do { __builtin_amdgcn_s_setprio(1); _Pragma("unroll") for (int m = 0; m < 4; ++m) _Pragma("unroll") for (int n = 0; n < 2; ++n) _Pragma("unroll") for (int k = 0; k < 2; ++k) \
        acc[ai][bj][m][n] = __builtin_amdgcn_mfma_f32_16x16x32_bf16(Bt[n][k], At[m][k], acc[ai][bj][m][n], 0, 0, 0); __builtin_amdgcn_s_setprio(0); } while (0)
#define PG8_WAIT_V(n) asm volatile("s_waitcnt vmcnt(" #n ")" ::: "memory")
#define PG8_WAIT_L(n) asm volatile("s_waitcnt lgkmcnt(" #n ")" ::: "memory")
#define PG8_BAR __builtin_amdgcn_s_barrier()
#define PG8_SCHED __builtin_amdgcn_sched_barrier(0)
    Unit cur, nxt; int ui = 0;
    if (!S.next(0, cur)) return;
    f32x4 acc[2][2][4][2];
#pragma unroll
    for (int a = 0; a < 2; ++a)
#pragma unroll
        for (int b = 0; b < 2; ++b)
#pragma unroll
            for (int m = 0; m < 4; ++m)
#pragma unroll
                for (int n = 0; n < 2; ++n) acc[a][b][m][n] = (f32x4){0.f, 0.f, 0.f, 0.f};
    bf16x8 At[4][2], B0[2][2], B1[2][2];
    const char* cA = (const char*)g.A + (size_t)cur.pm * tstep; const char* cB = (const char*)g.Bt + (size_t)cur.pn * tstep;
    PG8_STAGE(PG8_SB(0, 0), cB, voffB); PG8_STAGE(PG8_SB(0, 1), cB + hstep, voffB); PG8_STAGE(PG8_SA(0, 0), cA, voffA); PG8_STAGE(PG8_SA(0, 1), cA + hstep, voffA);
    if (wr == 1) PG8_BAR;
    PG8_WAIT_V(2); PG8_BAR;
    PG8_STAGE(PG8_SB(1, 0), cB + kstep, voffB); PG8_STAGE(PG8_SA(1, 0), cA + kstep, voffA); PG8_STAGE(PG8_SB(1, 1), cB + hstep + kstep, voffB);
    PG8_WAIT_V(6); PG8_BAR;
    for (;;) {
        const bool has_next = S.next(ui + 1, nxt);
        const char* nA = has_next ? (const char*)g.A + (size_t)nxt.pm * tstep : cA; const char* nB = has_next ? (const char*)g.Bt + (size_t)nxt.pn * tstep : cB;
        for (int t = 0; t < nt; t += 2) {
            const bool last = (t == nt - 2);
            const char* a1 = cA + (size_t)(t + 1) * kstep;
            const char* a2 = last ? nA : cA + (size_t)(t + 2) * kstep; const char* b2 = last ? nB : cB + (size_t)(t + 2) * kstep;
            const char* a3 = a2 + kstep; const char* b3 = b2 + kstep;
            PG8_LDB(B0, 0, 0); PG8_LDB(B1, 0, 1); PG8_SCHED; PG8_LDA(At, 0, 0); PG8_STAGE(PG8_SA(1, 1), a1 + hstep, voffA);
            PG8_WAIT_V(8); PG8_WAIT_L(0); PG8_BAR; PG8_MMA(0, 0, At, B0); PG8_MMA(0, 1, At, B1); PG8_BAR; PG8_SCHED;
            PG8_LDA(At, 0, 1); PG8_STAGE(PG8_SB(0, 0), b2, voffB); PG8_STAGE(PG8_SB(0, 1), b2 + hstep, voffB); PG8_STAGE(PG8_SA(0, 0), a2, voffA);
            PG8_WAIT_V(8); PG8_WAIT_L(0); PG8_BAR; PG8_MMA(1, 0, At, B0); PG8_MMA(1, 1, At, B1); PG8_BAR; PG8_SCHED;
            PG8_LDB(B0, 1, 0); PG8_LDB(B1, 1, 1); PG8_SCHED; PG8_LDA(At, 1, 0); PG8_STAGE(PG8_SA(0, 1), a2 + hstep, voffA);
            PG8_WAIT_V(8); PG8_WAIT_L(0); PG8_BAR; PG8_MMA(0, 0, At, B0); PG8_MMA(0, 1, At, B1); PG8_BAR; PG8_SCHED;
            PG8_LDA(At, 1, 1); PG8_STAGE(PG8_SB(1, 0), b3, voffB); PG8_STAGE(PG8_SB(1, 1), b3 + hstep, voffB); PG8_STAGE(PG8_SA(1, 0), a3, voffA);
            PG8_WAIT_V(8); PG8_WAIT_L(0); PG8_BAR; PG8_MMA(1, 0, At, B0); PG8_MMA(1, 1, At, B1); PG8_BAR; PG8_SCHED;
        }
        if (wr == 0) PG8_BAR;
        E(acc, cur, wr, wc, fr, fq);
        if (!has_next) break;
#pragma unroll
        for (int a = 0; a < 2; ++a)
#pragma unroll
            for (int b = 0; b < 2; ++b)
#pragma unroll
                for (int m = 0; m < 4; ++m)
#pragma unroll
                    for (int n = 0; n < 2; ++n) acc[a][b][m][n] = (f32x4){0.f, 0.f, 0.f, 0.f};
        cur = nxt; cA = nA; cB = nB; ++ui;
        if (wr == 1) PG8_BAR;
    }
    PG8_WAIT_V(0);
    PG8_BAR;
#undef PG8_SA
#undef PG8_SB
#undef PG8_STAGE
#undef PG8_LDA
#undef PG8_LDB
#undef PG8_MMA
#undef PG8_WAIT_V
#undef PG8_WAIT_L
#undef PG8_BAR
#undef PG8_SCHED
}
}

#define XB_TMO      128
#define XB_XCNT(j)  (256  + 64 * (j))
#define XB_XSUB(j)  (1280 + 64 * (j))
#define XB_XGEN(j)  (2304 + 64 * (j))
#define XB_TOP      3328
#define XB_TOPGEN   3392
#define XCD_BAR_WORDS 3456
#define XB_SPIN_CAP (1u << 18)
__device__ __forceinline__ unsigned xb_ld(unsigned* p)              { return __hip_atomic_load(p, __ATOMIC_RELAXED, __HIP_MEMORY_SCOPE_AGENT); }
__device__ __forceinline__ unsigned xb_add(unsigned* p, unsigned v) { return __hip_atomic_fetch_add(p, v, __ATOMIC_RELAXED, __HIP_MEMORY_SCOPE_AGENT); }
__device__ __forceinline__ unsigned xb_xcc_id() { return (unsigned)__builtin_amdgcn_s_getreg((3 << 11) | 20) & 0xFu; }
#define XB_SPIN(cond, bar) do { unsigned _sp = 0; while (cond) { __builtin_amdgcn_s_sleep(1); \
    if ((++_sp & 255u) == 0u) { if (xb_ld(&(bar)[XB_TMO])) break; if (_sp > XB_SPIN_CAP) { atomicAdd(&(bar)[XB_TMO], 1u); break; } } } } while (0)
struct XcdBarrier { unsigned* bar; unsigned x; volatile LAS unsigned* st; };
__device__ __forceinline__ XcdBarrier xcd_barrier_post(unsigned* bar, volatile LAS unsigned* st) {
    XcdBarrier b; b.bar = bar; b.x = xb_xcc_id(); b.st = st;
    if (threadIdx.x == 0) (void)xb_add(&bar[XB_XCNT(b.x)], 1u);
    return b;
}
__device__ __forceinline__ void xcd_barrier_complete(unsigned* bar, unsigned x, unsigned& nloc, unsigned& nx) {
    const unsigned G = gridDim.x * gridDim.y * gridDim.z;
    unsigned sum, cnt, mine, sp = 0u;
    for (;;) {
        sum = 0u; cnt = 0u; mine = 0u;
#pragma unroll
        for (unsigned j = 0; j < 16; ++j) { const unsigned c = xb_ld(&bar[XB_XCNT(j)]); sum += c; cnt += (c > 0u) ? 1u : 0u; mine = (j == x) ? c : mine; }
        if (sum == G) break;
        __builtin_amdgcn_s_sleep(1);
        if ((++sp & 255u) == 0u) { if (xb_ld(&bar[XB_TMO])) break; if (sp > XB_SPIN_CAP) { atomicAdd(&bar[XB_TMO], 1u); break; } }
    }
    nloc = mine > 0u ? mine : 1u; nx = cnt > 0u ? cnt : 1u;
}
__device__ __forceinline__ void xcd_barrier(const XcdBarrier& b) {
    asm volatile("s_waitcnt vmcnt(0)" ::: "memory");
    __syncthreads();
    if (threadIdx.x == 0) {
        unsigned* bar = b.bar;
        __builtin_amdgcn_s_waitcnt(0);
        unsigned nloc = b.st[0], nx = b.st[1];
        if (nloc == 0u) { xcd_barrier_complete(bar, b.x, nloc, nx); b.st[0] = nloc; b.st[1] = nx; }
        const unsigned old = xb_add(&bar[XB_XSUB(b.x)], 1u);
        const unsigned gen = old / nloc;
        if (old + 1u == (gen + 1u) * nloc) {
            __builtin_amdgcn_fence(__ATOMIC_RELEASE, "agent");
            asm volatile("s_waitcnt vmcnt(0)" ::: "memory");
            const unsigned og = xb_add(&bar[XB_TOP], 1u);
            const unsigned tg = og / nx;
            if (og + 1u == (tg + 1u) * nx) xb_add(&bar[XB_TOPGEN], 1u);
            else XB_SPIN(xb_ld(&bar[XB_TOPGEN]) == tg, bar);
            __builtin_amdgcn_fence(__ATOMIC_ACQUIRE, "agent");
            xb_add(&bar[XB_XGEN(b.x)], 1u);
            asm volatile("s_waitcnt vmcnt(0)" ::: "memory");
        } else {
            XB_SPIN(xb_ld(&bar[XB_XGEN(b.x)]) == gen, bar);
            __builtin_amdgcn_fence(__ATOMIC_ACQUIRE, "agent");
            asm volatile("s_waitcnt vmcnt(0)" ::: "memory");
        }
    }
    __syncthreads();
}

struct Frame {
    LAS unsigned char* lds;
    int tid, lane, wave, vcu, G;
    unsigned char* ws; float* out;
};
#define WSP(T, off) ((T*)(ws + (off)))

struct Seg { int in, off, ld, col0; unsigned long long dst; int row0, nrows, K, gin, goff, flags; };
constexpr int SEG_PERM = 1, SEG_QS = 2;
constexpr int NSEG = 26;
__constant__ Seg c_segs[NSEG] = {
    {9, 0 * 1024 * 512, 512, 0, WS_WMEM, 0, 512, 1024, 8, 0, 0},
    {9, 1 * 1024 * 512, 512, 0, WS_WMEM, 512, 512, 1024, 8, 1024, 0},
    {9, 2 * 1024 * 512, 512, 0, WS_WMEM, 1024, 512, 1024, 8, 2048, 0},
    {9, 3 * 1024 * 512, 512, 0, WS_WMEM, 1536, 512, 1024, 8, 3072, 0},
    {10, 0, NA, 0, WS_WINA, 0, 3072, 1024, 18, 0, 0},
    {10, 0, NA, 3072, WS_WINA, 3072, 256, 1024, 18, 0, SEG_QS},
    {10, 1024 * NA, NA, 0, WS_WINA + SZ_WINA, 0, 3072, 1024, 18, 1024, 0},
    {10, 1024 * NA, NA, 3072, WS_WINA + SZ_WINA, 3072, 256, 1024, 18, 1024, SEG_QS},
    {13, 0, 1024, 0, WS_WINB0, 0, 768, 1024, 18, 2048, SEG_PERM | SEG_QS},
    {13, 0, 1024, 768, WS_WINB0, 768, 256, 1024, 18, 2048, SEG_QS},
    {16, 0, 512, 0, WS_WINB0, 1024, 256, 1024, 15, 0, SEG_PERM},
    {16, 0, 512, 256, WS_WINB0, 1280, 256, 1024, 15, 0, 0},
    {13, 1024 * 1024, 1024, 0, WS_WINB1, 0, 768, 1024, 18, 3072, SEG_PERM | SEG_QS},
    {13, 1024 * 1024, 1024, 768, WS_WINB1, 768, 256, 1024, 18, 3072, SEG_QS},
    {17, 0 * 1024 * 1024, 1024, 0, WS_WOUT + 0 * 2097152ull, 0, 1024, 1024, -1, 0, 0},
    {17, 1 * 1024 * 1024, 1024, 0, WS_WOUT + 1 * 2097152ull, 0, 1024, 1024, -1, 0, 0},
    {17, 2 * 1024 * 1024, 1024, 0, WS_WOUT + 2 * 2097152ull, 0, 1024, 1024, -1, 0, 0},
    {17, 3 * 1024 * 1024, 1024, 0, WS_WOUT + 3 * 2097152ull, 0, 1024, 1024, -1, 0, 0},
    {22, 0 * 4096 * 1024, 4096, 0, WS_WUP + 0 * 8388608ull, 0, 4096, 1024, 20, 0, 0},
    {22, 1 * 4096 * 1024, 4096, 0, WS_WUP + 1 * 8388608ull, 0, 4096, 1024, 20, 1024, 0},
    {22, 2 * 4096 * 1024, 4096, 0, WS_WUP + 2 * 8388608ull, 0, 4096, 1024, 20, 2048, 0},
    {22, 3 * 4096 * 1024, 4096, 0, WS_WUP + 3 * 8388608ull, 0, 4096, 1024, 20, 3072, 0},
    {23, 0 * 4096 * 1024, 1024, 0, WS_WDN + 0 * 8388608ull, 0, 1024, 4096, -1, 0, 0},
    {23, 1 * 4096 * 1024, 1024, 0, WS_WDN + 1 * 8388608ull, 0, 1024, 4096, -1, 0, 0},
    {23, 2 * 4096 * 1024, 1024, 0, WS_WDN + 2 * 8388608ull, 0, 1024, 4096, -1, 0, 0},
    {23, 3 * 4096 * 1024, 1024, 0, WS_WDN + 3 * 8388608ull, 0, 1024, 4096, -1, 0, 0},
};
__constant__ double c_invfreq[32] = {1.0, 0.7498942093324559, 0.5623413251903491, 0.4216965034285822, 0.31622776601683794, 0.23713737056616552, 0.1778279410038923, 0.1333521432163324, 0.1, 0.07498942093324558, 0.05623413251903491, 0.042169650342858224, 0.03162277660168379, 0.023713737056616554, 0.01778279410038923, 0.01333521432163324, 0.01, 0.007498942093324558, 0.005623413251903491, 0.004216965034285823, 0.0031622776601683794, 0.0023713737056616554, 0.0017782794100389228, 0.001333521432163324, 0.001, 0.0007498942093324559, 0.0005623413251903491, 0.00042169650342858224, 0.00031622776601683794, 0.00023713737056616554, 0.00017782794100389227, 0.0001333521432163324};

__device__ __forceinline__ void seg_item(unsigned char* ws, const Seg& s, LAS float* scr, int item, int lane) {
    const float* W = in_ptr(s.in) + s.off;
    const float* gain = s.gin >= 0 ? in_ptr(s.gin) + s.goff : nullptr;
    const float scale = (s.flags & SEG_QS) ? QSCALE : 1.0f;
    bf16_t* WT = (bf16_t*)(ws + s.dst);
    const int nblk = s.nrows / 32, kb = item / nblk, nb = item % nblk, k0 = 64 * kb, n0 = 32 * nb, K = s.K;
    int j = lane & 31, src;
    if (s.flags & SEG_PERM) { const int jj = (n0 & 63) + j; src = (n0 & ~63) + (jj >> 1) + 32 * (jj & 1); } else src = n0 + j;
    src += s.col0;
#pragma unroll 8
    for (int i = 0; i < 32; ++i) { const int kk = 2 * i + (lane >> 5); float w = W[(size_t)(k0 + kk) * s.ld + src]; const float gn = gain ? gain[k0 + kk] * scale : scale; scr[kk * 33 + j] = w * gn; }
    LDS_WAIT(); asm volatile("" ::: "memory");
    const int c = lane & 7;
#pragma unroll
    for (int jq = 0; jq < 4; ++jq) { const int n = (lane >> 3) + 8 * jq; const LAS float* sp = scr + (8 * c) * 33 + n;
        u32x4 o; o.x = cvtpk(sp[0 * 33], sp[1 * 33]); o.y = cvtpk(sp[2 * 33], sp[3 * 33]); o.z = cvtpk(sp[4 * 33], sp[5 * 33]); o.w = cvtpk(sp[6 * 33], sp[7 * 33]);
        *(u32x4*)(WT + (size_t)(s.row0 + n0 + n) * K + k0 + 8 * c) = o; }
    LDS_WAIT(); asm volatile("" ::: "memory");
}

__device__ __forceinline__ void rms_row_to_bf16(const float* xrow, bf16_t* orow, float* hcopy, int lane) {
    const f32x4* xr = (const f32x4*)xrow + lane;
    f32x4 v[4]; float s = 0.f;
#pragma unroll
    for (int j = 0; j < 4; ++j) { v[j] = xr[64 * j]; s += (v[j].x * v[j].x + v[j].y * v[j].y) + (v[j].z * v[j].z + v[j].w * v[j].w); }
    const float rstd = rsqrtf(wave_sum(s) * (1.f / D) + EPS);
    u32x2* o8 = (u32x2*)orow + lane;
#pragma unroll
    for (int j = 0; j < 4; ++j) { u32x2 w; w.x = cvtpk(v[j].x * rstd, v[j].y * rstd); w.y = cvtpk(v[j].z * rstd, v[j].w * rstd); o8[64 * j] = w; }
    if (hcopy) { f32x4* hc = (f32x4*)hcopy + lane;
#pragma unroll
        for (int j = 0; j < 4; ++j) hc[64 * j] = v[j]; }
}

__device__ __forceinline__ void p0_prologue(Frame& F) {
    unsigned char* ws = F.ws;
    LAS float* scr = (LAS float*)(F.lds + F.wave * 16384);
    const int gw = F.vcu * NWAVES + F.wave, NGW = F.G * NWAVES;
    int total = 0;
    for (int s = 0; s < NSEG; ++s) total += (c_segs[s].K / 64) * (c_segs[s].nrows / 32);
    for (int it = gw; it < total; it += NGW) {
        int r = it, s = 0;
        for (; s < NSEG; ++s) { const int n = (c_segs[s].K / 64) * (c_segs[s].nrows / 32); if (r < n) break; r -= n; }
        seg_item(ws, c_segs[s], scr, r, F.lane);
    }
    float* H = WSP(float, WS_H); bf16_t* XN = WSP(bf16_t, WS_XN);
    for (int m = gw; m < MT; m += NGW) {
        if (m < MP) rms_row_to_bf16(in_ptr(0) + (size_t)m * D, XN + (size_t)m * D, H + (size_t)m * D, F.lane);
        else if (m < MP + BS) rms_row_to_bf16(in_ptr(1) + (size_t)(m - MP) * D, XN + (size_t)m * D, H + (size_t)m * D, F.lane);
        else { u32x2* o8 = (u32x2*)(XN + (size_t)m * D) + F.lane; f32x4* hc = (f32x4*)(H + (size_t)m * D) + F.lane;
#pragma unroll
            for (int j = 0; j < 4; ++j) { o8[64 * j] = (u32x2){0u, 0u}; hc[64 * j] = (f32x4){0.f, 0.f, 0.f, 0.f}; } }
    }
    bf16_t* MN = WSP(bf16_t, WS_MN);
    for (int m = gw; m < 512; m += NGW) rms_row_to_bf16(in_ptr(7) + (size_t)m * D, MN + (size_t)m * D, nullptr, F.lane);
    f32x2* rope = WSP(f32x2, WS_ROPE);
    const int gt = F.vcu * NTHR + F.tid, NGT = F.G * NTHR;
    for (int e = gt; e < 8193 * 32; e += NGT) { const int pos = e >> 5, i = e & 31; double rev = (double)pos * c_invfreq[i] * 0.15915494309189535; rev -= __builtin_rint(rev);
        const float rf = (float)rev; rope[e] = (f32x2){__builtin_amdgcn_cosf(rf), __builtin_amdgcn_sinf(rf)}; }
    { float* LBS = WSP(float, WS_LBS); const float* lbl = in_ptr(11);
      for (int e = gt; e < HW; e += NGT) { LBS[e] = 0.f; LBS[HW + e] = fsigmoid(lbl[HW + e] - lbl[e]); } }
    bf16_t* KR = WSP(bf16_t, WS_KR); bf16_t* VT = WSP(bf16_t, WS_VT);
    for (int e = gt; e < 8 * 160 * 64; e += NGT) { const int bk = e / (160 * 64), r = (e / 64) % 160, d = e % 64; const int pos = r < 128 ? r : 128 + SEQ + (r - 128);
        KR[((size_t)bk * KVP + pos) * 64 + d] = 0; VT[((size_t)bk * 64 + d) * KVP + pos] = 0; }
}

enum { EK_MEMKV = 0, EK_INA = 1, EK_INB = 2, EK_F32 = 3, EK_UP = 4 };
struct Epi {
    int kind, layer; unsigned char* ws; float* out;
    __device__ __forceinline__ void operator()(const f32x4 (&acc)[2][2][4][2], const pg8::Unit& u, int wr, int wc, int fr, int fq) const {
        asm volatile("" : "+v"(fr), "+v"(fq));
        const int row0 = u.pm * 256 + wr * 64 + fr, cl0 = wc * 32 + 8 * fq;
        if (kind == EK_F32) {
            float* Y = WSP(float, WS_Y);
#pragma unroll
            for (int ai = 0; ai < 2; ++ai)
#pragma unroll
                for (int m = 0; m < 4; ++m) { float* rp = Y + (size_t)(row0 + ai * 128 + m * 16) * D + u.pn * 256 + cl0;
#pragma unroll
                    for (int bj = 0; bj < 2; ++bj) { *(f32x4*)(rp + bj * 128) = acc[ai][bj][m][0]; *(f32x4*)(rp + bj * 128 + 4) = acc[ai][bj][m][1]; } }
        } else if (kind == EK_UP) {
            bf16_t* HB = WSP(bf16_t, WS_HB);
#pragma unroll
            for (int ai = 0; ai < 2; ++ai)
#pragma unroll
                for (int m = 0; m < 4; ++m) { bf16_t* rp = HB + (size_t)(row0 + ai * 128 + m * 16) * FF + u.pn * 256 + cl0;
#pragma unroll
                    for (int bj = 0; bj < 2; ++bj) { f32x4 v0 = acc[ai][bj][m][0], v1 = acc[ai][bj][m][1];
#pragma unroll
                        for (int e = 0; e < 4; ++e) { const float r0 = fmaxf(v0[e], 0.f), r1 = fmaxf(v1[e], 0.f); v0[e] = r0 * r0; v1[e] = r1 * r1; }
                        u32x4 w; w.x = cvtpk(v0[0], v0[1]); w.y = cvtpk(v0[2], v0[3]); w.z = cvtpk(v1[0], v1[1]); w.w = cvtpk(v1[2], v1[3]);
                        *(u32x4*)(rp + bj * 128) = w; } }
        } else if (kind == EK_MEMKV) {
            const int l = u.pn >> 1, kv = u.pn & 1;
            float* of = out + (kv ? O_MV : O_MK);
            bf16_t* MKB = WSP(bf16_t, WS_MKB); bf16_t* MVT = WSP(bf16_t, WS_MVT);
#pragma unroll
            for (int ai = 0; ai < 2; ++ai)
#pragma unroll
                for (int m = 0; m < 4; ++m) { const int row = row0 + ai * 128 + m * 16, b = row >> 8, mm = row & 255;
#pragma unroll
                    for (int bj = 0; bj < 2; ++bj) { const int cc = bj * 128 + cl0, h = cc >> 6, d = cc & 63; const f32x4 v0 = acc[ai][bj][m][0], v1 = acc[ai][bj][m][1];
                        float* op = of + ((size_t)(l * 2 + b) * 256 + mm) * 256 + cc; *(f32x4*)op = v0; *(f32x4*)(op + 4) = v1;
                        if (kv == 0) { u32x4 w; w.x = cvtpk(v0[0], v0[1]); w.y = cvtpk(v0[2], v0[3]); w.z = cvtpk(v1[0], v1[1]); w.w = cvtpk(v1[2], v1[3]);
                            *(u32x4*)(MKB + ((size_t)((l * 2 + b) * 4 + h) * 256 + mm) * 64 + d) = w; }
                        else { bf16_t* vp = MVT + ((size_t)((l * 2 + b) * 4 + h) * 64 + d) * 256 + mm;
#pragma unroll
                            for (int e = 0; e < 4; ++e) { vp[(size_t)e * 256] = f2bf(v0[e]); vp[(size_t)(e + 4) * 256] = f2bf(v1[e]); } } } }
        } else if (kind == EK_INA) {
            const int sec = u.pn / 3, ct = u.pn % 3;
            bf16_t* QS = WSP(bf16_t, WS_QS); bf16_t* KK = WSP(bf16_t, WS_KK); bf16_t* VV = WSP(bf16_t, WS_VV); bf16_t* GG = WSP(bf16_t, WS_GG); float* LF = WSP(float, WS_LF); bf16_t* CQ = WSP(bf16_t, WS_CQ);
            if (sec == 4) {
#pragma unroll
                for (int ai = 0; ai < 2; ++ai)
#pragma unroll
                    for (int m = 0; m < 4; ++m) { bf16_t* rp = CQ + (size_t)(row0 + ai * 128 + m * 16) * XW + cl0;
#pragma unroll
                        for (int bj = 0; bj < 2; ++bj) { const f32x4 v0 = acc[ai][bj][m][0], v1 = acc[ai][bj][m][1]; u32x4 w; w.x = cvtpk(v0[0], v0[1]); w.y = cvtpk(v0[2], v0[3]); w.z = cvtpk(v1[0], v1[1]); w.w = cvtpk(v1[2], v1[3]);
                            *(u32x4*)(rp + bj * 128) = w; } }
            } else if (sec == 1) {
                const float* LBS = WSP(float, WS_LBS) + layer * HW + ct * 256 + cl0;
                f32x4 lb4[2][2];
#pragma unroll
                for (int bj = 0; bj < 2; ++bj) { lb4[bj][0] = *(const f32x4*)(LBS + bj * 128); lb4[bj][1] = *(const f32x4*)(LBS + bj * 128 + 4); }
#pragma unroll
                for (int ai = 0; ai < 2; ++ai)
#pragma unroll
                    for (int m = 0; m < 4; ++m) { const size_t ro = (size_t)(row0 + ai * 128 + m * 16) * HW + ct * 256 + cl0;
#pragma unroll
                        for (int bj = 0; bj < 2; ++bj) { float lf[8], kk[8];
#pragma unroll
                            for (int e = 0; e < 8; ++e) { const float z = e < 4 ? acc[ai][bj][m][0][e] : acc[ai][bj][m][1][e - 4];
                                const float t = fexp(-fabsf(z)), r = __builtin_amdgcn_rcpf(1.0f + t), big = r, small = t * r; const float sp = z >= 0.f ? big : small, sn = z >= 0.f ? small : big;
                                const float l1 = e < 4 ? lb4[bj][0][e] : lb4[bj][1][e - 4], f = l1 + (1.0f - l1) * sp, k = (1.0f - l1) * sn;
                                lf[e] = flog(f); kk[e] = k; }
                            *(f32x4*)(LF + ro + bj * 128) = (f32x4){lf[0], lf[1], lf[2], lf[3]}; *(f32x4*)(LF + ro + bj * 128 + 4) = (f32x4){lf[4], lf[5], lf[6], lf[7]};
                            u32x4 w; w.x = cvtpk(kk[0], kk[1]); w.y = cvtpk(kk[2], kk[3]); w.z = cvtpk(kk[4], kk[5]); w.w = cvtpk(kk[6], kk[7]);
                            *(u32x4*)(KK + ro + bj * 128) = w; } }
            } else {
                bf16_t* dst = sec == 0 ? QS : (sec == 2 ? VV : GG); const bool act = sec != 2;
#pragma unroll
                for (int ai = 0; ai < 2; ++ai)
#pragma unroll
                    for (int m = 0; m < 4; ++m) { bf16_t* rp = dst + (size_t)(row0 + ai * 128 + m * 16) * HW + ct * 256 + cl0;
#pragma unroll
                        for (int bj = 0; bj < 2; ++bj) { f32x4 v0 = acc[ai][bj][m][0], v1 = acc[ai][bj][m][1];
                            if (act) {
#pragma unroll
                                for (int e = 0; e < 4; ++e) { v0[e] = fsilu(v0[e]); v1[e] = fsilu(v1[e]); } }
                            u32x4 w; w.x = cvtpk(v0[0], v0[1]); w.y = cvtpk(v0[2], v0[3]); w.z = cvtpk(v1[0], v1[1]); w.w = cvtpk(v1[2], v1[3]);
                            *(u32x4*)(rp + bj * 128) = w; } }
            }
        } else {
            bf16_t* QR = WSP(bf16_t, WS_QS); bf16_t* CQ = WSP(bf16_t, WS_CQ); bf16_t* KR = WSP(bf16_t, WS_KR); bf16_t* VT = WSP(bf16_t, WS_VT);
            float* KSN = WSP(float, WS_KSN); float* VSN = WSP(float, WS_VSN); const f32x2* rope = WSP(f32x2, WS_ROPE);
            const int pn = u.pn;
#pragma unroll
            for (int ai = 0; ai < 2; ++ai)
#pragma unroll
                for (int m = 0; m < 4; ++m) { const int row = row0 + ai * 128 + m * 16; const int pos = row < MP ? (row & (SEQ - 1)) : SEQ; const int b = row >> 13, t = row & (SEQ - 1);
#pragma unroll
                    for (int bj = 0; bj < 2; ++bj) { const int cc = bj * 128 + cl0; f32x4 v0 = acc[ai][bj][m][0], v1 = acc[ai][bj][m][1];
                        if (pn == 3) { u32x4 w; w.x = cvtpk(v0[0], v0[1]); w.y = cvtpk(v0[2], v0[3]); w.z = cvtpk(v1[0], v1[1]); w.w = cvtpk(v1[2], v1[3]); *(u32x4*)(CQ + (size_t)row * XW + cc) = w; }
                        else if (pn == 5) {
                            const int kvh = cc >> 6, d = cc & 63;
                            if (row < MP) { bf16_t* vp = VT + ((size_t)((b * 4 + kvh) * 64 + d)) * KVP + 128 + t;
#pragma unroll
                                for (int e = 0; e < 4; ++e) { vp[(size_t)e * KVP] = f2bf(v0[e]); vp[(size_t)(e + 4) * KVP] = f2bf(v1[e]); }
                                if (t >= SEQ - 128) { float* op = out + O_SVP + ((size_t)(b * 128 + (t - (SEQ - 128))) * 4 + kvh) * 64 + d; *(f32x4*)op = v0; *(f32x4*)(op + 4) = v1; } }
                            else if (row < MP + BS) { const int bs = row - MP; float* op = out + O_SVS + ((size_t)(bs * 128 + 127) * 4 + kvh) * 64 + d; *(f32x4*)op = v0; *(f32x4*)(op + 4) = v1;
                                float* sp = VSN + (size_t)(bs * 4 + kvh) * 64 + d; *(f32x4*)sp = v0; *(f32x4*)(sp + 4) = v1; }
                        } else {
                            const int hh = cc >> 6, i0 = (cc & 63) >> 1; const f32x2* rp = rope + (size_t)pos * 32 + i0;
                            float o[8];
#pragma unroll
                            for (int p = 0; p < 4; ++p) { const f32x2 cs = rp[p]; const float x1 = p < 2 ? v0[2 * p] : v1[2 * p - 4], x2 = p < 2 ? v0[2 * p + 1] : v1[2 * p - 3];
                                o[2 * p] = x1 * cs.x - x2 * cs.y; o[2 * p + 1] = x2 * cs.x + x1 * cs.y; }
                            u32x4 w; w.x = cvtpk(o[0], o[1]); w.y = cvtpk(o[2], o[3]); w.z = cvtpk(o[4], o[5]); w.w = cvtpk(o[6], o[7]);
                            if (pn < 3) *(u32x4*)(QR + (size_t)row * HW + pn * 256 + cc) = w;
                            else {
                                if (row < MP) { *(u32x4*)(KR + ((size_t)(b * 4 + hh) * KVP + 128 + t) * 64 + (cc & 63)) = w;
                                    if (t >= SEQ - 128) { float* op = out + O_SKP + ((size_t)(b * 128 + (t - (SEQ - 128))) * 4 + hh) * 64;
#pragma unroll
                                        for (int p = 0; p < 4; ++p) { op[i0 + p] = o[2 * p]; op[i0 + p + 32] = o[2 * p + 1]; } } }
                                else if (row < MP + BS) { const int bs = row - MP; float* op = out + O_SKS + ((size_t)(bs * 128 + 127) * 4 + hh) * 64; float* sp = KSN + (size_t)(bs * 4 + hh) * 64;
#pragma unroll
                                    for (int p = 0; p < 4; ++p) { op[i0 + p] = o[2 * p]; op[i0 + p + 32] = o[2 * p + 1]; sp[i0 + p] = o[2 * p]; sp[i0 + p + 32] = o[2 * p + 1]; } }
                            }
                        } } }
        }
    }
};

__device__ __forceinline__ void norm_phase(Frame& F, const float* gpost, bool final_out) {
    unsigned char* ws = F.ws;
    const int gw = F.vcu * NWAVES + F.wave, NGW = F.G * NWAVES, lane = F.lane;
    float* H = WSP(float, WS_H); const float* Y = WSP(float, WS_Y); bf16_t* XN = WSP(bf16_t, WS_XN);
    f32x4 gp[4];
#pragma unroll
    for (int j = 0; j < 4; ++j) gp[j] = ((const f32x4*)gpost)[lane + 64 * j];
    for (int m = gw; m < MP + BS; m += NGW) {
        const f32x4* yr = (const f32x4*)(Y + (size_t)m * D) + lane; f32x4* hr = (f32x4*)(H + (size_t)m * D) + lane;
        f32x4 y[4], h[4]; float s = 0.f;
#pragma unroll
        for (int j = 0; j < 4; ++j) { y[j] = yr[64 * j]; h[j] = hr[64 * j]; s += (y[j].x * y[j].x + y[j].y * y[j].y) + (y[j].z * y[j].z + y[j].w * y[j].w); }
        const float rstd = rsqrtf(wave_sum(s) * (1.f / D) + EPS); float s2 = 0.f;
#pragma unroll
        for (int j = 0; j < 4; ++j) { h[j] = h[j] + y[j] * rstd * gp[j]; s2 += (h[j].x * h[j].x + h[j].y * h[j].y) + (h[j].z * h[j].z + h[j].w * h[j].w); }
        if (final_out) { f32x4* orow = (f32x4*)(m < MP ? F.out + O_YP + (size_t)m * D : F.out + O_YS + (size_t)(m - MP) * D) + lane;
#pragma unroll
            for (int j = 0; j < 4; ++j) orow[64 * j] = h[j];
        } else {
            const float rstd2 = rsqrtf(wave_sum(s2) * (1.f / D) + EPS);
            u32x2* o8 = (u32x2*)(XN + (size_t)m * D) + lane;
#pragma unroll
            for (int j = 0; j < 4; ++j) { hr[64 * j] = h[j]; u32x2 w; w.x = cvtpk(h[j].x * rstd2, h[j].y * rstd2); w.y = cvtpk(h[j].z * rstd2, h[j].w * rstd2); o8[64 * j] = w; }
        }
    }
}

constexpr int HL_TOT = 0;
constexpr int HL_KT = 2048;
constexpr int HL_VTT = HL_KT + 128 * 144;
constexpr int HL_QH = HL_VTT + 128 * 144;
constexpr int HL_QT = HL_QH + 64 * 272;
constexpr int HL_KTL = HL_QT + 64 * 272;
constexpr int HL_P = HL_KTL + 64 * 272;
constexpr int HL_RS = HL_P + 64 * 144;
constexpr int HL_END = HL_RS + 2048 + 256;
static_assert(HL_END <= RING_BYTES, "hgrn lds");

__device__ __forceinline__ f32x4 mfma16(bf16x8 a, bf16x8 b, f32x4 c) { return __builtin_amdgcn_mfma_f32_16x16x32_bf16(a, b, c, 0, 0, 0); }

__device__ __forceinline__ void hgrn_cumsum(Frame& F, const float* LFp  , float (&b)[16], float& btot, float& bmid, int ch, int tq) {
    LAS float* tot = (LAS float*)(F.lds + HL_TOT);
    float run = 0.f;
#pragma unroll
    for (int i = 0; i < 16; ++i) { run += LFp[(size_t)i * HW]; b[i] = run; }
    tot[tq * 128 + ch] = run;
    __syncthreads();
    const float t0 = tot[ch], t1 = tot[128 + ch], t2 = tot[256 + ch], t3 = tot[384 + ch];
    const float pre = tq == 0 ? 0.f : (tq == 1 ? t0 : (tq == 2 ? t0 + t1 : t0 + t1 + t2));
#pragma unroll
    for (int i = 0; i < 16; ++i) b[i] += pre;
    btot = (t0 + t1) + (t2 + t3); bmid = t0 + t1;
}
__device__ __forceinline__ void st16_lds(LAS unsigned char* p, const float (&v)[16]) {
    u32x4 w0, w1; w0.x = cvtpk(v[0], v[1]); w0.y = cvtpk(v[2], v[3]); w0.z = cvtpk(v[4], v[5]); w0.w = cvtpk(v[6], v[7]);
    w1.x = cvtpk(v[8], v[9]); w1.y = cvtpk(v[10], v[11]); w1.z = cvtpk(v[12], v[13]); w1.w = cvtpk(v[14], v[15]);
    *(LAS u32x4*)p = w0; *(LAS u32x4*)(p + 16) = w1;
}

__device__ __forceinline__ void hgrn_h1_unit(Frame& F, int unit) {
    unsigned char* ws = F.ws;
    const int bh = unit >> 7, c = unit & 127, b_ = bh / 6, h = bh % 6, row0 = b_ * SEQ + c * 64;
    const int tid = F.tid, ch = tid & 127, tq = tid >> 7, lane = F.lane, w = F.wave, fr = lane & 15, g = lane >> 4;
    const float* LF = WSP(float, WS_LF); const bf16_t* KK = WSP(bf16_t, WS_KK); const bf16_t* VV = WSP(bf16_t, WS_VV);
    const size_t e0 = (size_t)(row0 + tq * 16) * HW + h * 128 + ch;
    float bb[16], btot, bmid;
    hgrn_cumsum(F, LF + e0, bb, btot, bmid, ch, tq);
    float kh[16], vv[16];
#pragma unroll
    for (int i = 0; i < 16; ++i) { kh[i] = bf2f(KK[e0 + (size_t)i * HW]) * fexp(btot - bb[i]); vv[i] = bf2f(VV[e0 + (size_t)i * HW]); }
    st16_lds(F.lds + HL_KT + ch * 144 + tq * 32, kh);
    st16_lds(F.lds + HL_VTT + ch * 144 + tq * 32, vv);
    if (tq == 0) WSP(float, WS_AC)[(size_t)unit * 128 + ch] = fexp(btot);
    __syncthreads();
    bf16x8 af[2];
#pragma unroll
    for (int ks = 0; ks < 2; ++ks) af[ks] = *(const LAS bf16x8*)(F.lds + HL_VTT + (16 * w + fr) * 144 + ks * 64 + g * 16);
    float* UT = WSP(float, WS_UT) + (size_t)unit * 16384;
#pragma unroll
    for (int nb = 0; nb < 8; ++nb) { f32x4 acc = {0.f, 0.f, 0.f, 0.f};
#pragma unroll
        for (int ks = 0; ks < 2; ++ks) { const bf16x8 bf = *(const LAS bf16x8*)(F.lds + HL_KT + (16 * nb + fr) * 144 + ks * 64 + g * 16); acc = mfma16(af[ks], bf, acc); }
#pragma unroll
        for (int i = 0; i < 4; ++i) UT[(size_t)(16 * w + 4 * g + i) * 128 + 16 * nb + fr] = acc[i]; }
    __syncthreads();
}

__device__ __forceinline__ void hgrn_h2(Frame& F, int layer) {
    unsigned char* ws = F.ws;
    const int gt = F.vcu * NTHR + F.tid;
    if (gt >= 12 * 128 * 64) return;
    const int bh = gt >> 13, rem = gt & 8191, v = rem >> 6, ch2 = (rem & 63) * 2;
    const float* UT = WSP(float, WS_UT) + (size_t)bh * 128 * 16384 + v * 128 + ch2;
    const float* AC = WSP(float, WS_AC) + (size_t)bh * 128 * 128 + ch2;
    unsigned* ST = (unsigned*)(WSP(bf16_t, WS_ST) + (size_t)bh * 128 * 16384 + v * 128 + ch2);
    float s0 = 0.f, s1 = 0.f;
    for (int c = 0; c < 128; c += 8) {
        f32x2 u[8], a[8];
#pragma unroll
        for (int j = 0; j < 8; ++j) { u[j] = *(const f32x2*)(UT + (size_t)(c + j) * 16384); a[j] = *(const f32x2*)(AC + (size_t)(c + j) * 128); }
#pragma unroll
        for (int j = 0; j < 8; ++j) { s0 = a[j].x * s0 + u[j].x; s1 = a[j].y * s1 + u[j].y; ST[(size_t)(c + j) * 8192] = cvtpk(s0, s1); }
    }
    const int b_ = bh / 6, h = bh % 6;
    float* hp = F.out + O_HP + ((size_t)((layer * 2 + b_) * 6 + h)) * 16384;
    hp[(size_t)ch2 * 128 + v] = s0; hp[(size_t)(ch2 + 1) * 128 + v] = s1;
}

__device__ __forceinline__ void hgrn_h3_unit(Frame& F, int unit, int layer) {
    unsigned char* ws = F.ws;
    const int bh = unit >> 7, c = unit & 127, b_ = bh / 6, h = bh % 6, row0 = b_ * SEQ + c * 64;
    const int tid = F.tid, ch = tid & 127, tq = tid >> 7, lane = F.lane, w = F.wave, fr = lane & 15, g = lane >> 4;
    const float* LF = WSP(float, WS_LF); const bf16_t* KK = WSP(bf16_t, WS_KK); const bf16_t* VV = WSP(bf16_t, WS_VV); const bf16_t* QS = WSP(bf16_t, WS_QS); const bf16_t* GG = WSP(bf16_t, WS_GG);
    const size_t e0 = (size_t)(row0 + tq * 16) * HW + h * 128 + ch;
    float bb[16], btot, bmid;
    hgrn_cumsum(F, LF + e0, bb, btot, bmid, ch, tq);
    {
        float vv[16];
#pragma unroll
        for (int i = 0; i < 16; ++i) vv[i] = bf2f(VV[e0 + (size_t)i * HW]);
        st16_lds(F.lds + HL_VTT + ch * 144 + tq * 32, vv);
        LAS bf16_t* qh = (LAS bf16_t*)(F.lds + HL_QH); LAS bf16_t* qt = (LAS bf16_t*)(F.lds + HL_QT); LAS bf16_t* kt = (LAS bf16_t*)(F.lds + HL_KTL);
#pragma unroll
        for (int i = 0; i < 16; ++i) { const float q = bf2f(QS[e0 + (size_t)i * HW]), k = bf2f(KK[e0 + (size_t)i * HW]); const int tok = tq * 16 + i;
            const float d = bb[i] - bmid;
            qh[tok * 136 + ch] = f2bf(q * fexp(bb[i])); qt[tok * 136 + ch] = f2bf(q * fexp(fminf(d, 80.f))); kt[tok * 136 + ch] = f2bf(k * fexp(fminf(-d, 80.f))); }
    }
    __syncthreads();
    {
        const int tb = w >> 1;
#pragma unroll
        for (int q2 = 0; q2 < 2; ++q2) { const int sb = 2 * (w & 1) + q2; f32x4 acc = {0.f, 0.f, 0.f, 0.f};
            if (sb <= tb) {
#pragma unroll
                for (int ks = 0; ks < 4; ++ks) { const bf16x8 af = *(const LAS bf16x8*)(F.lds + HL_QT + (16 * tb + fr) * 272 + ks * 64 + g * 16);
                    const bf16x8 bf = *(const LAS bf16x8*)(F.lds + HL_KTL + (16 * sb + fr) * 272 + ks * 64 + g * 16); acc = mfma16(af, bf, acc); } }
            LAS bf16_t* P = (LAS bf16_t*)(F.lds + HL_P);
#pragma unroll
            for (int i = 0; i < 4; ++i) { const int t = 16 * tb + 4 * g + i, s = 16 * sb + fr; P[t * 72 + s] = f2bf((sb <= tb && s <= t) ? acc[i] : 0.f); } }
    }
    __syncthreads();
    f32x4 o[4];
#pragma unroll
    for (int tb = 0; tb < 4; ++tb) o[tb] = (f32x4){0.f, 0.f, 0.f, 0.f};
    if (c > 0) {
        const bf16_t* ST = WSP(bf16_t, WS_ST) + ((size_t)bh * 128 + (c - 1)) * 16384 + (size_t)(16 * w + fr) * 128;
#pragma unroll
        for (int ks = 0; ks < 4; ++ks) { const bf16x8 bf = *(const bf16x8*)(ST + ks * 32 + g * 8);
#pragma unroll
            for (int tb = 0; tb < 4; ++tb) { const bf16x8 af = *(const LAS bf16x8*)(F.lds + HL_QH + (16 * tb + fr) * 272 + ks * 64 + g * 16); o[tb] = mfma16(af, bf, o[tb]); } }
    }
#pragma unroll
    for (int ks = 0; ks < 2; ++ks) { const bf16x8 bf = *(const LAS bf16x8*)(F.lds + HL_VTT + (16 * w + fr) * 144 + ks * 64 + g * 16);
#pragma unroll
        for (int tb = 0; tb < 4; ++tb) { const bf16x8 af = *(const LAS bf16x8*)(F.lds + HL_P + (16 * tb + fr) * 144 + ks * 64 + g * 16); o[tb] = mfma16(af, bf, o[tb]); } }
    LAS float* RS = (LAS float*)(F.lds + HL_RS); LAS float* RSTD = (LAS float*)(F.lds + HL_RS + 2048);
#pragma unroll
    for (int tb = 0; tb < 4; ++tb)
#pragma unroll
        for (int i = 0; i < 4; ++i) { float s = o[tb][i] * o[tb][i]; s += __shfl_xor(s, 1); s += __shfl_xor(s, 2); s += __shfl_xor(s, 4); s += __shfl_xor(s, 8);
            if (fr == 0) RS[(16 * tb + 4 * g + i) * 8 + w] = s; }
    __syncthreads();
    if (tid < 64) { float s = 0.f;
#pragma unroll
        for (int j = 0; j < 8; ++j) s += RS[tid * 8 + j];
        RSTD[tid] = rsqrtf(s * (1.f / 128.f) + EPS); }
    __syncthreads();
    const int v = 16 * w + fr; const float gg = in_ptr(12)[layer * HW + h * 128 + v];
    bf16_t* MIX = WSP(bf16_t, WS_MIX);
#pragma unroll
    for (int tb = 0; tb < 4; ++tb)
#pragma unroll
        for (int i = 0; i < 4; ++i) { const int t = 16 * tb + 4 * g + i; const size_t r = (size_t)(row0 + t);
            MIX[r * D + h * 128 + v] = f2bf(o[tb][i] * RSTD[t] * gg * bf2f(GG[r * HW + h * 128 + v])); }
    __syncthreads();
}

__device__ __forceinline__ void hgrn_sample_unit(Frame& F, int unit, int layer) {
    unsigned char* ws = F.ws;
    const int bs = unit / 6, h = unit % 6, row = MP + bs, tid = F.tid, v4 = tid & 31, chg = tid >> 5;
    const float* LF = WSP(float, WS_LF); const bf16_t* KK = WSP(bf16_t, WS_KK); const bf16_t* VV = WSP(bf16_t, WS_VV); const bf16_t* QS = WSP(bf16_t, WS_QS); const bf16_t* GG = WSP(bf16_t, WS_GG);
    const size_t e0 = (size_t)row * HW + h * 128;
    const float* S0 = in_ptr(4) + ((size_t)(layer * BS + bs) * 6 + h) * 16384; float* SN = F.out + O_HS + ((size_t)(layer * BS + bs) * 6 + h) * 16384;
    f32x4 vv; { const u32x2 w = *(const u32x2*)(VV + e0 + 4 * v4); vv = (f32x4){bflo(w.x), bfhi(w.x), bflo(w.y), bfhi(w.y)}; }
    f32x4 oacc = {0.f, 0.f, 0.f, 0.f};
#pragma unroll
    for (int i = 0; i < 8; ++i) { const int ch = chg + 16 * i; const float f = fexp(LF[e0 + ch]), k = bf2f(KK[e0 + ch]), q = bf2f(QS[e0 + ch]);
        const f32x4 s0 = *(const f32x4*)(S0 + (size_t)ch * 128 + 4 * v4); const f32x4 sn = s0 * f + vv * k; *(f32x4*)(SN + (size_t)ch * 128 + 4 * v4) = sn; oacc = oacc + sn * q; }
    LAS float* red = (LAS float*)F.lds;
    *(LAS f32x4*)(red + chg * 128 + 4 * v4) = oacc;
    __syncthreads();
    if (tid < 128) { float o = 0.f;
#pragma unroll
        for (int j = 0; j < 16; ++j) o += red[j * 128 + tid];
        float ss = wave_sum(o * o); LAS float* part = red + 2048; if (F.lane == 0) part[F.wave] = ss;
        red[2064 + tid] = o; }
    __syncthreads();
    if (tid < 128) { const float ss = red[2048] + red[2049]; const float rstd = rsqrtf(ss * (1.f / 128.f) + EPS); const float o = red[2064 + tid];
        WSP(bf16_t, WS_MIX)[(size_t)row * D + h * 128 + tid] = f2bf(o * rstd * in_ptr(12)[layer * HW + h * 128 + tid] * bf2f(GG[e0 + tid])); }
    __syncthreads();
}

template <int NKB, bool SWA>
__device__ __forceinline__ void attn16(const bf16_t* Qrow0, int q_ld, const bf16_t* Kb, const bf16_t* VTb, int ldv, bf16_t* Orow0, int o_ld, float sink2, bool has_sink, int t0, int lane) {
    constexpr int NKS = (NKB + 1) / 2, NKP = 2 * NKS;
    const int fr = lane & 15, g = lane >> 4;
    bf16x8 qf[2];
#pragma unroll
    for (int ks = 0; ks < 2; ++ks) qf[ks] = *(const bf16x8*)(Qrow0 + (size_t)fr * q_ld + ks * 32 + g * 8);
    f32x4 s[NKP];
#pragma unroll
    for (int blk = 0; blk < NKP; ++blk) { s[blk] = (f32x4){0.f, 0.f, 0.f, 0.f};
        if (blk < NKB) {
#pragma unroll
            for (int ks = 0; ks < 2; ++ks) { const bf16x8 kf = *(const bf16x8*)(Kb + (size_t)(16 * blk + fr) * 64 + ks * 32 + g * 8); s[blk] = mfma16(kf, qf[ks], s[blk]); } } }
    float m = -1e30f;
    if (SWA) { const int lo = max(fr + 1, 128 - t0), hi = fr + 128;
#pragma unroll
        for (int blk = 0; blk < NKP; ++blk)
#pragma unroll
            for (int i = 0; i < 4; ++i) { const int kidx = 16 * blk + 4 * g + i; if (blk >= NKB || kidx < lo || kidx > hi) s[blk][i] = -1e30f; } }
#pragma unroll
    for (int blk = 0; blk < NKB; ++blk)
#pragma unroll
        for (int i = 0; i < 4; ++i) m = fmaxf(m, s[blk][i]);
    m = fmaxf(m, __shfl_xor(m, 16)); m = fmaxf(m, __shfl_xor(m, 32));
    if (has_sink) m = fmaxf(m, sink2);
    float l = 0.f;
#pragma unroll
    for (int blk = 0; blk < NKP; ++blk)
#pragma unroll
        for (int i = 0; i < 4; ++i) { const float p = (blk < NKB) ? __builtin_amdgcn_exp2f(s[blk][i] - m) : 0.f; s[blk][i] = p; l += p; }
    l += __shfl_xor(l, 16); l += __shfl_xor(l, 32);
    if (has_sink) l += __builtin_amdgcn_exp2f(sink2 - m);
    const float inv = 1.0f / l;
    f32x4 o[4];
#pragma unroll
    for (int db = 0; db < 4; ++db) o[db] = (f32x4){0.f, 0.f, 0.f, 0.f};
#pragma unroll
    for (int ks = 0; ks < NKS; ++ks) {
        u32x4 pw; pw.x = cvtpk(s[2 * ks][0], s[2 * ks][1]); pw.y = cvtpk(s[2 * ks][2], s[2 * ks][3]); pw.z = cvtpk(s[2 * ks + 1][0], s[2 * ks + 1][1]); pw.w = cvtpk(s[2 * ks + 1][2], s[2 * ks + 1][3]);
        const bf16x8 pf = __builtin_bit_cast(bf16x8, pw);
#pragma unroll
        for (int db = 0; db < 4; ++db) { const bf16_t* vp = VTb + (size_t)(16 * db + fr) * ldv + 32 * ks + 4 * g;
            const u32x2 lo = *(const u32x2*)vp, hi = *(const u32x2*)(vp + 16); u32x4 vw; vw.x = lo.x; vw.y = lo.y; vw.z = hi.x; vw.w = hi.y;
            o[db] = mfma16(__builtin_bit_cast(bf16x8, vw), pf, o[db]); } }
#pragma unroll
    for (int db = 0; db < 4; ++db) { u32x2 w; w.x = cvtpk(o[db][0] * inv, o[db][1] * inv); w.y = cvtpk(o[db][2] * inv, o[db][3] * inv);
        *(u32x2*)(Orow0 + (size_t)fr * o_ld + 16 * db + 4 * g) = w; }
}

__device__ __forceinline__ void memattn_prompt(Frame& F, int layer) {
    unsigned char* ws = F.ws;
    const int gw = F.vcu * NWAVES + F.wave, NGW = F.G * NWAVES;
    const bf16_t* CQ = WSP(bf16_t, WS_CQ); bf16_t* MIX = WSP(bf16_t, WS_MIX);
    for (int u = gw; u < 2 * 4 * 512; u += NGW) { const int qb = u & 511, h = (u >> 9) & 3, b = u >> 11; const int row0 = b * SEQ + qb * 16;
        const bf16_t* Kb = WSP(bf16_t, WS_MKB) + (size_t)((layer * 2 + b) * 4 + h) * 256 * 64; const bf16_t* Vb = WSP(bf16_t, WS_MVT) + (size_t)((layer * 2 + b) * 4 + h) * 64 * 256;
        attn16<16, false>(CQ + (size_t)row0 * XW + h * 64, XW, Kb, Vb, 256, MIX + (size_t)row0 * D + HW + h * 64, D, 0.f, false, 0, F.lane); }
}
__device__ __forceinline__ void swa_prompt(Frame& F, int j) {
    unsigned char* ws = F.ws;
    const int gw = F.vcu * NWAVES + F.wave, NGW = F.G * NWAVES;
    const bf16_t* QR = WSP(bf16_t, WS_QS); bf16_t* MIX = WSP(bf16_t, WS_MIX);
    for (int u = gw; u < 2 * 4 * 512; u += NGW) { const int qb = u & 511, kvh = (u >> 9) & 3, b = u >> 11; const int t0 = qb * 16, row0 = b * SEQ + t0;
        const bf16_t* Kb = WSP(bf16_t, WS_KR) + ((size_t)(b * 4 + kvh) * KVP + t0) * 64; const bf16_t* Vb = WSP(bf16_t, WS_VT) + (size_t)(b * 4 + kvh) * 64 * KVP + t0;
#pragma unroll 1
        for (int gi = 0; gi < 3; ++gi) { const int hq = kvh * 3 + gi;
            attn16<9, true>(QR + (size_t)row0 * HW + hq * 64, HW, Kb, Vb, KVP, MIX + (size_t)row0 * D + hq * 64, D, in_ptr(14)[j * 12 + hq] * LOG2E, true, t0, F.lane); } }
}

__device__ __forceinline__ void memattn_sample(Frame& F, int layer) {
    unsigned char* ws = F.ws;
    const int gw = F.vcu * NWAVES + F.wave, NGW = F.G * NWAVES, lane = F.lane;
    LAS float* sc = (LAS float*)(F.lds + F.wave * 4096);
    const bf16_t* CQ = WSP(bf16_t, WS_CQ); bf16_t* MIX = WSP(bf16_t, WS_MIX);
    for (int u = gw; u < BS * 4; u += NGW) { const int bs = u >> 2, h = u & 3, row = MP + bs;
        sc[lane] = bf2f(CQ[(size_t)row * XW + h * 64 + lane]);
        LDS_WAIT();
        const float* Kc = in_ptr(2) + ((size_t)(layer * BS + bs) * 256) * 256 + h * 64; const float* Vc = in_ptr(3) + ((size_t)(layer * BS + bs) * 256) * 256 + h * 64;
        float s[4] = {0.f, 0.f, 0.f, 0.f};
#pragma unroll 4
        for (int d4 = 0; d4 < 16; ++d4) { const f32x4 q = *(const LAS f32x4*)(sc + 4 * d4);
#pragma unroll
            for (int i = 0; i < 4; ++i) { const f32x4 k = *(const f32x4*)(Kc + (size_t)(lane + 64 * i) * 256 + 4 * d4); s[i] += (k.x * q.x + k.y * q.y) + (k.z * q.z + k.w * q.w); } }
        float m = fmaxf(fmaxf(s[0], s[1]), fmaxf(s[2], s[3]));
#pragma unroll
        for (int o = 1; o < 64; o <<= 1) m = fmaxf(m, __shfl_xor(m, o));
        float l = 0.f;
#pragma unroll
        for (int i = 0; i < 4; ++i) { s[i] = __builtin_amdgcn_exp2f(s[i] - m); l += s[i]; sc[64 + lane + 64 * i] = s[i]; }
        l = wave_sum(l);
        LDS_WAIT();
        float o = 0.f;
#pragma unroll 8
        for (int mm = 0; mm < 256; ++mm) o += sc[64 + mm] * Vc[(size_t)mm * 256 + lane];
        MIX[(size_t)row * D + HW + h * 64 + lane] = f2bf(o / l);
        LDS_WAIT();
    }
}

__device__ __forceinline__ void swa_sample(Frame& F, int j) {
    unsigned char* ws = F.ws;
    const int gw = F.vcu * NWAVES + F.wave, NGW = F.G * NWAVES, lane = F.lane;
    LAS float* sc = (LAS float*)(F.lds + F.wave * 4096);
    const bf16_t* QR = WSP(bf16_t, WS_QS); bf16_t* MIX = WSP(bf16_t, WS_MIX);
    const float* KSN = WSP(float, WS_KSN); const float* VSN = WSP(float, WS_VSN);
    for (int u = gw; u < BS * 4; u += NGW) { const int bs = u >> 2, kvh = u & 3, row = MP + bs;
        const int pd = 2 * (lane & 31) + (lane >> 5);
#pragma unroll
        for (int gi = 0; gi < 3; ++gi) sc[gi * 64 + lane] = bf2f(QR[(size_t)row * HW + (kvh * 3 + gi) * 64 + pd]);
        LDS_WAIT();
        float s[3][2];
#pragma unroll
        for (int kk = 0; kk < 2; ++kk) { const int key = lane + 64 * kk;
            const float* kp = key < 127 ? in_ptr(5) + ((size_t)(bs * 128 + key + 1) * 4 + kvh) * 64 : KSN + (size_t)(bs * 4 + kvh) * 64;
            float* ko = F.out + O_SKS + ((size_t)(bs * 128 + key) * 4 + kvh) * 64;
            float a0 = 0.f, a1 = 0.f, a2 = 0.f;
#pragma unroll 4
            for (int d4 = 0; d4 < 16; ++d4) { const f32x4 k = *(const f32x4*)(kp + 4 * d4); if (j == 0 && key < 127) *(f32x4*)(ko + 4 * d4) = k;
                const f32x4 q0 = *(const LAS f32x4*)(sc + 4 * d4), q1 = *(const LAS f32x4*)(sc + 64 + 4 * d4), q2 = *(const LAS f32x4*)(sc + 128 + 4 * d4);
                a0 += (k.x * q0.x + k.y * q0.y) + (k.z * q0.z + k.w * q0.w); a1 += (k.x * q1.x + k.y * q1.y) + (k.z * q1.z + k.w * q1.w); a2 += (k.x * q2.x + k.y * q2.y) + (k.z * q2.z + k.w * q2.w); }
            s[0][kk] = a0; s[1][kk] = a1; s[2][kk] = a2; }
        float linv[3];
#pragma unroll
        for (int gi = 0; gi < 3; ++gi) { const float sink2 = in_ptr(14)[j * 12 + kvh * 3 + gi] * LOG2E; float m = fmaxf(s[gi][0], s[gi][1]);
#pragma unroll
            for (int o = 1; o < 64; o <<= 1) m = fmaxf(m, __shfl_xor(m, o));
            m = fmaxf(m, sink2);
            const float p0 = __builtin_amdgcn_exp2f(s[gi][0] - m), p1 = __builtin_amdgcn_exp2f(s[gi][1] - m);
            sc[192 + gi * 128 + lane] = p0; sc[192 + gi * 128 + 64 + lane] = p1;
            linv[gi] = 1.0f / (wave_sum(p0 + p1) + __builtin_amdgcn_exp2f(sink2 - m)); }
        LDS_WAIT();
        float o0 = 0.f, o1 = 0.f, o2 = 0.f;
#pragma unroll 4
        for (int key = 0; key < 128; ++key) { const float v = key < 127 ? in_ptr(6)[((size_t)(bs * 128 + key + 1) * 4 + kvh) * 64 + lane] : VSN[(size_t)(bs * 4 + kvh) * 64 + lane];
            if (j == 0 && key < 127) F.out[O_SVS + ((size_t)(bs * 128 + key) * 4 + kvh) * 64 + lane] = v;
            o0 += sc[192 + key] * v; o1 += sc[192 + 128 + key] * v; o2 += sc[192 + 256 + key] * v; }
        MIX[(size_t)row * D + (kvh * 3 + 0) * 64 + lane] = f2bf(o0 * linv[0]);
        MIX[(size_t)row * D + (kvh * 3 + 1) * 64 + lane] = f2bf(o1 * linv[1]);
        MIX[(size_t)row * D + (kvh * 3 + 2) * 64 + lane] = f2bf(o2 * linv[2]);
        LDS_WAIT();
    }
}

enum { OP_PROLOGUE = 0, OP_GEMM, OP_MIXA, OP_H2, OP_H3, OP_MIXB, OP_NORM };
struct Phase { int op, layer; unsigned long long aoff, boff; int M, N, K, ekind, cshift, nobar; };
#define PH_GEMM(l, A, B, M, N, K, ek, cs, nb) {OP_GEMM, l, A, B, M, N, K, ek, cs, nb}
#define PH_MLP(l) PH_GEMM(l, WS_MIX, WS_WOUT + (size_t)(l) * 2097152, MT, D, D, EK_F32, 0, 0), {OP_NORM, l, 0, 0, 0, 0, 0, 19, 0, 0}, \
    PH_GEMM(l, WS_XN, WS_WUP + (size_t)(l) * 8388608, MT, FF, D, EK_UP, 0, 0), PH_GEMM(l, WS_HB, WS_WDN + (size_t)(l) * 8388608, MT, D, FF, EK_F32, 0, 0), {OP_NORM, l, 0, 0, (l) == 3, 0, 0, 21, 0, 0}
__constant__ Phase c_prog[] = {
    {OP_PROLOGUE, 0, 0, 0, 0, 0, 0, 0, 0, 0},
    PH_GEMM(0, WS_MN, WS_WMEM, 512, 2048, D, EK_MEMKV, 16, 1),
    PH_GEMM(0, WS_XN, WS_WINA, MT, NA, D, EK_INA, 0, 0),
    {OP_MIXA, 0, 0, 0, 0, 0, 0, 0, 0, 0}, {OP_H2, 0, 0, 0, 0, 0, 0, 0, 0, 0}, {OP_H3, 0, 0, 0, 0, 0, 0, 0, 0, 0}, PH_MLP(0),
    PH_GEMM(1, WS_XN, WS_WINA + SZ_WINA, MT, NA, D, EK_INA, 0, 0),
    {OP_MIXA, 1, 0, 0, 0, 0, 0, 0, 0, 0}, {OP_H2, 1, 0, 0, 0, 0, 0, 0, 0, 0}, {OP_H3, 1, 0, 0, 0, 0, 0, 0, 0, 0}, PH_MLP(1),
    PH_GEMM(0, WS_XN, WS_WINB0, MT, 1536, D, EK_INB, 0, 0),
    {OP_MIXB, 2, 0, 0, 0, 0, 0, 0, 0, 0}, PH_MLP(2),
    PH_GEMM(1, WS_XN, WS_WINB1, MT, 1024, D, EK_INB, 0, 0),
    {OP_MIXB, 3, 0, 0, 0, 0, 0, 0, 0, 0}, PH_MLP(3),
};
constexpr int NPHASE = sizeof(c_prog) / sizeof(Phase);

__global__ void __launch_bounds__(NTHR, 2) yoco_fwd(Args args) {
    extern __shared__ __attribute__((aligned(16))) unsigned char lds_raw[];
    Frame F;
    F.lds = (LAS unsigned char*)lds_raw;
    F.tid = threadIdx.x; F.lane = F.tid & 63; F.wave = __builtin_amdgcn_readfirstlane(F.tid >> 6);
    F.G = gridDim.x; { const int bx = blockIdx.x; F.vcu = (F.G % 8 == 0) ? (bx % 8) * (F.G / 8) + bx / 8 : bx; }
    F.ws = args.ws; F.out = args.out;
    unsigned char* ws = F.ws;
    for (int u = F.tid; u < (LDS_BYTES - LDSCTL_OFF) / 4; u += NTHR) ((LAS unsigned*)(F.lds + LDSCTL_OFF))[u] = 0u;
    __syncthreads();
    XcdBarrier bar = xcd_barrier_post((unsigned*)(ws + WS_CTL) + 4096, (volatile LAS unsigned*)(F.lds + MISC_OFF) + 8);
#define GRID_BAR() xcd_barrier(bar)
    const int G = F.G, bx = blockIdx.x;

#pragma unroll 1
    for (int ph = 0; ph < NPHASE; ++ph) {
        const Phase P = c_prog[ph];
        const int l = P.layer;
        { int t_ = threadIdx.x; asm volatile("" : "+v"(t_)); F.tid = t_; F.lane = t_ & 63; F.wave = __builtin_amdgcn_readfirstlane(t_ >> 6); }
        switch (P.op) {
        case OP_PROLOGUE: p0_prologue(F); break;
        case OP_GEMM: {
            pg8::Gemm g{(const bf16_t*)(ws + P.aoff), (const bf16_t*)(ws + P.boff), P.M, P.N, P.K}; pg8::StaticOrder S; S.init(P.M, P.N, G, (bx + P.cshift) % G);
            Epi E{P.ekind, l, F.ws, F.out}; pg8::gemm_phase(F.lds, g, S, E, F.tid);
        } break;
        case OP_MIXA:
            for (int u = F.vcu; u < 1536; u += G) hgrn_h1_unit(F, u);
            for (int u = F.vcu; u < BS * 6; u += G) hgrn_sample_unit(F, u, l);
            memattn_prompt(F, l);
            memattn_sample(F, l);
            break;
        case OP_H2: hgrn_h2(F, l); break;
        case OP_H3: for (int u = F.vcu; u < 1536; u += G) hgrn_h3_unit(F, u, l); break;
        case OP_MIXB:
            swa_prompt(F, l - 2);
            swa_sample(F, l - 2);
            memattn_prompt(F, l);
            memattn_sample(F, l);
            break;
        case OP_NORM: norm_phase(F, in_ptr(P.ekind) + l * D, P.M != 0); break;
        default: break;
        }
        if (!P.nobar) GRID_BAR();
    }
}

extern "C" void kernel_launch(void* const* d_in, const int* in_sizes, int n_in, void* d_out, int out_size, void* d_ws, size_t ws_size, hipStream_t stream) {
    static int grid = 0;
    if (grid == 0) {
        if (n_in != 24 || (size_t)out_size != O_END || ws_size < WS_END) { fprintf(stderr, "kernel_launch: unexpected shapes: n_in %d out %d ws %zu (need %zu)\n", n_in, out_size, ws_size, (size_t)WS_END); grid = -1; return; }
        int dev = 0, cus = 0, per_cu = 0;
        if (hipGetDevice(&dev) != hipSuccess || hipDeviceGetAttribute(&cus, hipDeviceAttributeMultiprocessorCount, dev) != hipSuccess) { grid = -1; return; }
        if (hipFuncSetAttribute((const void*)yoco_fwd, hipFuncAttributeMaxDynamicSharedMemorySize, LDS_BYTES) != hipSuccess) { fprintf(stderr, "kernel_launch: hipFuncSetAttribute failed\n"); grid = -1; return; }
        if (hipOccupancyMaxActiveBlocksPerMultiprocessor(&per_cu, (const void*)yoco_fwd, NTHR, LDS_BYTES) != hipSuccess || per_cu < 1) { fprintf(stderr, "kernel_launch: occupancy query says %d blocks per CU\n", per_cu); (void)hipGetLastError(); grid = -1; return; }
        grid = cus;
    }
    if (grid < 0) return;
    (void)hipMemsetAsync((char*)d_ws + WS_CTL, 0, CTL_BYTES, stream);
    Args a{};
    for (int i = 0; i < 24; ++i) a.in[i] = (const float*)d_in[i];
    a.out = (float*)d_out; a.ws = (unsigned char*)d_ws;
    void* params[] = {&a};
    hipError_t e = hipLaunchCooperativeKernel((const void*)yoco_fwd, dim3(grid), dim3(NTHR), params, LDS_BYTES, stream);
    if (e != hipSuccess) fprintf(stderr, "kernel_launch: cooperative launch failed: %s (grid %d)\n", hipGetErrorString(e), grid);
}
```

```cpp
#include <hip/hip_runtime.h>
#include <cstdio>
#include <cstdint>

#define LAS __attribute__((address_space(3)))
#define GAS __attribute__((address_space(1)))
typedef unsigned short bf16_t;
typedef short bf16x8 __attribute__((ext_vector_type(8)));
typedef short s16x4 __attribute__((ext_vector_type(4)));
typedef float f32x4 __attribute__((ext_vector_type(4)));
typedef float f32x2 __attribute__((ext_vector_type(2)));
typedef unsigned u32x4 __attribute__((ext_vector_type(4)));
typedef unsigned u32x2 __attribute__((ext_vector_type(2)));
typedef __bf16 bf16x2_t __attribute__((ext_vector_type(2)));

constexpr int D = 1024, SEQ = 8192, BP = 2, MP = BP * SEQ, BS = 128, MT = 16640  ;
constexpr int FF = 4096, NA = 3328, HW = 768, XW = 256, NMEM = 256;
constexpr int KVP = 128 + SEQ + 32;
constexpr float QSCALE = 0.18033688011112042f;
constexpr float LOG2E = 1.4426950408889634f;
constexpr float EPS = 1e-6f;
constexpr int NWAVES = 8, NTHR = 512;

constexpr size_t O_YP = 0, O_YS = O_YP + (size_t)MP * D, O_MK = O_YS + (size_t)BS * D, O_MV = O_MK + 524288, O_HP = O_MV + 524288,
                 O_SKP = O_HP + 393216, O_SVP = O_SKP + 65536, O_HS = O_SVP + 65536, O_SKS = O_HS + 25165824, O_SVS = O_SKS + 4194304, O_END = O_SVS + 4194304;

constexpr size_t al256(size_t x) { return (x + 255) & ~(size_t)255; }
constexpr size_t WS_CTL = 0, CTL_BYTES = 1u << 20;
constexpr size_t WS_WMEM = WS_CTL + CTL_BYTES;
constexpr size_t WS_WINA = WS_WMEM + (size_t)2048 * 1024 * 2;
constexpr size_t SZ_WINA = (size_t)NA * 1024 * 2;
constexpr size_t WS_WINB0 = WS_WINA + 2 * SZ_WINA;
constexpr size_t WS_WINB1 = WS_WINB0 + (size_t)1536 * 1024 * 2;
constexpr size_t WS_WOUT = WS_WINB1 + (size_t)1024 * 1024 * 2;
constexpr size_t WS_WUP = WS_WOUT + (size_t)4 * 1024 * 1024 * 2;
constexpr size_t WS_WDN = WS_WUP + (size_t)4 * 4096 * 1024 * 2;
constexpr size_t WS_H = WS_WDN + (size_t)4 * 4096 * 1024 * 2;
constexpr size_t WS_XN = WS_H + (size_t)MT * D * 4;
constexpr size_t WS_MN = WS_XN + (size_t)MT * D * 2;
constexpr size_t WS_ROPE = WS_MN + (size_t)512 * D * 2;
constexpr size_t WS_MKB = al256(WS_ROPE + (size_t)8193 * 32 * 8);
constexpr size_t WS_MVT = WS_MKB + (size_t)4 * 2 * 4 * 256 * 64 * 2;
constexpr size_t WS_KR = WS_MVT + (size_t)4 * 2 * 4 * 256 * 64 * 2;
constexpr size_t WS_VT = WS_KR + (size_t)2 * 4 * KVP * 64 * 2;
constexpr size_t WS_KSN = WS_VT + (size_t)2 * 4 * KVP * 64 * 2;
constexpr size_t WS_VSN = WS_KSN + (size_t)128 * 256 * 4;
constexpr size_t WS_ASEG = WS_VSN + (size_t)128 * 256 * 4;
constexpr size_t WS_LBS = WS_ASEG + (size_t)12 * 16 * 128 * 4;
constexpr size_t WS_OV = al256(WS_LBS + (size_t)2 * 768 * 4);
constexpr size_t WS_MIX = WS_OV;
constexpr size_t WS_Y = WS_MIX + (size_t)MT * D * 2;
constexpr size_t WS_HB = WS_Y + (size_t)MT * D * 4;
constexpr size_t WS_QS = WS_MIX + (size_t)MT * D * 2;
constexpr size_t SZ_P768 = (size_t)MT * HW * 2;
constexpr size_t WS_KK = WS_QS + SZ_P768, WS_VV = WS_KK + SZ_P768, WS_GG = WS_VV + SZ_P768;
constexpr size_t WS_LF = WS_GG + SZ_P768;
constexpr size_t WS_CQ = WS_LF + (size_t)MT * HW * 4;
constexpr size_t WS_USEG = WS_CQ + (size_t)MT * XW * 2;
constexpr size_t WS_SST = WS_USEG + (size_t)12 * 16 * 16384 * 4;
constexpr size_t WS_END_A = WS_SST + (size_t)12 * 16 * 16384 * 4;
constexpr size_t WS_END_B = WS_HB + (size_t)MT * FF * 2;
constexpr size_t WS_END = WS_END_A > WS_END_B ? WS_END_A : WS_END_B;

constexpr int RING_BYTES = 131072, LDSCTL_OFF = RING_BYTES, MISC_OFF = LDSCTL_OFF + 320, LDS_BYTES = 147456;

__device__ __forceinline__ unsigned cvtpk(float lo, float hi) { f32x2 v = {lo, hi}; bf16x2_t b = __builtin_convertvector(v, bf16x2_t); return __builtin_bit_cast(unsigned, b); }
__device__ __forceinline__ bf16_t f2bf(float f) { return (bf16_t)(cvtpk(f, 0.f) & 0xffffu); }
__device__ __forceinline__ float bf2f(bf16_t x) { return __uint_as_float((unsigned)x << 16); }
__device__ __forceinline__ float bflo(unsigned w) { return __uint_as_float(w << 16); }
__device__ __forceinline__ float bfhi(unsigned w) { return __uint_as_float(w & 0xffff0000u); }
__device__ __forceinline__ float wave_sum(float v) {
#pragma unroll
    for (int o = 1; o < 64; o <<= 1) v += __shfl_xor(v, o);
    return v;
}
__device__ __forceinline__ float fexp(float x) { return __builtin_amdgcn_exp2f(x * 1.4426950408889634f); }
__device__ __forceinline__ float flog(float x) { return __builtin_amdgcn_logf(x) * 0.6931471805599453f; }
__device__ __forceinline__ float fsigmoid(float x) { return __builtin_amdgcn_rcpf(1.0f + fexp(-x)); }
__device__ __forceinline__ float fsilu(float x) { return x * __builtin_amdgcn_rcpf(1.0f + fexp(-x)); }
#define LDS_WAIT() asm volatile("s_waitcnt lgkmcnt(0)" ::: "memory")
#define VM_WAIT() asm volatile("s_waitcnt vmcnt(0)" ::: "memory")

struct Args { const float* in[24]; float* out; unsigned char* ws; };
typedef const float* cfptr_t;
__device__ __forceinline__ const float* in_ptr(int i) { return ((const __attribute__((address_space(4))) cfptr_t*)__builtin_amdgcn_kernarg_segment_ptr())[i]; }

namespace pg8 {
constexpr int BM = 256, BK = 64, HALF = 128, HTB = HALF * BK * 2, STAGE_BYTES = 8 * HTB, NXCD = 8, WGM = 8;
__host__ __device__ __forceinline__ int lds_byte(int r, int c) { const int st = (r >> 4) * 2 + (c >> 5), rr = r & 15, cc = c & 31, ob = rr * 64 + cc * 2; return st * 1024 + (ob ^ (((ob >> 9) & 1) << 5)); }
__host__ __device__ __forceinline__ void stage_rc(int b, int& R, int& C) { const int st = b / 1024, sb = b % 1024, swz = sb ^ (((sb >> 9) & 1) << 5); R = (st >> 1) * 16 + swz / 64; C = (st & 1) * 32 + (swz % 64) / 2; }
__host__ __device__ __forceinline__ int perm32(int rho) { const int n = rho >> 4, i = rho & 15; return 8 * (i >> 2) + 4 * n + (i & 3); }
struct Unit { int pm, pn; };
struct Gemm { const bf16_t* A; const bf16_t* Bt; int M, N, K; };
struct StaticOrder {
    int nM, nN, nwg, G, c;
    __device__ void init(int M, int N, int G_, int c_) { nM = M / BM; nN = N / BM; nwg = nM * nN; G = G_; c = c_; }
    __device__ bool next(int i, Unit& u) const {
        const long L = (long)i * G + c; if (L >= nwg) return false;
        int wgid = (int)L; { const int q = nwg / NXCD, r = nwg % NXCD, xcd = wgid % NXCD, off = wgid / NXCD; wgid = (xcd < r ? xcd * (q + 1) : r * (q + 1) + (xcd - r) * q) + off; }
        const int nig = WGM * nN, gid = wgid / nig, fm = gid * WGM, gsz = (nM - fm) < WGM ? (nM - fm) : WGM;
        u.pm = fm + ((wgid % nig) % gsz); u.pn = (wgid % nig) / gsz; return true;
    }
};

template <class Epi>
__device__ __forceinline__ void gemm_phase(LAS unsigned char* lds, const Gemm g, const StaticOrder& S, const Epi& E, const int tid) {
    const int wid = __builtin_amdgcn_readfirstlane(tid >> 6), lane = tid & 63, wr = wid >> 2, wc = wid & 3, fr = lane & 15, fq = lane >> 4;
    const int K = g.K, nt = K / BK;
    unsigned voffA[2], voffB[2];
#pragma unroll
    for (int i = 0; i < 2; ++i) { int R, C; stage_rc(tid * 16 + i * 8192, R, C); const int Rb = (R & ~31) + perm32(R & 31);
        voffA[i] = (unsigned)(R * K + C) * 2u; voffB[i] = (unsigned)(Rb * K + C) * 2u; }
    const size_t kstep = (size_t)(BK * 2);
    const size_t hstep = (size_t)HALF * K * 2;
    const size_t tstep = 2 * hstep;
    const unsigned ldsw = (unsigned)wid * 1024u;
    const int aoff = lds_byte(wr * 64 + fr, fq * 8), boff = lds_byte(wc * 32 + fr, fq * 8);
#define PG8_SA(b, h) (((b) * 2 + (h)) * HTB)
#define PG8_SB(b, h) ((4 + (b) * 2 + (h)) * HTB)
#define PG8_STAGE(bufoff, gbase, voff) do { _Pragma("unroll") for (int _i = 0; _i < 2; ++_i) \
        __builtin_amdgcn_global_load_lds((const unsigned*)((const char*)(gbase) + (voff)[_i]), (LAS unsigned*)(lds + (bufoff) + ldsw + _i * 8192), 16, 0, 0); } while (0)
#define PG8_LDA(dst, b, h) do { _Pragma("unroll") for (int m = 0; m < 4; ++m) _Pragma("unroll") for (int k = 0; k < 2; ++k) dst[m][k] = *(const LAS bf16x8*)(lds + PG8_SA(b, h) + aoff + m * 2048 + k * 1024); } while (0)
#define PG8_LDB(dst, b, h) do { _Pragma("unroll") for (int n = 0; n < 2; ++n) _Pragma("unroll") for (int k = 0; k < 2; ++k) dst[n][k] = *(const LAS bf16x8*)(lds + PG8_SB(b, h) + boff + n * 2048 + k * 1024); } while (0)
#define PG8_MMA(ai, bj, At, Bt) do { __builtin_amdgcn_s_setprio(1); _Pragma("unroll") for (int m = 0; m < 4; ++m) _Pragma("unroll") for (int n = 0; n < 2; ++n) _Pragma("unroll") for (int k = 0; k < 2; ++k) \
        acc[ai][bj][m][n] = __builtin_amdgcn_mfma_f32_16x16x32_bf16(Bt[n][k], At[m][k], acc[ai][bj][m][n], 0, 0, 0); __builtin_amdgcn_s_setprio(0); } while (0)
#define PG8_WAIT_V(n) asm volatile("s_waitcnt vmcnt(" #n ")" ::: "memory")
#define PG8_WAIT_L(n) asm volatile("s_waitcnt lgkmcnt(" #n ")" ::: "memory")
#define PG8_BAR __builtin_amdgcn_s_barrier()
#define PG8_SCHED __builtin_amdgcn_sched_barrier(0)
    Unit cur, nxt; int ui = 0;
    if (!S.next(0, cur)) return;
    f32x4 acc[2][2][4][2];
#pragma unroll
    for (int a = 0; a < 2; ++a)
#pragma unroll
        for (int b = 0; b < 2; ++b)
#pragma unroll
            for (int m = 0; m < 4; ++m)
#pragma unroll
                for (int n = 0; n < 2; ++n) acc[a][b][m][n] = (f32x4){0.f, 0.f, 0.f, 0.f};
    bf16x8 At[4][2], B0[2][2], B1[2][2];
    const char* cA = (const char*)g.A + (size_t)cur.pm * tstep; const char* cB = (const char*)g.Bt + (size_t)cur.pn * tstep;
    PG8_STAGE(PG8_SB(0, 0), cB, voffB); PG8_STAGE(PG8_SB(0, 1), cB + hstep, voffB); PG8_STAGE(PG8_SA(0, 0), cA, voffA); PG8_STAGE(PG8_SA(0, 1), cA + hstep, voffA);
    if (wr == 1) PG8_BAR;
    PG8_WAIT_V(2); PG8_BAR;
    PG8_STAGE(PG8_SB(1, 0), cB + kstep, voffB); PG8_STAGE(PG8_SA(1, 0), cA + kstep, voffA); PG8_STAGE(PG8_SB(1, 1), cB + hstep + kstep, voffB);
    PG8_WAIT_V(6); PG8_BAR;
    for (;;) {
        const bool has_next = S.next(ui + 1, nxt);
        const char* nA = has_next ? (const char*)g.A + (size_t)nxt.pm * tstep : cA; const char* nB = has_next ? (const char*)g.Bt + (size_t)nxt.pn * tstep : cB;
        for (int t = 0; t < nt; t += 2) {
            const bool last = (t == nt - 2);
            const char* a1 = cA + (size_t)(t + 1) * kstep;
            const char* a2 = last ? nA : cA + (size_t)(t + 2) * kstep; const char* b2 = last ? nB : cB + (size_t)(t + 2) * kstep;
            const char* a3 = a2 + kstep; const char* b3 = b2 + kstep;
            PG8_LDB(B0, 0, 0); PG8_LDB(B1, 0, 1); PG8_SCHED; PG8_LDA(At, 0, 0); PG8_STAGE(PG8_SA(1, 1), a1 + hstep, voffA);
            PG8_WAIT_V(8); PG8_WAIT_L(0); PG8_BAR; PG8_MMA(0, 0, At, B0); PG8_MMA(0, 1, At, B1); PG8_BAR; PG8_SCHED;
            PG8_LDA(At, 0, 1); PG8_STAGE(PG8_SB(0, 0), b2, voffB); PG8_STAGE(PG8_SB(0, 1), b2 + hstep, voffB); PG8_STAGE(PG8_SA(0, 0), a2, voffA);
            PG8_WAIT_V(8); PG8_WAIT_L(0); PG8_BAR; PG8_MMA(1, 0, At, B0); PG8_MMA(1, 1, At, B1); PG8_BAR; PG8_SCHED;
            PG8_LDB(B0, 1, 0); PG8_LDB(B1, 1, 1); PG8_SCHED; PG8_LDA(At, 1, 0); PG8_STAGE(PG8_SA(0, 1), a2 + hstep, voffA);
            PG8_WAIT_V(8); PG8_WAIT_L(0); PG8_BAR; PG8_MMA(0, 0, At, B0); PG8_MMA(0, 1, At, B1); PG8_BAR; PG8_SCHED;
            PG8_LDA(At, 1, 1); PG8_STAGE(PG8_SB(1, 0), b3, voffB); PG8_STAGE(PG8_SB(1, 1), b3 + hstep, voffB); PG8_STAGE(PG8_SA(1, 0), a3, voffA);
            PG8_WAIT_V(8); PG8_WAIT_L(0); PG8_BAR; PG8_MMA(1, 0, At, B0); PG8_MMA(1, 1, At, B1); PG8_BAR; PG8_SCHED;
        }
        if (wr == 0) PG8_BAR;
        E(acc, cur, wr, wc, fr, fq);
        if (!has_next) break;
#pragma unroll
        for (int a = 0; a < 2; ++a)
#pragma unroll
            for (int b = 0; b < 2; ++b)
#pragma unroll
                for (int m = 0; m < 4; ++m)
#pragma unroll
                    for (int n = 0; n < 2; ++n) acc[a][b][m][n] = (f32x4){0.f, 0.f, 0.f, 0.f};
        cur = nxt; cA = nA; cB = nB; ++ui;
        if (wr == 1) PG8_BAR;
    }
    PG8_WAIT_V(0);
    PG8_BAR;
#undef PG8_SA
#undef PG8_SB
#undef PG8_STAGE
#undef PG8_LDA
#undef PG8_LDB
#undef PG8_MMA
#undef PG8_WAIT_V
#undef PG8_WAIT_L
#undef PG8_BAR
#undef PG8_SCHED
}
}

#define XB_TMO      128
#define XB_XCNT(j)  (256  + 64 * (j))
#define XB_XSUB(j)  (1280 + 64 * (j))
#define XB_XGEN(j)  (2304 + 64 * (j))
#define XB_TOP      3328
#define XB_TOPGEN   3392
#define XCD_BAR_WORDS 3456
#define XB_SPIN_CAP (1u << 18)
__device__ __forceinline__ unsigned xb_ld(unsigned* p)              { return __hip_atomic_load(p, __ATOMIC_RELAXED, __HIP_MEMORY_SCOPE_AGENT); }
__device__ __forceinline__ unsigned xb_add(unsigned* p, unsigned v) { return __hip_atomic_fetch_add(p, v, __ATOMIC_RELAXED, __HIP_MEMORY_SCOPE_AGENT); }
__device__ __forceinline__ unsigned xb_xcc_id() { return (unsigned)__builtin_amdgcn_s_getreg((3 << 11) | 20) & 0xFu; }
#define XB_SPIN(cond, bar) do { unsigned _sp = 0; while (cond) { __builtin_amdgcn_s_sleep(1); \
    if ((++_sp & 255u) == 0u) { if (xb_ld(&(bar)[XB_TMO])) break; if (_sp > XB_SPIN_CAP) { atomicAdd(&(bar)[XB_TMO], 1u); break; } } } } while (0)
struct XcdBarrier { unsigned* bar; unsigned x; volatile LAS unsigned* st; };
__device__ __forceinline__ XcdBarrier xcd_barrier_post(unsigned* bar, volatile LAS unsigned* st) {
    XcdBarrier b; b.bar = bar; b.x = xb_xcc_id(); b.st = st;
    if (threadIdx.x == 0) (void)xb_add(&bar[XB_XCNT(b.x)], 1u);
    return b;
}
__device__ __forceinline__ void xcd_barrier_complete(unsigned* bar, unsigned x, unsigned& nloc, unsigned& nx) {
    const unsigned G = gridDim.x * gridDim.y * gridDim.z;
    unsigned sum, cnt, mine, sp = 0u;
    for (;;) {
        sum = 0u; cnt = 0u; mine = 0u;
#pragma unroll
        for (unsigned j = 0; j < 16; ++j) { const unsigned c = xb_ld(&bar[XB_XCNT(j)]); sum += c; cnt += (c > 0u) ? 1u : 0u; mine = (j == x) ? c : mine; }
        if (sum == G) break;
        __builtin_amdgcn_s_sleep(1);
        if ((++sp & 255u) == 0u) { if (xb_ld(&bar[XB_TMO])) break; if (sp > XB_SPIN_CAP) { atomicAdd(&bar[XB_TMO], 1u); break; } }
    }
    nloc = mine > 0u ? mine : 1u; nx = cnt > 0u ? cnt : 1u;
}
__device__ __forceinline__ void xcd_barrier(const XcdBarrier& b) {
    asm volatile("s_waitcnt vmcnt(0)" ::: "memory");
    __syncthreads();
    if (threadIdx.x == 0) {
        unsigned* bar = b.bar;
        __builtin_amdgcn_s_waitcnt(0);
        unsigned nloc = b.st[0], nx = b.st[1];
        if (nloc == 0u) { xcd_barrier_complete(bar, b.x, nloc, nx); b.st[0] = nloc; b.st[1] = nx; }
        const unsigned old = xb_add(&bar[XB_XSUB(b.x)], 1u);
        const unsigned gen = old / nloc;
        if (old + 1u == (gen + 1u) * nloc) {
            __builtin_amdgcn_fence(__ATOMIC_RELEASE, "agent");
            asm volatile("s_waitcnt vmcnt(0)" ::: "memory");
            const unsigned og = xb_add(&bar[XB_TOP], 1u);
            const unsigned tg = og / nx;
            if (og + 1u == (tg + 1u) * nx) xb_add(&bar[XB_TOPGEN], 1u);
            else XB_SPIN(xb_ld(&bar[XB_TOPGEN]) == tg, bar);
            __builtin_amdgcn_fence(__ATOMIC_ACQUIRE, "agent");
            xb_add(&bar[XB_XGEN(b.x)], 1u);
            asm volatile("s_waitcnt vmcnt(0)" ::: "memory");
        } else {
            XB_SPIN(xb_ld(&bar[XB_XGEN(b.x)]) == gen, bar);
            __builtin_amdgcn_fence(__ATOMIC_ACQUIRE, "agent");
            asm volatile("s_waitcnt vmcnt(0)" ::: "memory");
        }
    }
    __syncthreads();
}

struct Frame {
    LAS unsigned char* lds;
    int tid, lane, wave, vcu, G;
    unsigned char* ws; float* out;
};
#define WSP(T, off) ((T*)(ws + (off)))

struct Seg { int in, off, ld, col0; unsigned long long dst; int row0, nrows, K, gin, goff, flags; };
constexpr int SEG_PERM = 1, SEG_QS = 2;
constexpr int NSEG = 26;
__constant__ Seg c_segs[NSEG] = {
    {9, 0 * 1024 * 512, 512, 0, WS_WMEM, 0, 512, 1024, 8, 0, 0},
    {9, 1 * 1024 * 512, 512, 0, WS_WMEM, 512, 512, 1024, 8, 1024, 0},
    {9, 2 * 1024 * 512, 512, 0, WS_WMEM, 1024, 512, 1024, 8, 2048, 0},
    {9, 3 * 1024 * 512, 512, 0, WS_WMEM, 1536, 512, 1024, 8, 3072, 0},
    {10, 0, NA, 0, WS_WINA, 0, 3072, 1024, 18, 0, 0},
    {10, 0, NA, 3072, WS_WINA, 3072, 256, 1024, 18, 0, SEG_QS},
    {10, 1024 * NA, NA, 0, WS_WINA + SZ_WINA, 0, 3072, 1024, 18, 1024, 0},
    {10, 1024 * NA, NA, 3072, WS_WINA + SZ_WINA, 3072, 256, 1024, 18, 1024, SEG_QS},
    {13, 0, 1024, 0, WS_WINB0, 0, 768, 1024, 18, 2048, SEG_PERM | SEG_QS},
    {13, 0, 1024, 768, WS_WINB0, 768, 256, 1024, 18, 2048, SEG_QS},
    {16, 0, 512, 0, WS_WINB0, 1024, 256, 1024, 15, 0, SEG_PERM},
    {16, 0, 512, 256, WS_WINB0, 1280, 256, 1024, 15, 0, 0},
    {13, 1024 * 1024, 1024, 0, WS_WINB1, 0, 768, 1024, 18, 3072, SEG_PERM | SEG_QS},
    {13, 1024 * 1024, 1024, 768, WS_WINB1, 768, 256, 1024, 18, 3072, SEG_QS},
    {17, 0 * 1024 * 1024, 1024, 0, WS_WOUT + 0 * 2097152ull, 0, 1024, 1024, -1, 0, 0},
    {17, 1 * 1024 * 1024, 1024, 0, WS_WOUT + 1 * 2097152ull, 0, 1024, 1024, -1, 0, 0},
    {17, 2 * 1024 * 1024, 1024, 0, WS_WOUT + 2 * 2097152ull, 0, 1024, 1024, -1, 0, 0},
    {17, 3 * 1024 * 1024, 1024, 0, WS_WOUT + 3 * 2097152ull, 0, 1024, 1024, -1, 0, 0},
    {22, 0 * 4096 * 1024, 4096, 0, WS_WUP + 0 * 8388608ull, 0, 4096, 1024, 20, 0, 0},
    {22, 1 * 4096 * 1024, 4096, 0, WS_WUP + 1 * 8388608ull, 0, 4096, 1024, 20, 1024, 0},
    {22, 2 * 4096 * 1024, 4096, 0, WS_WUP + 2 * 8388608ull, 0, 4096, 1024, 20, 2048, 0},
    {22, 3 * 4096 * 1024, 4096, 0, WS_WUP + 3 * 8388608ull, 0, 4096, 1024, 20, 3072, 0},
    {23, 0 * 4096 * 1024, 1024, 0, WS_WDN + 0 * 8388608ull, 0, 1024, 4096, -1, 0, 0},
    {23, 1 * 4096 * 1024, 1024, 0, WS_WDN + 1 * 8388608ull, 0, 1024, 4096, -1, 0, 0},
    {23, 2 * 4096 * 1024, 1024, 0, WS_WDN + 2 * 8388608ull, 0, 1024, 4096, -1, 0, 0},
    {23, 3 * 4096 * 1024, 1024, 0, WS_WDN + 3 * 8388608ull, 0, 1024, 4096, -1, 0, 0},
};
__constant__ double c_invfreq[32] = {1.0, 0.7498942093324559, 0.5623413251903491, 0.4216965034285822, 0.31622776601683794, 0.23713737056616552, 0.1778279410038923, 0.1333521432163324, 0.1, 0.07498942093324558, 0.05623413251903491, 0.042169650342858224, 0.03162277660168379, 0.023713737056616554, 0.01778279410038923, 0.01333521432163324, 0.01, 0.007498942093324558, 0.005623413251903491, 0.004216965034285823, 0.0031622776601683794, 0.0023713737056616554, 0.0017782794100389228, 0.001333521432163324, 0.001, 0.0007498942093324559, 0.0005623413251903491, 0.00042169650342858224, 0.00031622776601683794, 0.00023713737056616554, 0.00017782794100389227, 0.0001333521432163324};

__device__ __forceinline__ void seg_item(unsigned char* ws, const Seg& s, LAS float* scr, int item, int lane) {
    const float* W = in_ptr(s.in) + s.off;
    const float* gain = s.gin >= 0 ? in_ptr(s.gin) + s.goff : nullptr;
    const float scale = (s.flags & SEG_QS) ? QSCALE : 1.0f;
    bf16_t* WT = (bf16_t*)(ws + s.dst);
    const int nblk = s.nrows / 32, kb = item / nblk, nb = item % nblk, k0 = 64 * kb, n0 = 32 * nb, K = s.K;
    int j = lane & 31, src;
    if (s.flags & SEG_PERM) { const int jj = (n0 & 63) + j; src = (n0 & ~63) + (jj >> 1) + 32 * (jj & 1); } else src = n0 + j;
    src += s.col0;
#pragma unroll 8
    for (int i = 0; i < 32; ++i) { const int kk = 2 * i + (lane >> 5); float w = W[(size_t)(k0 + kk) * s.ld + src]; const float gn = gain ? gain[k0 + kk] * scale : scale; scr[kk * 33 + j] = w * gn; }
    LDS_WAIT(); asm volatile("" ::: "memory");
    const int c = lane & 7;
#pragma unroll
    for (int jq = 0; jq < 4; ++jq) { const int n = (lane >> 3) + 8 * jq; const LAS float* sp = scr + (8 * c) * 33 + n;
        u32x4 o; o.x = cvtpk(sp[0 * 33], sp[1 * 33]); o.y = cvtpk(sp[2 * 33], sp[3 * 33]); o.z = cvtpk(sp[4 * 33], sp[5 * 33]); o.w = cvtpk(sp[6 * 33], sp[7 * 33]);
        *(u32x4*)(WT + (size_t)(s.row0 + n0 + n) * K + k0 + 8 * c) = o; }
    LDS_WAIT(); asm volatile("" ::: "memory");
}

__device__ __forceinline__ void rms_row_to_bf16(const float* xrow, bf16_t* orow, float* hcopy, int lane) {
    const f32x4* xr = (const f32x4*)xrow + lane;
    f32x4 v[4]; float s = 0.f;
#pragma unroll
    for (int j = 0; j < 4; ++j) { v[j] = xr[64 * j]; s += (v[j].x * v[j].x + v[j].y * v[j].y) + (v[j].z * v[j].z + v[j].w * v[j].w); }
    const float rstd = rsqrtf(wave_sum(s) * (1.f / D) + EPS);
    u32x2* o8 = (u32x2*)orow + lane;
#pragma unroll
    for (int j = 0; j < 4; ++j) { u32x2 w; w.x = cvtpk(v[j].x * rstd, v[j].y * rstd); w.y = cvtpk(v[j].z * rstd, v[j].w * rstd); o8[64 * j] = w; }
    if (hcopy) { f32x4* hc = (f32x4*)hcopy + lane;
#pragma unroll
        for (int j = 0; j < 4; ++j) hc[64 * j] = v[j]; }
}

__device__ __forceinline__ void p0_prologue(Frame& F) {
    unsigned char* ws = F.ws;
    LAS float* scr = (LAS float*)(F.lds + F.wave * 16384);
    const int gw = F.vcu * NWAVES + F.wave, NGW = F.G * NWAVES;
    int total = 0;
    for (int s = 0; s < NSEG; ++s) total += (c_segs[s].K / 64) * (c_segs[s].nrows / 32);
    for (int it = gw; it < total; it += NGW) {
        int r = it, s = 0;
        for (; s < NSEG; ++s) { const int n = (c_segs[s].K / 64) * (c_segs[s].nrows / 32); if (r < n) break; r -= n; }
        seg_item(ws, c_segs[s], scr, r, F.lane);
    }
    float* H = WSP(float, WS_H); bf16_t* XN = WSP(bf16_t, WS_XN);
    for (int m = gw; m < MT; m += NGW) {
        if (m < MP) rms_row_to_bf16(in_ptr(0) + (size_t)m * D, XN + (size_t)m * D, H + (size_t)m * D, F.lane);
        else if (m < MP + BS) rms_row_to_bf16(in_ptr(1) + (size_t)(m - MP) * D, XN + (size_t)m * D, H + (size_t)m * D, F.lane);
        else { u32x2* o8 = (u32x2*)(XN + (size_t)m * D) + F.lane; f32x4* hc = (f32x4*)(H + (size_t)m * D) + F.lane;
#pragma unroll
            for (int j = 0; j < 4; ++j) { o8[64 * j] = (u32x2){0u, 0u}; hc[64 * j] = (f32x4){0.f, 0.f, 0.f, 0.f}; } }
    }
    bf16_t* MN = WSP(bf16_t, WS_MN);
    for (int m = gw; m < 512; m += NGW) rms_row_to_bf16(in_ptr(7) + (size_t)m * D, MN + (size_t)m * D, nullptr, F.lane);
    f32x2* rope = WSP(f32x2, WS_ROPE);
    const int gt = F.vcu * NTHR + F.tid, NGT = F.G * NTHR;
    for (int e = gt; e < 8193 * 32; e += NGT) { const int pos = e >> 5, i = e & 31; double rev = (double)pos * c_invfreq[i] * 0.15915494309189535; rev -= __builtin_rint(rev);
        const float rf = (float)rev; rope[e] = (f32x2){__builtin_amdgcn_cosf(rf), __builtin_amdgcn_sinf(rf)}; }
    { float* LBS = WSP(float, WS_LBS); const float* lbl = in_ptr(11);
      for (int e = gt; e < HW; e += NGT) { LBS[e] = 0.f; LBS[HW + e] = fsigmoid(lbl[HW + e] - lbl[e]); } }
    bf16_t* KR = WSP(bf16_t, WS_KR); bf16_t* VT = WSP(bf16_t, WS_VT);
    for (int e = gt; e < 8 * 160 * 64; e += NGT) { const int bk = e / (160 * 64), r = (e / 64) % 160, d = e % 64; const int pos = r < 128 ? r : 128 + SEQ + (r - 128);
        KR[((size_t)bk * KVP + pos) * 64 + d] = 0; VT[((size_t)bk * 64 + d) * KVP + pos] = 0; }
}

enum { EK_MEMKV = 0, EK_INA = 1, EK_INB = 2, EK_F32 = 3, EK_UP = 4 };
struct Epi {
    int kind, layer; unsigned char* ws; float* out;
    __device__ __forceinline__ void operator()(const f32x4 (&acc)[2][2][4][2], const pg8::Unit& u, int wr, int wc, int fr, int fq) const {
        asm volatile("" : "+v"(fr), "+v"(fq));
        const int row0 = u.pm * 256 + wr * 64 + fr, cl0 = wc * 32 + 8 * fq;
        if (kind == EK_F32) {
            float* Y = WSP(float, WS_Y);
#pragma unroll
            for (int ai = 0; ai < 2; ++ai)
#pragma unroll
                for (int m = 0; m < 4; ++m) { float* rp = Y + (size_t)(row0 + ai * 128 + m * 16) * D + u.pn * 256 + cl0;
#pragma unroll
                    for (int bj = 0; bj < 2; ++bj) { *(f32x4*)(rp + bj * 128) = acc[ai][bj][m][0]; *(f32x4*)(rp + bj * 128 + 4) = acc[ai][bj][m][1]; } }
        } else if (kind == EK_UP) {
            bf16_t* HB = WSP(bf16_t, WS_HB);
#pragma unroll
            for (int ai = 0; ai < 2; ++ai)
#pragma unroll
                for (int m = 0; m < 4; ++m) { bf16_t* rp = HB + (size_t)(row0 + ai * 128 + m * 16) * FF + u.pn * 256 + cl0;
#pragma unroll
                    for (int bj = 0; bj < 2; ++bj) { f32x4 v0 = acc[ai][bj][m][0], v1 = acc[ai][bj][m][1];
#pragma unroll
                        for (int e = 0; e < 4; ++e) { const float r0 = fmaxf(v0[e], 0.f), r1 = fmaxf(v1[e], 0.f); v0[e] = r0 * r0; v1[e] = r1 * r1; }
                        u32x4 w; w.x = cvtpk(v0[0], v0[1]); w.y = cvtpk(v0[2], v0[3]); w.z = cvtpk(v1[0], v1[1]); w.w = cvtpk(v1[2], v1[3]);
                        *(u32x4*)(rp + bj * 128) = w; } }
        } else if (kind == EK_MEMKV) {
            const int l = u.pn >> 1, kv = u.pn & 1;
            float* of = out + (kv ? O_MV : O_MK);
            bf16_t* MKB = WSP(bf16_t, WS_MKB); bf16_t* MVT = WSP(bf16_t, WS_MVT);
#pragma unroll
            for (int ai = 0; ai < 2; ++ai)
#pragma unroll
                for (int m = 0; m < 4; ++m) { const int row = row0 + ai * 128 + m * 16, b = row >> 8, mm = row & 255;
#pragma unroll
                    for (int bj = 0; bj < 2; ++bj) { const int cc = bj * 128 + cl0, h = cc >> 6, d = cc & 63; const f32x4 v0 = acc[ai][bj][m][0], v1 = acc[ai][bj][m][1];
                        float* op = of + ((size_t)(l * 2 + b) * 256 + mm) * 256 + cc; *(f32x4*)op = v0; *(f32x4*)(op + 4) = v1;
                        if (kv == 0) { u32x4 w; w.x = cvtpk(v0[0], v0[1]); w.y = cvtpk(v0[2], v0[3]); w.z = cvtpk(v1[0], v1[1]); w.w = cvtpk(v1[2], v1[3]);
                            *(u32x4*)(MKB + ((size_t)((l * 2 + b) * 4 + h) * 256 + mm) * 64 + d) = w; }
                        else { bf16_t* vp = MVT + ((size_t)((l * 2 + b) * 4 + h) * 64 + d) * 256 + mm;
#pragma unroll
                            for (int e = 0; e < 4; ++e) { vp[(size_t)e * 256] = f2bf(v0[e]); vp[(size_t)(e + 4) * 256] = f2bf(v1[e]); } } } }
        } else if (kind == EK_INA) {
            const int sec = u.pn / 3, ct = u.pn % 3;
            bf16_t* QS = WSP(bf16_t, WS_QS); bf16_t* KK = WSP(bf16_t, WS_KK); bf16_t* VV = WSP(bf16_t, WS_VV); bf16_t* GG = WSP(bf16_t, WS_GG); float* LF = WSP(float, WS_LF); bf16_t* CQ = WSP(bf16_t, WS_CQ);
            if (sec == 4) {
#pragma unroll
                for (int ai = 0; ai < 2; ++ai)
#pragma unroll
                    for (int m = 0; m < 4; ++m) { bf16_t* rp = CQ + (size_t)(row0 + ai * 128 + m * 16) * XW + cl0;
#pragma unroll
                        for (int bj = 0; bj < 2; ++bj) { const f32x4 v0 = acc[ai][bj][m][0], v1 = acc[ai][bj][m][1]; u32x4 w; w.x = cvtpk(v0[0], v0[1]); w.y = cvtpk(v0[2], v0[3]); w.z = cvtpk(v1[0], v1[1]); w.w = cvtpk(v1[2], v1[3]);
                            *(u32x4*)(rp + bj * 128) = w; } }
            } else if (sec == 1) {
                const float* LBS = WSP(float, WS_LBS) + layer * HW + ct * 256 + cl0;
                f32x4 lb4[2][2];
#pragma unroll
                for (int bj = 0; bj < 2; ++bj) { lb4[bj][0] = *(const f32x4*)(LBS + bj * 128); lb4[bj][1] = *(const f32x4*)(LBS + bj * 128 + 4); }
#pragma unroll
                for (int ai = 0; ai < 2; ++ai)
#pragma unroll
                    for (int m = 0; m < 4; ++m) { const size_t ro = (size_t)(row0 + ai * 128 + m * 16) * HW + ct * 256 + cl0;
#pragma unroll
                        for (int bj = 0; bj < 2; ++bj) { float lf[8], kk[8];
#pragma unroll
                            for (int e = 0; e < 8; ++e) { const float z = e < 4 ? acc[ai][bj][m][0][e] : acc[ai][bj][m][1][e - 4];
                                const float t = fexp(-fabsf(z)), r = __builtin_amdgcn_rcpf(1.0f + t), big = r, small = t * r; const float sp = z >= 0.f ? big : small, sn = z >= 0.f ? small : big;
                                const float l1 = e < 4 ? lb4[bj][0][e] : lb4[bj][1][e - 4], f = l1 + (1.0f - l1) * sp, k = (1.0f - l1) * sn;
                                lf[e] = flog(f); kk[e] = k; }
                            *(f32x4*)(LF + ro + bj * 128) = (f32x4){lf[0], lf[1], lf[2], lf[3]}; *(f32x4*)(LF + ro + bj * 128 + 4) = (f32x4){lf[4], lf[5], lf[6], lf[7]};
                            u32x4 w; w.x = cvtpk(kk[0], kk[1]); w.y = cvtpk(kk[2], kk[3]); w.z = cvtpk(kk[4], kk[5]); w.w = cvtpk(kk[6], kk[7]);
                            *(u32x4*)(KK + ro + bj * 128) = w; } }
            } else {
                bf16_t* dst = sec == 0 ? QS : (sec == 2 ? VV : GG); const bool act = sec != 2;
#pragma unroll
                for (int ai = 0; ai < 2; ++ai)
#pragma unroll
                    for (int m = 0; m < 4; ++m) { bf16_t* rp = dst + (size_t)(row0 + ai * 128 + m * 16) * HW + ct * 256 + cl0;
#pragma unroll
                        for (int bj = 0; bj < 2; ++bj) { f32x4 v0 = acc[ai][bj][m][0], v1 = acc[ai][bj][m][1];
                            if (act) {
#pragma unroll
                                for (int e = 0; e < 4; ++e) { v0[e] = fsilu(v0[e]); v1[e] = fsilu(v1[e]); } }
                            u32x4 w; w.x = cvtpk(v0[0], v0[1]); w.y = cvtpk(v0[2], v0[3]); w.z = cvtpk(v1[0], v1[1]); w.w = cvtpk(v1[2], v1[3]);
                            *(u32x4*)(rp + bj * 128) = w; } }
            }
        } else {
            bf16_t* QR = WSP(bf16_t, WS_QS); bf16_t* CQ = WSP(bf16_t, WS_CQ); bf16_t* KR = WSP(bf16_t, WS_KR); bf16_t* VT = WSP(bf16_t, WS_VT);
            float* KSN = WSP(float, WS_KSN); float* VSN = WSP(float, WS_VSN); const f32x2* rope = WSP(f32x2, WS_ROPE);
            const int pn = u.pn;
#pragma unroll
            for (int ai = 0; ai < 2; ++ai)
#pragma unroll
                for (int m = 0; m < 4; ++m) { const int row = row0 + ai * 128 + m * 16; const int pos = row < MP ? (row & (SEQ - 1)) : SEQ; const int b = row >> 13, t = row & (SEQ - 1);
#pragma unroll
                    for (int bj = 0; bj < 2; ++bj) { const int cc = bj * 128 + cl0; f32x4 v0 = acc[ai][bj][m][0], v1 = acc[ai][bj][m][1];
                        if (pn == 3) { u32x4 w; w.x = cvtpk(v0[0], v0[1]); w.y = cvtpk(v0[2], v0[3]); w.z = cvtpk(v1[0], v1[1]); w.w = cvtpk(v1[2], v1[3]); *(u32x4*)(CQ + (size_t)row * XW + cc) = w; }
                        else if (pn == 5) {
                            const int kvh = cc >> 6, d = cc & 63;
                            if (row < MP) { bf16_t* vp = VT + ((size_t)((b * 4 + kvh) * 64 + d)) * KVP + 128 + t;
#pragma unroll
                                for (int e = 0; e < 4; ++e) { vp[(size_t)e * KVP] = f2bf(v0[e]); vp[(size_t)(e + 4) * KVP] = f2bf(v1[e]); }
                                if (t >= SEQ - 128) { float* op = out + O_SVP + ((size_t)(b * 128 + (t - (SEQ - 128))) * 4 + kvh) * 64 + d; *(f32x4*)op = v0; *(f32x4*)(op + 4) = v1; } }
                            else if (row < MP + BS) { const int bs = row - MP; float* op = out + O_SVS + ((size_t)(bs * 128 + 127) * 4 + kvh) * 64 + d; *(f32x4*)op = v0; *(f32x4*)(op + 4) = v1;
                                float* sp = VSN + (size_t)(bs * 4 + kvh) * 64 + d; *(f32x4*)sp = v0; *(f32x4*)(sp + 4) = v1; }
                        } else {
                            const int hh = cc >> 6, i0 = (cc & 63) >> 1; const f32x2* rp = rope + (size_t)pos * 32 + i0;
                            float o[8];
#pragma unroll
                            for (int p = 0; p < 4; ++p) { const f32x2 cs = rp[p]; const float x1 = p < 2 ? v0[2 * p] : v1[2 * p - 4], x2 = p < 2 ? v0[2 * p + 1] : v1[2 * p - 3];
                                o[2 * p] = x1 * cs.x - x2 * cs.y; o[2 * p + 1] = x2 * cs.x + x1 * cs.y; }
                            u32x4 w; w.x = cvtpk(o[0], o[1]); w.y = cvtpk(o[2], o[3]); w.z = cvtpk(o[4], o[5]); w.w = cvtpk(o[6], o[7]);
                            if (pn < 3) *(u32x4*)(QR + (size_t)row * HW + pn * 256 + cc) = w;
                            else {
                                if (row < MP) { *(u32x4*)(KR + ((size_t)(b * 4 + hh) * KVP + 128 + t) * 64 + (cc & 63)) = w;
                                    if (t >= SEQ - 128) { float* op = out + O_SKP + ((size_t)(b * 128 + (t - (SEQ - 128))) * 4 + hh) * 64;
#pragma unroll
                                        for (int p = 0; p < 4; ++p) { op[i0 + p] = o[2 * p]; op[i0 + p + 32] = o[2 * p + 1]; } } }
                                else if (row < MP + BS) { const int bs = row - MP; float* op = out + O_SKS + ((size_t)(bs * 128 + 127) * 4 + hh) * 64; float* sp = KSN + (size_t)(bs * 4 + hh) * 64;
#pragma unroll
                                    for (int p = 0; p < 4; ++p) { op[i0 + p] = o[2 * p]; op[i0 + p + 32] = o[2 * p + 1]; sp[i0 + p] = o[2 * p]; sp[i0 + p + 32] = o[2 * p + 1]; } }
                            }
                        } } }
        }
    }
};

__device__ __forceinline__ void norm_phase(Frame& F, const float* gpost, bool final_out) {
    unsigned char* ws = F.ws;
    const int gw = F.vcu * NWAVES + F.wave, NGW = F.G * NWAVES, lane = F.lane;
    float* H = WSP(float, WS_H); const float* Y = WSP(float, WS_Y); bf16_t* XN = WSP(bf16_t, WS_XN);
    f32x4 gp[4];
#pragma unroll
    for (int j = 0; j < 4; ++j) gp[j] = ((const f32x4*)gpost)[lane + 64 * j];
    for (int m = gw; m < MP + BS; m += NGW) {
        const f32x4* yr = (const f32x4*)(Y + (size_t)m * D) + lane; f32x4* hr = (f32x4*)(H + (size_t)m * D) + lane;
        f32x4 y[4], h[4]; float s = 0.f;
#pragma unroll
        for (int j = 0; j < 4; ++j) { y[j] = yr[64 * j]; h[j] = hr[64 * j]; s += (y[j].x * y[j].x + y[j].y * y[j].y) + (y[j].z * y[j].z + y[j].w * y[j].w); }
        const float rstd = rsqrtf(wave_sum(s) * (1.f / D) + EPS); float s2 = 0.f;
#pragma unroll
        for (int j = 0; j < 4; ++j) { h[j] = h[j] + y[j] * rstd * gp[j]; s2 += (h[j].x * h[j].x + h[j].y * h[j].y) + (h[j].z * h[j].z + h[j].w * h[j].w); }
        if (final_out) { f32x4* orow = (f32x4*)(m < MP ? F.out + O_YP + (size_t)m * D : F.out + O_YS + (size_t)(m - MP) * D) + lane;
#pragma unroll
            for (int j = 0; j < 4; ++j) orow[64 * j] = h[j];
        } else {
            const float rstd2 = rsqrtf(wave_sum(s2) * (1.f / D) + EPS);
            u32x2* o8 = (u32x2*)(XN + (size_t)m * D) + lane;
#pragma unroll
            for (int j = 0; j < 4; ++j) { hr[64 * j] = h[j]; u32x2 w; w.x = cvtpk(h[j].x * rstd2, h[j].y * rstd2); w.y = cvtpk(h[j].z * rstd2, h[j].w * rstd2); o8[64 * j] = w; }
        }
    }
}

constexpr int HS_NSEG = 16, HS_CPS = 8, HS_UNITS = 12 * HS_NSEG;
constexpr int HL_RAW_LF = 0, HL_RAW_K = 32768, HL_RAW_V = 49152, HL_RAW_Q = 65536;
constexpr int HL_TOT = 81920;
constexpr int HL_A = HL_TOT + 2048;
constexpr int HL_KT = HL_A + 512;
constexpr int HL_VTT = HL_KT + 128 * 144;
constexpr int HL_QH = 0;
constexpr int HL_QT = HL_QH + 64 * 272, HL_KTL = HL_QT + 64 * 272, HL_P = HL_KTL + 64 * 272;
constexpr int HL_O = HL_P + 64 * 144;
static_assert(HL_O + 64 * 272 <= HL_TOT && HL_VTT + 128 * 144 <= RING_BYTES, "hgrn lds");

__device__ __forceinline__ f32x4 mfma16(bf16x8 a, bf16x8 b, f32x4 c) { return __builtin_amdgcn_mfma_f32_16x16x32_bf16(a, b, c, 0, 0, 0); }
__device__ __forceinline__ void st16_lds(LAS unsigned char* p, const float (&v)[16]) {
    u32x4 w0, w1; w0.x = cvtpk(v[0], v[1]); w0.y = cvtpk(v[2], v[3]); w0.z = cvtpk(v[4], v[5]); w0.w = cvtpk(v[6], v[7]);
    w1.x = cvtpk(v[8], v[9]); w1.y = cvtpk(v[10], v[11]); w1.z = cvtpk(v[12], v[13]); w1.w = cvtpk(v[14], v[15]);
    *(LAS u32x4*)p = w0; *(LAS u32x4*)(p + 16) = w1;
}
struct HRaw { f32x4 lf[4]; u32x4 k[2], v[2], q[2]; };
template <bool WITHQ> __device__ __forceinline__ void hraw_load(HRaw& r, unsigned char* ws, int row0, int h, int tid) {
    const size_t e = (size_t)(row0 + (tid >> 3)) * HW + h * 128 + (tid & 7) * 16;
    const float* LF = WSP(float, WS_LF) + e; const bf16_t* KK = WSP(bf16_t, WS_KK) + e; const bf16_t* VV = WSP(bf16_t, WS_VV) + e; const bf16_t* QS = WSP(bf16_t, WS_QS) + e;
#pragma unroll
    for (int j = 0; j < 4; ++j) r.lf[j] = *(const f32x4*)(LF + 4 * j);
#pragma unroll
    for (int j = 0; j < 2; ++j) { r.k[j] = *(const u32x4*)(KK + 8 * j); r.v[j] = *(const u32x4*)(VV + 8 * j); if (WITHQ) r.q[j] = *(const u32x4*)(QS + 8 * j); }
}
template <bool WITHQ> __device__ __forceinline__ void hraw_store(const HRaw& r, LAS unsigned char* lds, int tid) {
    const int o = (tid >> 3) * 128 + (tid & 7) * 16;
#pragma unroll
    for (int j = 0; j < 4; ++j) *(LAS f32x4*)(lds + HL_RAW_LF + (o + 4 * j) * 4) = r.lf[j];
#pragma unroll
    for (int j = 0; j < 2; ++j) { *(LAS u32x4*)(lds + HL_RAW_K + (o + 8 * j) * 2) = r.k[j]; *(LAS u32x4*)(lds + HL_RAW_V + (o + 8 * j) * 2) = r.v[j]; if (WITHQ) *(LAS u32x4*)(lds + HL_RAW_Q + (o + 8 * j) * 2) = r.q[j]; }
}
__device__ __forceinline__ void hgrn_state_update(f32x4 (&acc)[8], LAS unsigned char* lds, int w, int fr, int g) {
    bf16x8 bf[2];
#pragma unroll
    for (int ks = 0; ks < 2; ++ks) bf[ks] = *(const LAS bf16x8*)(lds + HL_VTT + (16 * w + fr) * 144 + ks * 64 + g * 16);
#pragma unroll
    for (int nb = 0; nb < 8; ++nb) { const f32x4 a4 = *(const LAS f32x4*)(lds + HL_A + (16 * nb + 4 * g) * 4); acc[nb] = acc[nb] * a4;
#pragma unroll
        for (int ks = 0; ks < 2; ++ks) { const bf16x8 af = *(const LAS bf16x8*)(lds + HL_KT + (16 * nb + fr) * 144 + ks * 64 + g * 16); acc[nb] = mfma16(af, bf[ks], acc[nb]); } }
}

__device__ __forceinline__ void hgrn_pass1_unit(Frame& F, int unit) {
    unsigned char* ws = F.ws; LAS unsigned char* lds = F.lds;
    const int bh = unit >> 4, seg = unit & 15, b_ = bh / 6, h = bh % 6;
    const int tid = F.tid, ch = tid & 127, tq = tid >> 7, lane = F.lane, w = F.wave, fr = lane & 15, g = lane >> 4;
    f32x4 acc[8];
#pragma unroll
    for (int nb = 0; nb < 8; ++nb) acc[nb] = (f32x4){0.f, 0.f, 0.f, 0.f};
    float bsum = 0.f;
    HRaw r; hraw_load<false>(r, ws, b_ * SEQ + seg * (HS_CPS * 64), h, tid);
#pragma unroll 1
    for (int cc = 0; cc < HS_CPS; ++cc) {
        hraw_store<false>(r, lds, tid);
        __syncthreads();
        if (cc + 1 < HS_CPS) hraw_load<false>(r, ws, b_ * SEQ + (seg * HS_CPS + cc + 1) * 64, h, tid);
        float bb[16], kv[16], vv[16]; float run = 0.f;
#pragma unroll
        for (int i = 0; i < 16; ++i) { const int o = (tq * 16 + i) * 128 + ch; run += *(const LAS float*)(lds + HL_RAW_LF + o * 4); bb[i] = run;
            kv[i] = bf2f(*(const LAS bf16_t*)(lds + HL_RAW_K + o * 2)); vv[i] = bf2f(*(const LAS bf16_t*)(lds + HL_RAW_V + o * 2)); }
        LAS float* tot = (LAS float*)(lds + HL_TOT);
        tot[tq * 128 + ch] = run;
        __syncthreads();
        const float t0 = tot[ch], t1 = tot[128 + ch], t2 = tot[256 + ch], t3 = tot[384 + ch];
        const float pre = tq == 0 ? 0.f : (tq == 1 ? t0 : (tq == 2 ? t0 + t1 : t0 + t1 + t2)), btot = (t0 + t1) + (t2 + t3);
#pragma unroll
        for (int i = 0; i < 16; ++i) kv[i] *= fexp(btot - (bb[i] + pre));
        st16_lds(lds + HL_KT + ch * 144 + tq * 32, kv);
        st16_lds(lds + HL_VTT + ch * 144 + tq * 32, vv);
        if (tq == 0) *(LAS float*)(lds + HL_A + ch * 4) = fexp(btot);
        bsum += btot;
        __syncthreads();
        hgrn_state_update(acc, lds, w, fr, g);
        __syncthreads();
    }
    float* US = WSP(float, WS_USEG) + (size_t)unit * 16384;
#pragma unroll
    for (int nb = 0; nb < 8; ++nb)
#pragma unroll
        for (int i = 0; i < 4; ++i) US[(nb * 4 + i) * 512 + tid] = acc[nb][i];
    if (tq == 0) WSP(float, WS_ASEG)[(size_t)unit * 128 + ch] = fexp(bsum);
}

__device__ __forceinline__ void hgrn_pass2(Frame& F, int layer) {
    unsigned char* ws = F.ws;
    const int gt = F.vcu * NTHR + F.tid, NGT = F.G * NTHR;
    for (int e = gt; e < 12 * 16384; e += NGT) {
        const int bh = e >> 14, idx = e & 16383, nbi = idx >> 9, t = idx & 511, g = (t >> 4) & 3, fr = t & 15, w = t >> 6;
        const int ch = 16 * (nbi >> 2) + 4 * g + (nbi & 3), v = 16 * w + fr;
        const float* US = WSP(float, WS_USEG) + (size_t)bh * HS_NSEG * 16384 + idx; float* SS = WSP(float, WS_SST) + (size_t)bh * HS_NSEG * 16384 + idx;
        const float* AS = WSP(float, WS_ASEG) + (size_t)bh * HS_NSEG * 128 + ch;
        float u[HS_NSEG], a[HS_NSEG];
#pragma unroll
        for (int s = 0; s < HS_NSEG; ++s) { u[s] = US[(size_t)s * 16384]; a[s] = AS[s * 128]; }
        float st = 0.f;
#pragma unroll
        for (int s = 0; s < HS_NSEG; ++s) { SS[(size_t)s * 16384] = st; st = a[s] * st + u[s]; }
        const int b_ = bh / 6, h = bh % 6;
        F.out[O_HP + ((size_t)((layer * 2 + b_) * 6 + h)) * 16384 + (size_t)ch * 128 + v] = st;
    }
}

__device__ __forceinline__ void hgrn_pass3_unit(Frame& F, int unit, int layer) {
    unsigned char* ws = F.ws; LAS unsigned char* lds = F.lds;
    const int bh = unit >> 4, seg = unit & 15, b_ = bh / 6, h = bh % 6;
    const int tid = F.tid, ch = tid & 127, tq = tid >> 7, lane = F.lane, w = F.wave, fr = lane & 15, g = lane >> 4;
    f32x4 acc[8];
    { const float* SS = WSP(float, WS_SST) + (size_t)unit * 16384;
#pragma unroll
      for (int nb = 0; nb < 8; ++nb)
#pragma unroll
          for (int i = 0; i < 4; ++i) acc[nb][i] = SS[(nb * 4 + i) * 512 + tid]; }
    const bf16_t* GG = WSP(bf16_t, WS_GG); bf16_t* MIX = WSP(bf16_t, WS_MIX);
    const int etok = tid >> 3, ec = (tid & 7) * 16;
    HRaw r; hraw_load<true>(r, ws, b_ * SEQ + seg * (HS_CPS * 64), h, tid);
#pragma unroll 1
    for (int cc = 0; cc < HS_CPS; ++cc) {
        const int row0 = b_ * SEQ + (seg * HS_CPS + cc) * 64;
        hraw_store<true>(r, lds, tid);
        __syncthreads();
        if (cc + 1 < HS_CPS) hraw_load<true>(r, ws, row0 + 64, h, tid);
        float bb[16], kv[16], vv[16], qv[16]; float run = 0.f;
#pragma unroll
        for (int i = 0; i < 16; ++i) { const int o = (tq * 16 + i) * 128 + ch; run += *(const LAS float*)(lds + HL_RAW_LF + o * 4); bb[i] = run;
            kv[i] = bf2f(*(const LAS bf16_t*)(lds + HL_RAW_K + o * 2)); vv[i] = bf2f(*(const LAS bf16_t*)(lds + HL_RAW_V + o * 2)); qv[i] = bf2f(*(const LAS bf16_t*)(lds + HL_RAW_Q + o * 2)); }
        LAS float* tot = (LAS float*)(lds + HL_TOT);
        tot[tq * 128 + ch] = run;
        st16_lds(lds + HL_VTT + ch * 144 + tq * 32, vv);
        __syncthreads();
        const float t0 = tot[ch], t1 = tot[128 + ch], t2 = tot[256 + ch], t3 = tot[384 + ch];
        const float pre = tq == 0 ? 0.f : (tq == 1 ? t0 : (tq == 2 ? t0 + t1 : t0 + t1 + t2)), btot = (t0 + t1) + (t2 + t3), bmid = t0 + t1;
        {
            LAS bf16_t* qh = (LAS bf16_t*)(lds + HL_QH); LAS bf16_t* qt = (LAS bf16_t*)(lds + HL_QT); LAS bf16_t* kt = (LAS bf16_t*)(lds + HL_KTL);
            float kh[16];
#pragma unroll
            for (int i = 0; i < 16; ++i) { const float b = bb[i] + pre, d = b - bmid; const int tok = tq * 16 + i;
                qh[tok * 136 + ch] = f2bf(qv[i] * fexp(b)); qt[tok * 136 + ch] = f2bf(qv[i] * fexp(fminf(d, 80.f))); kt[tok * 136 + ch] = f2bf(kv[i] * fexp(fminf(-d, 80.f)));
                kh[i] = kv[i] * fexp(btot - b); }
            st16_lds(lds + HL_KT + ch * 144 + tq * 32, kh);
            if (tq == 0) *(LAS float*)(lds + HL_A + ch * 4) = fexp(btot);
        }
        __syncthreads();
        u32x4 gg[2];
#pragma unroll
        for (int j = 0; j < 2; ++j) gg[j] = *(const u32x4*)(GG + (size_t)(row0 + etok) * HW + h * 128 + ec + 8 * j);
        {
            const int tb = w >> 1;
#pragma unroll
            for (int q2 = 0; q2 < 2; ++q2) { const int sb = 2 * (w & 1) + q2; f32x4 pa = {0.f, 0.f, 0.f, 0.f};
                if (sb <= tb) {
#pragma unroll
                    for (int ks = 0; ks < 4; ++ks) { const bf16x8 af = *(const LAS bf16x8*)(lds + HL_QT + (16 * tb + fr) * 272 + ks * 64 + g * 16);
                        const bf16x8 bf = *(const LAS bf16x8*)(lds + HL_KTL + (16 * sb + fr) * 272 + ks * 64 + g * 16); pa = mfma16(af, bf, pa); } }
                LAS bf16_t* P = (LAS bf16_t*)(lds + HL_P);
#pragma unroll
                for (int i = 0; i < 4; ++i) { const int t = 16 * tb + 4 * g + i, s = 16 * sb + fr; P[t * 72 + s] = f2bf((sb <= tb && s <= t) ? pa[i] : 0.f); } }
        }
        __syncthreads();
        {
            f32x4 o[4];
#pragma unroll
            for (int tb = 0; tb < 4; ++tb) o[tb] = (f32x4){0.f, 0.f, 0.f, 0.f};
#pragma unroll
            for (int ks = 0; ks < 4; ++ks) { u32x4 sw; sw.x = cvtpk(acc[2 * ks][0], acc[2 * ks][1]); sw.y = cvtpk(acc[2 * ks][2], acc[2 * ks][3]); sw.z = cvtpk(acc[2 * ks + 1][0], acc[2 * ks + 1][1]); sw.w = cvtpk(acc[2 * ks + 1][2], acc[2 * ks + 1][3]);
                const bf16x8 bf = __builtin_bit_cast(bf16x8, sw);
#pragma unroll
                for (int tb = 0; tb < 4; ++tb) { const LAS unsigned char* qp = lds + HL_QH + (16 * tb + fr) * 272 + (32 * ks + 4 * g) * 2;
                    const u32x2 lo = *(const LAS u32x2*)qp, hi = *(const LAS u32x2*)(qp + 32); u32x4 aw; aw.x = lo.x; aw.y = lo.y; aw.z = hi.x; aw.w = hi.y;
                    o[tb] = mfma16(__builtin_bit_cast(bf16x8, aw), bf, o[tb]); } }
#pragma unroll
            for (int ks = 0; ks < 2; ++ks) { const bf16x8 bf = *(const LAS bf16x8*)(lds + HL_VTT + (16 * w + fr) * 144 + ks * 64 + g * 16);
#pragma unroll
                for (int tb = 0; tb < 4; ++tb) { const bf16x8 af = *(const LAS bf16x8*)(lds + HL_P + (16 * tb + fr) * 144 + ks * 64 + g * 16); o[tb] = mfma16(af, bf, o[tb]); } }
            LAS bf16_t* O = (LAS bf16_t*)(lds + HL_O);
#pragma unroll
            for (int tb = 0; tb < 4; ++tb)
#pragma unroll
                for (int i = 0; i < 4; ++i) O[(16 * tb + 4 * g + i) * 136 + 16 * w + fr] = f2bf(o[tb][i]);
        }
        hgrn_state_update(acc, lds, w, fr, g);
        __syncthreads();
        {
            const u32x4 o0 = *(const LAS u32x4*)(lds + HL_O + etok * 272 + ec * 2), o1 = *(const LAS u32x4*)(lds + HL_O + etok * 272 + ec * 2 + 16);
            float ov[16] = {bflo(o0.x), bfhi(o0.x), bflo(o0.y), bfhi(o0.y), bflo(o0.z), bfhi(o0.z), bflo(o0.w), bfhi(o0.w), bflo(o1.x), bfhi(o1.x), bflo(o1.y), bfhi(o1.y), bflo(o1.z), bfhi(o1.z), bflo(o1.w), bfhi(o1.w)};
            float ss = 0.f;
#pragma unroll
            for (int e = 0; e < 16; ++e) ss += ov[e] * ov[e];
            ss += __shfl_xor(ss, 1); ss += __shfl_xor(ss, 2); ss += __shfl_xor(ss, 4);
            const float rstd = rsqrtf(ss * (1.f / 128.f) + EPS);
            f32x4 gain[4];
#pragma unroll
            for (int j = 0; j < 4; ++j) gain[j] = *(const f32x4*)(in_ptr(12) + layer * HW + h * 128 + ec + 4 * j);
            const unsigned gw_[8] = {gg[0].x, gg[0].y, gg[0].z, gg[0].w, gg[1].x, gg[1].y, gg[1].z, gg[1].w};
            unsigned res[8];
#pragma unroll
            for (int e = 0; e < 8; ++e) { const float ga = gain[e >> 1][(e & 1) * 2], gb = gain[e >> 1][(e & 1) * 2 + 1];
                res[e] = cvtpk(ov[2 * e] * rstd * ga * bflo(gw_[e]), ov[2 * e + 1] * rstd * gb * bfhi(gw_[e])); }
            bf16_t* mp = MIX + (size_t)(row0 + etok) * D + h * 128 + ec;
            *(u32x4*)mp = (u32x4){res[0], res[1], res[2], res[3]}; *(u32x4*)(mp + 8) = (u32x4){res[4], res[5], res[6], res[7]};
        }
        __syncthreads();
    }
}

__device__ __forceinline__ void hgrn_sample_unit(Frame& F, int unit, int layer) {
    unsigned char* ws = F.ws;
    const int bs = unit / 6, h = unit % 6, row = MP + bs, tid = F.tid, v4 = tid & 31, chg = tid >> 5;
    const float* LF = WSP(float, WS_LF); const bf16_t* KK = WSP(bf16_t, WS_KK); const bf16_t* VV = WSP(bf16_t, WS_VV); const bf16_t* QS = WSP(bf16_t, WS_QS); const bf16_t* GG = WSP(bf16_t, WS_GG);
    const size_t e0 = (size_t)row * HW + h * 128;
    const float* S0 = in_ptr(4) + ((size_t)(layer * BS + bs) * 6 + h) * 16384; float* SN = F.out + O_HS + ((size_t)(layer * BS + bs) * 6 + h) * 16384;
    f32x4 vv; { const u32x2 w = *(const u32x2*)(VV + e0 + 4 * v4); vv = (f32x4){bflo(w.x), bfhi(w.x), bflo(w.y), bfhi(w.y)}; }
    f32x4 oacc = {0.f, 0.f, 0.f, 0.f};
#pragma unroll
    for (int i = 0; i < 8; ++i) { const int ch = chg + 16 * i; const float f = fexp(LF[e0 + ch]), k = bf2f(KK[e0 + ch]), q = bf2f(QS[e0 + ch]);
        const f32x4 s0 = *(const f32x4*)(S0 + (size_t)ch * 128 + 4 * v4); const f32x4 sn = s0 * f + vv * k; *(f32x4*)(SN + (size_t)ch * 128 + 4 * v4) = sn; oacc = oacc + sn * q; }
    LAS float* red = (LAS float*)F.lds;
    *(LAS f32x4*)(red + chg * 128 + 4 * v4) = oacc;
    __syncthreads();
    if (tid < 128) { float o = 0.f;
#pragma unroll
        for (int j = 0; j < 16; ++j) o += red[j * 128 + tid];
        float ss = wave_sum(o * o); LAS float* part = red + 2048; if (F.lane == 0) part[F.wave] = ss;
        red[2064 + tid] = o; }
    __syncthreads();
    if (tid < 128) { const float ss = red[2048] + red[2049]; const float rstd = rsqrtf(ss * (1.f / 128.f) + EPS); const float o = red[2064 + tid];
        WSP(bf16_t, WS_MIX)[(size_t)row * D + h * 128 + tid] = f2bf(o * rstd * in_ptr(12)[layer * HW + h * 128 + tid] * bf2f(GG[e0 + tid])); }
    __syncthreads();
}

constexpr int AL_K = 0, AL_KROW = 144, AL_NK = 272;
constexpr int AL_V = AL_K + AL_NK * AL_KROW, AL_VROW = 560;
static_assert(AL_V + 64 * AL_VROW <= RING_BYTES, "attention lds");
__device__ __forceinline__ void attn_stage(LAS unsigned char* lds, const bf16_t* Kg, const bf16_t* Vg, int ldv, int nk, int tid) {
    for (int p = tid; p < nk * 8; p += NTHR) { const int row = p >> 3, c = p & 7; *(LAS u32x4*)(lds + AL_K + row * AL_KROW + c * 16) = *(const u32x4*)(Kg + (size_t)row * 64 + c * 8); }
    const int ppr = nk >> 3;
    for (int p = tid; p < 64 * ppr; p += NTHR) { const int row = p / ppr, c = p - row * ppr; *(LAS u32x4*)(lds + AL_V + row * AL_VROW + c * 16) = *(const u32x4*)(Vg + (size_t)row * ldv + c * 8); }
}
template <int NKB, bool SWA>
__device__ __forceinline__ void attn16(const bf16_t* Qrow0, int q_ld, LAS const unsigned char* lds, int koff, bf16_t* Orow0, int o_ld, float sink2, bool has_sink, int t0, int lane) {
    constexpr int NKS = (NKB + 1) / 2, NKP = 2 * NKS;
    const int fr = lane & 15, g = lane >> 4;
    LAS const unsigned char* Kl = lds + AL_K + (koff + fr) * AL_KROW + g * 16;
    LAS const unsigned char* Vl = lds + AL_V + fr * AL_VROW + (koff + 4 * g) * 2;
    bf16x8 qf[2];
#pragma unroll
    for (int ks = 0; ks < 2; ++ks) qf[ks] = *(const bf16x8*)(Qrow0 + (size_t)fr * q_ld + ks * 32 + g * 8);
    f32x4 s[NKP];
#pragma unroll
    for (int blk = 0; blk < NKP; ++blk) { s[blk] = (f32x4){0.f, 0.f, 0.f, 0.f};
        if (blk < NKB) {
#pragma unroll
            for (int ks = 0; ks < 2; ++ks) { const bf16x8 kf = *(const LAS bf16x8*)(Kl + blk * 16 * AL_KROW + ks * 64); s[blk] = mfma16(kf, qf[ks], s[blk]); } }
        if ((blk & 3) == 3) asm volatile("" ::: "memory"); }
    float m = -1e30f;
    if (SWA) { const int lo = max(fr + 1, 128 - t0), hi = fr + 128;
#pragma unroll
        for (int blk = 0; blk < NKP; ++blk)
#pragma unroll
            for (int i = 0; i < 4; ++i) { const int kidx = 16 * blk + 4 * g + i; if (blk >= NKB || kidx < lo || kidx > hi) s[blk][i] = -1e30f; } }
#pragma unroll
    for (int blk = 0; blk < NKB; ++blk)
#pragma unroll
        for (int i = 0; i < 4; ++i) m = fmaxf(m, s[blk][i]);
    m = fmaxf(m, __shfl_xor(m, 16)); m = fmaxf(m, __shfl_xor(m, 32));
    if (has_sink) m = fmaxf(m, sink2);
    float l = 0.f;
#pragma unroll
    for (int blk = 0; blk < NKP; ++blk)
#pragma unroll
        for (int i = 0; i < 4; ++i) { const float p = (blk < NKB) ? __builtin_amdgcn_exp2f(s[blk][i] - m) : 0.f; s[blk][i] = p; l += p; }
    l += __shfl_xor(l, 16); l += __shfl_xor(l, 32);
    if (has_sink) l += __builtin_amdgcn_exp2f(sink2 - m);
    const float inv = __builtin_amdgcn_rcpf(l);
    f32x4 o[4];
#pragma unroll
    for (int db = 0; db < 4; ++db) o[db] = (f32x4){0.f, 0.f, 0.f, 0.f};
#pragma unroll
    for (int ks = 0; ks < NKS; ++ks) {
        u32x4 pw; pw.x = cvtpk(s[2 * ks][0], s[2 * ks][1]); pw.y = cvtpk(s[2 * ks][2], s[2 * ks][3]); pw.z = cvtpk(s[2 * ks + 1][0], s[2 * ks + 1][1]); pw.w = cvtpk(s[2 * ks + 1][2], s[2 * ks + 1][3]);
        const bf16x8 pf = __builtin_bit_cast(bf16x8, pw);
#pragma unroll
        for (int db = 0; db < 4; ++db) { LAS const unsigned char* vp = Vl + db * 16 * AL_VROW + ks * 64;
            const u32x2 lo = *(const LAS u32x2*)vp, hi = *(const LAS u32x2*)(vp + 32); u32x4 vw; vw.x = lo.x; vw.y = lo.y; vw.z = hi.x; vw.w = hi.y;
            o[db] = mfma16(__builtin_bit_cast(bf16x8, vw), pf, o[db]); }
        asm volatile("" ::: "memory"); }
#pragma unroll
    for (int db = 0; db < 4; ++db) { u32x2 wv; wv.x = cvtpk(o[db][0] * inv, o[db][1] * inv); wv.y = cvtpk(o[db][2] * inv, o[db][3] * inv);
        *(u32x2*)(Orow0 + (size_t)fr * o_ld + 16 * db + 4 * g) = wv; }
}

__device__ __forceinline__ void memattn_wg(Frame& F, int u, int layer) {
    unsigned char* ws = F.ws;
    const int qc = u & 31, h = (u >> 5) & 3, b = u >> 7;
    const bf16_t* Kb = WSP(bf16_t, WS_MKB) + (size_t)((layer * 2 + b) * 4 + h) * 256 * 64; const bf16_t* Vb = WSP(bf16_t, WS_MVT) + (size_t)((layer * 2 + b) * 4 + h) * 64 * 256;
    attn_stage(F.lds, Kb, Vb, 256, 256, F.tid);
    __syncthreads();
    const bf16_t* CQ = WSP(bf16_t, WS_CQ); bf16_t* MIX = WSP(bf16_t, WS_MIX);
#pragma unroll 1
    for (int j = 0; j < 2; ++j) { const int row0 = b * SEQ + qc * 256 + (F.wave + 8 * j) * 16;
        attn16<16, false>(CQ + (size_t)row0 * XW + h * 64, XW, F.lds, 0, MIX + (size_t)row0 * D + HW + h * 64, D, 0.f, false, 0, F.lane); }
    __syncthreads();
}
__device__ __forceinline__ void swa_wg(Frame& F, int u, int j) {
    unsigned char* ws = F.ws;
    const int qc = u & 63, kvh = (u >> 6) & 3, b = u >> 8, tq0 = qc * 128;
    const bf16_t* Kb = WSP(bf16_t, WS_KR) + ((size_t)(b * 4 + kvh) * KVP + tq0) * 64; const bf16_t* Vb = WSP(bf16_t, WS_VT) + (size_t)(b * 4 + kvh) * 64 * KVP + tq0;
    attn_stage(F.lds, Kb, Vb, KVP, AL_NK, F.tid);
    __syncthreads();
    const bf16_t* QR = WSP(bf16_t, WS_QS); bf16_t* MIX = WSP(bf16_t, WS_MIX);
    const int t0 = tq0 + F.wave * 16, row0 = b * SEQ + t0;
#pragma unroll 1
    for (int gi = 0; gi < 3; ++gi) { const int hq = kvh * 3 + gi;
        attn16<9, true>(QR + (size_t)row0 * HW + hq * 64, HW, F.lds, F.wave * 16, MIX + (size_t)row0 * D + hq * 64, D, in_ptr(14)[j * 12 + hq] * LOG2E, true, t0, F.lane); }
    __syncthreads();
}

__device__ __forceinline__ void memattn_sample_wg(Frame& F, int u8, int layer) {
    unsigned char* ws = F.ws;
    const int lane = F.lane;
    LAS float* sc = (LAS float*)(F.lds + F.wave * 4096);
    const bf16_t* CQ = WSP(bf16_t, WS_CQ); bf16_t* MIX = WSP(bf16_t, WS_MIX);
    { const int u = u8 * 8 + F.wave; const int bs = u >> 2, h = u & 3, row = MP + bs;
        sc[lane] = bf2f(CQ[(size_t)row * XW + h * 64 + lane]);
        LDS_WAIT();
        const float* Kc = in_ptr(2) + ((size_t)(layer * BS + bs) * 256) * 256 + h * 64; const float* Vc = in_ptr(3) + ((size_t)(layer * BS + bs) * 256) * 256 + h * 64;
        float s[4] = {0.f, 0.f, 0.f, 0.f};
#pragma unroll 4
        for (int d4 = 0; d4 < 16; ++d4) { const f32x4 q = *(const LAS f32x4*)(sc + 4 * d4);
#pragma unroll
            for (int i = 0; i < 4; ++i) { const f32x4 k = *(const f32x4*)(Kc + (size_t)(lane + 64 * i) * 256 + 4 * d4); s[i] += (k.x * q.x + k.y * q.y) + (k.z * q.z + k.w * q.w); } }
        float m = fmaxf(fmaxf(s[0], s[1]), fmaxf(s[2], s[3]));
#pragma unroll
        for (int o = 1; o < 64; o <<= 1) m = fmaxf(m, __shfl_xor(m, o));
        float l = 0.f;
#pragma unroll
        for (int i = 0; i < 4; ++i) { s[i] = __builtin_amdgcn_exp2f(s[i] - m); l += s[i]; sc[64 + lane + 64 * i] = s[i]; }
        l = wave_sum(l);
        LDS_WAIT();
        float o = 0.f;
#pragma unroll 8
        for (int mm = 0; mm < 256; ++mm) o += sc[64 + mm] * Vc[(size_t)mm * 256 + lane];
        MIX[(size_t)row * D + HW + h * 64 + lane] = f2bf(o / l);
        LDS_WAIT();
    }
    __syncthreads();
}

__device__ __forceinline__ void swa_sample_wg(Frame& F, int u8, int j) {
    unsigned char* ws = F.ws;
    const int lane = F.lane;
    LAS float* sc = (LAS float*)(F.lds + F.wave * 4096);
    const bf16_t* QR = WSP(bf16_t, WS_QS); bf16_t* MIX = WSP(bf16_t, WS_MIX);
    const float* KSN = WSP(float, WS_KSN); const float* VSN = WSP(float, WS_VSN);
    { const int u = u8 * 8 + F.wave; const int bs = u >> 2, kvh = u & 3, row = MP + bs;
        const int pd = 2 * (lane & 31) + (lane >> 5);
#pragma unroll
        for (int gi = 0; gi < 3; ++gi) sc[gi * 64 + lane] = bf2f(QR[(size_t)row * HW + (kvh * 3 + gi) * 64 + pd]);
        LDS_WAIT();
        float s[3][2];
#pragma unroll
        for (int kk = 0; kk < 2; ++kk) { const int key = lane + 64 * kk;
            const float* kp = key < 127 ? in_ptr(5) + ((size_t)(bs * 128 + key + 1) * 4 + kvh) * 64 : KSN + (size_t)(bs * 4 + kvh) * 64;
            float* ko = F.out + O_SKS + ((size_t)(bs * 128 + key) * 4 + kvh) * 64;
            float a0 = 0.f, a1 = 0.f, a2 = 0.f;
#pragma unroll 4
            for (int d4 = 0; d4 < 16; ++d4) { const f32x4 k = *(const f32x4*)(kp + 4 * d4); if (j == 0 && key < 127) *(f32x4*)(ko + 4 * d4) = k;
                const f32x4 q0 = *(const LAS f32x4*)(sc + 4 * d4), q1 = *(const LAS f32x4*)(sc + 64 + 4 * d4), q2 = *(const LAS f32x4*)(sc + 128 + 4 * d4);
                a0 += (k.x * q0.x + k.y * q0.y) + (k.z * q0.z + k.w * q0.w); a1 += (k.x * q1.x + k.y * q1.y) + (k.z * q1.z + k.w * q1.w); a2 += (k.x * q2.x + k.y * q2.y) + (k.z * q2.z + k.w * q2.w); }
            s[0][kk] = a0; s[1][kk] = a1; s[2][kk] = a2; }
        float linv[3];
#pragma unroll
        for (int gi = 0; gi < 3; ++gi) { const float sink2 = in_ptr(14)[j * 12 + kvh * 3 + gi] * LOG2E; float m = fmaxf(s[gi][0], s[gi][1]);
#pragma unroll
            for (int o = 1; o < 64; o <<= 1) m = fmaxf(m, __shfl_xor(m, o));
            m = fmaxf(m, sink2);
            const float p0 = __builtin_amdgcn_exp2f(s[gi][0] - m), p1 = __builtin_amdgcn_exp2f(s[gi][1] - m);
            sc[192 + gi * 128 + lane] = p0; sc[192 + gi * 128 + 64 + lane] = p1;
            linv[gi] = 1.0f / (wave_sum(p0 + p1) + __builtin_amdgcn_exp2f(sink2 - m)); }
        LDS_WAIT();
        float o0 = 0.f, o1 = 0.f, o2 = 0.f;
#pragma unroll 4
        for (int key = 0; key < 128; ++key) { const float v = key < 127 ? in_ptr(6)[((size_t)(bs * 128 + key + 1) * 4 + kvh) * 64 + lane] : VSN[(size_t)(bs * 4 + kvh) * 64 + lane];
            if (j == 0 && key < 127) F.out[O_SVS + ((size_t)(bs * 128 + key) * 4 + kvh) * 64 + lane] = v;
            o0 += sc[192 + key] * v; o1 += sc[192 + 128 + key] * v; o2 += sc[192 + 256 + key] * v; }
        MIX[(size_t)row * D + (kvh * 3 + 0) * 64 + lane] = f2bf(o0 * linv[0]);
        MIX[(size_t)row * D + (kvh * 3 + 1) * 64 + lane] = f2bf(o1 * linv[1]);
        MIX[(size_t)row * D + (kvh * 3 + 2) * 64 + lane] = f2bf(o2 * linv[2]);
        LDS_WAIT();
    }
    __syncthreads();
}

__device__ __forceinline__ int q_pull(Frame& F, unsigned* ctr) {
    volatile LAS int* slot = (volatile LAS int*)(F.lds + MISC_OFF + 64);
    __syncthreads();
    if (F.tid == 0) *slot = (int)__hip_atomic_fetch_add(ctr, 1u, __ATOMIC_RELAXED, __HIP_MEMORY_SCOPE_AGENT);
    __syncthreads();
    { int t_ = F.tid; asm volatile("" : "+v"(t_)); F.tid = t_; F.lane = t_ & 63; }
    return *slot;
}

enum { OP_PROLOGUE = 0, OP_GEMM, OP_MIXA, OP_H2, OP_H3, OP_MIXB, OP_NORM };
struct Phase { int op, layer; unsigned long long aoff, boff; int M, N, K, ekind, cshift, nobar; };
#define PH_GEMM(l, A, B, M, N, K, ek, cs, nb) {OP_GEMM, l, A, B, M, N, K, ek, cs, nb}
#define PH_MLP(l) PH_GEMM(l, WS_MIX, WS_WOUT + (size_t)(l) * 2097152, MT, D, D, EK_F32, 0, 0), {OP_NORM, l, 0, 0, 0, 0, 0, 19, 0, 0}, \
    PH_GEMM(l, WS_XN, WS_WUP + (size_t)(l) * 8388608, MT, FF, D, EK_UP, 0, 0), PH_GEMM(l, WS_HB, WS_WDN + (size_t)(l) * 8388608, MT, D, FF, EK_F32, 0, 0), {OP_NORM, l, 0, 0, (l) == 3, 0, 0, 21, 0, 0}
__constant__ Phase c_prog[] = {
    {OP_PROLOGUE, 0, 0, 0, 0, 0, 0, 0, 0, 0},
    PH_GEMM(0, WS_MN, WS_WMEM, 512, 2048, D, EK_MEMKV, 16, 1),
    PH_GEMM(0, WS_XN, WS_WINA, MT, NA, D, EK_INA, 0, 0),
    {OP_MIXA, 0, 0, 0, 0, 0, 0, 0, 0, 0}, {OP_H2, 0, 0, 0, 0, 0, 0, 0, 0, 0}, {OP_H3, 0, 0, 0, 0, 0, 0, 0, 0, 0}, PH_MLP(0),
    PH_GEMM(1, WS_XN, WS_WINA + SZ_WINA, MT, NA, D, EK_INA, 0, 0),
    {OP_MIXA, 1, 0, 0, 0, 0, 0, 0, 0, 0}, {OP_H2, 1, 0, 0, 0, 0, 0, 0, 0, 0}, {OP_H3, 1, 0, 0, 0, 0, 0, 0, 0, 0}, PH_MLP(1),
    PH_GEMM(0, WS_XN, WS_WINB0, MT, 1536, D, EK_INB, 0, 0),
    {OP_MIXB, 2, 0, 0, 0, 0, 0, 0, 0, 0}, PH_MLP(2),
    PH_GEMM(1, WS_XN, WS_WINB1, MT, 1024, D, EK_INB, 0, 0),
    {OP_MIXB, 3, 0, 0, 0, 0, 0, 0, 0, 0}, PH_MLP(3),
};
constexpr int NPHASE = sizeof(c_prog) / sizeof(Phase);

__global__ void __launch_bounds__(NTHR, 2) yoco_fwd(Args args) {
    extern __shared__ __attribute__((aligned(16))) unsigned char lds_raw[];
    Frame F;
    F.lds = (LAS unsigned char*)lds_raw;
    F.tid = threadIdx.x; F.lane = F.tid & 63; F.wave = __builtin_amdgcn_readfirstlane(F.tid >> 6);
    F.G = gridDim.x; { const int bx = blockIdx.x; F.vcu = (F.G % 8 == 0) ? (bx % 8) * (F.G / 8) + bx / 8 : bx; }
    F.ws = args.ws; F.out = args.out;
    unsigned char* ws = F.ws;
    for (int u = F.tid; u < (LDS_BYTES - LDSCTL_OFF) / 4; u += NTHR) ((LAS unsigned*)(F.lds + LDSCTL_OFF))[u] = 0u;
    __syncthreads();
    XcdBarrier bar = xcd_barrier_post((unsigned*)(ws + WS_CTL) + 4096, (volatile LAS unsigned*)(F.lds + MISC_OFF) + 8);
#define GRID_BAR() xcd_barrier(bar)
    const int G = F.G, bx = blockIdx.x;

#pragma unroll 1
    for (int ph = 0; ph < NPHASE; ++ph) {
        const Phase P = c_prog[ph];
        const int l = P.layer;
        unsigned* qctr = (unsigned*)(ws + WS_CTL) + 8192 + 64 * ph;
        { int t_ = threadIdx.x; asm volatile("" : "+v"(t_)); F.tid = t_; F.lane = t_ & 63; F.wave = __builtin_amdgcn_readfirstlane(t_ >> 6); }
#ifndef PROBE_DUP_MASK
#define PROBE_DUP_MASK 0
#endif
        const int reps_ = ((PROBE_DUP_MASK >> P.op) & 1) ? 2 : 1;
#pragma unroll 1
        for (int rep_ = 0; rep_ < reps_; ++rep_) {
        switch (P.op) {
        case OP_PROLOGUE: p0_prologue(F); break;
        case OP_GEMM: {
            pg8::Gemm g{(const bf16_t*)(ws + P.aoff), (const bf16_t*)(ws + P.boff), P.M, P.N, P.K}; pg8::StaticOrder S; S.init(P.M, P.N, G, (bx + P.cshift) % G);
            Epi E{P.ekind, l, F.ws, F.out}; pg8::gemm_phase(F.lds, g, S, E, F.tid);
        } break;
        case OP_MIXA:
            if (F.vcu < HS_UNITS) hgrn_pass1_unit(F, F.vcu);
            for (;;) { const int i = q_pull(F, qctr); if (i >= 256) break; memattn_wg(F, i, l); }
            break;
        case OP_H2: hgrn_pass2(F, l); break;
        case OP_H3:
            if (F.vcu < HS_UNITS) hgrn_pass3_unit(F, F.vcu, l);
            for (;;) { const int i = q_pull(F, qctr); if (i >= 768 + 64) break; if (i < 768) hgrn_sample_unit(F, i, l); else memattn_sample_wg(F, i - 768, l); }
            break;
        case OP_MIXB:
            for (;;) { const int i = q_pull(F, qctr); if (i >= 896) break;
                if (i < 512) swa_wg(F, i, l - 2); else if (i < 768) memattn_wg(F, i - 512, l); else if (i < 832) swa_sample_wg(F, i - 768, l - 2); else memattn_sample_wg(F, i - 832, l); }
            break;
        case OP_NORM: norm_phase(F, in_ptr(P.ekind) + l * D, P.M != 0); break;
        default: break;
        }
        if (!P.nobar || reps_ > 1) GRID_BAR();
        }
    }
}

extern "C" void kernel_launch(void* const* d_in, const int* in_sizes, int n_in, void* d_out, int out_size, void* d_ws, size_t ws_size, hipStream_t stream) {
    static int grid = 0;
    if (grid == 0) {
        if (n_in != 24 || (size_t)out_size != O_END || ws_size < WS_END) { fprintf(stderr, "kernel_launch: unexpected shapes: n_in %d out %d ws %zu (need %zu)\n", n_in, out_size, ws_size, (size_t)WS_END); grid = -1; return; }
        int dev = 0, cus = 0, per_cu = 0;
        if (hipGetDevice(&dev) != hipSuccess || hipDeviceGetAttribute(&cus, hipDeviceAttributeMultiprocessorCount, dev) != hipSuccess) { grid = -1; return; }
        if (hipFuncSetAttribute((const void*)yoco_fwd, hipFuncAttributeMaxDynamicSharedMemorySize, LDS_BYTES) != hipSuccess) { fprintf(stderr, "kernel_launch: hipFuncSetAttribute failed\n"); grid = -1; return; }
        if (hipOccupancyMaxActiveBlocksPerMultiprocessor(&per_cu, (const void*)yoco_fwd, NTHR, LDS_BYTES) != hipSuccess || per_cu < 1) { fprintf(stderr, "kernel_launch: occupancy query says %d blocks per CU\n", per_cu); (void)hipGetLastError(); grid = -1; return; }
        grid = cus;
    }
    if (grid < 0) return;
    (void)hipMemsetAsync((char*)d_ws + WS_CTL, 0, CTL_BYTES, stream);
    Args a{};
    for (int i = 0; i < 24; ++i) a.in[i] = (const float*)d_in[i];
    a.out = (float*)d_out; a.ws = (unsigned char*)d_ws;
    void* params[] = {&a};
    hipError_t e = hipLaunchCooperativeKernel((const void*)yoco_fwd, dim3(grid), dim3(NTHR), params, LDS_BYTES, stream);
    if (e != hipSuccess) fprintf(stderr, "kernel_launch: cooperative launch failed: %s (grid %d)\n", hipGetErrorString(e), grid);
}
```

```cpp
#include <hip/hip_runtime.h>
#include <cstdio>
#include <cstdint>

#define LAS __attribute__((address_space(3)))
#define GAS __attribute__((address_space(1)))
typedef unsigned short bf16_t;
typedef short bf16x8 __attribute__((ext_vector_type(8)));
typedef short s16x4 __attribute__((ext_vector_type(4)));
typedef float f32x4 __attribute__((ext_vector_type(4)));
typedef float f32x2 __attribute__((ext_vector_type(2)));
typedef unsigned u32x4 __attribute__((ext_vector_type(4)));
typedef unsigned u32x2 __attribute__((ext_vector_type(2)));
typedef __bf16 bf16x2_t __attribute__((ext_vector_type(2)));

constexpr int D = 1024, SEQ = 8192, BP = 2, MP = BP * SEQ, BS = 128, MT = 16640  ;
constexpr int FF = 4096, NA = 3328, HW = 768, XW = 256, NMEM = 256;
constexpr int KVP = 128 + SEQ + 32;
constexpr float QSCALE = 0.18033688011112042f;
constexpr float LOG2E = 1.4426950408889634f;
constexpr float EPS = 1e-6f;
constexpr int NWAVES = 8, NTHR = 512;

constexpr size_t O_YP = 0, O_YS = O_YP + (size_t)MP * D, O_MK = O_YS + (size_t)BS * D, O_MV = O_MK + 524288, O_HP = O_MV + 524288,
                 O_SKP = O_HP + 393216, O_SVP = O_SKP + 65536, O_HS = O_SVP + 65536, O_SKS = O_HS + 25165824, O_SVS = O_SKS + 4194304, O_END = O_SVS + 4194304;

constexpr size_t al256(size_t x) { return (x + 255) & ~(size_t)255; }
constexpr size_t WS_CTL = 0, CTL_BYTES = 1u << 20;
constexpr size_t WS_WMEM = WS_CTL + CTL_BYTES;
constexpr size_t WS_WINA = WS_WMEM + (size_t)2048 * 1024 * 2;
constexpr size_t SZ_WINA = (size_t)NA * 1024 * 2;
constexpr size_t WS_WINB0 = WS_WINA + 2 * SZ_WINA;
constexpr size_t WS_WINB1 = WS_WINB0 + (size_t)1536 * 1024 * 2;
constexpr size_t WS_WOUT = WS_WINB1 + (size_t)1024 * 1024 * 2;
constexpr size_t WS_WUP = WS_WOUT + (size_t)4 * 1024 * 1024 * 2;
constexpr size_t WS_WDN = WS_WUP + (size_t)4 * 4096 * 1024 * 2;
constexpr size_t WS_H = WS_WDN + (size_t)4 * 4096 * 1024 * 2;
constexpr size_t WS_XN = WS_H + (size_t)MT * D * 4;
constexpr size_t WS_MN = WS_XN + (size_t)MT * D * 2;
constexpr size_t WS_ROPE = WS_MN + (size_t)512 * D * 2;
constexpr size_t WS_MKB = al256(WS_ROPE + (size_t)8193 * 32 * 8);
constexpr size_t WS_MVT = WS_MKB + (size_t)4 * 2 * 4 * 256 * 64 * 2;
constexpr size_t WS_KR = WS_MVT + (size_t)4 * 2 * 4 * 256 * 64 * 2;
constexpr size_t WS_VT = WS_KR + (size_t)2 * 4 * KVP * 64 * 2;
constexpr size_t WS_KSN = WS_VT + (size_t)2 * 4 * KVP * 64 * 2;
constexpr size_t WS_VSN = WS_KSN + (size_t)128 * 256 * 4;
constexpr size_t WS_ASEG = WS_VSN + (size_t)128 * 256 * 4;
constexpr size_t WS_RS2 = WS_ASEG + (size_t)12 * 16 * 128 * 4;
constexpr size_t WS_LBS = WS_RS2 + (size_t)MP * 4;
constexpr size_t WS_XCH = al256(WS_LBS + (size_t)2 * 768 * 4);
constexpr size_t WS_SMP = WS_XCH + (size_t)16 * 65536 * 8;
#define SBUF(T, off) ((T*)(ws + WS_SMP + (off)))
constexpr size_t SB_H0 = 0, SB_H1 = SB_H0 + (size_t)BS * D * 4, SB_Y1 = SB_H1 + (size_t)BS * D * 4, SB_Y2 = SB_Y1 + (size_t)BS * D * 4;
constexpr size_t SB_QS = SB_Y2 + (size_t)4 * BS * D * 4, SB_KK = SB_QS + (size_t)BS * HW * 2, SB_VV = SB_KK + (size_t)BS * HW * 2, SB_GG = SB_VV + (size_t)BS * HW * 2;
constexpr size_t SB_LF = SB_GG + (size_t)BS * HW * 2, SB_CQ = SB_LF + (size_t)BS * HW * 4, SB_MIX = SB_CQ + (size_t)BS * XW * 2, SB_HB = SB_MIX + (size_t)BS * D * 2, SB_END = SB_HB + (size_t)BS * FF * 2;

constexpr size_t WS_OV = al256(WS_SMP + SB_END);
constexpr size_t WS_MIX = WS_OV;
constexpr size_t WS_Y = WS_MIX + (size_t)MT * D * 2;
constexpr size_t WS_HB = WS_Y + (size_t)MT * D * 4;
constexpr size_t WS_QS = WS_MIX + (size_t)MT * D * 2;
constexpr size_t SZ_P768 = (size_t)MT * HW * 2;
constexpr size_t WS_KK = WS_QS + SZ_P768, WS_VV = WS_KK + SZ_P768, WS_GG = WS_VV + SZ_P768;
constexpr size_t WS_LF = WS_GG + SZ_P768;
constexpr size_t WS_CQ = WS_LF + (size_t)MT * HW * 4;
constexpr size_t WS_USEG = WS_CQ + (size_t)MT * XW * 2;
constexpr size_t WS_SST = WS_USEG + (size_t)12 * 16 * 16384 * 4;
constexpr size_t WS_END_A = WS_SST + (size_t)12 * 16 * 16384 * 4;
constexpr size_t WS_END_B = WS_HB + (size_t)MT * FF * 2;
constexpr size_t WS_END = WS_END_A > WS_END_B ? WS_END_A : WS_END_B;

constexpr int RING_BYTES = 131072, LDSCTL_OFF = RING_BYTES, MISC_OFF = LDSCTL_OFF + 320, LDS_BYTES = 147456;

__device__ __forceinline__ unsigned cvtpk(float lo, float hi) { f32x2 v = {lo, hi}; bf16x2_t b = __builtin_convertvector(v, bf16x2_t); return __builtin_bit_cast(unsigned, b); }
__device__ __forceinline__ bf16_t f2bf(float f) { return (bf16_t)(cvtpk(f, 0.f) & 0xffffu); }
__device__ __forceinline__ float bf2f(bf16_t x) { return __uint_as_float((unsigned)x << 16); }
__device__ __forceinline__ float bflo(unsigned w) { return __uint_as_float(w << 16); }
__device__ __forceinline__ float bfhi(unsigned w) { return __uint_as_float(w & 0xffff0000u); }
__device__ __forceinline__ f32x4 zero4() { float z = 0.f; asm volatile("" : "+v"(z)); return (f32x4){z, z, z, z}; }
__device__ __forceinline__ float wave_sum(float v) {
#pragma unroll
    for (int o = 1; o < 64; o <<= 1) v += __shfl_xor(v, o);
    return v;
}
__device__ __forceinline__ float fexp(float x) { return __builtin_amdgcn_exp2f(x * 1.4426950408889634f); }
__device__ __forceinline__ float flog(float x) { return __builtin_amdgcn_logf(x) * 0.6931471805599453f; }
__device__ __forceinline__ float fsigmoid(float x) { return __builtin_amdgcn_rcpf(1.0f + fexp(-x)); }
__device__ __forceinline__ float fsilu(float x) { return x * __builtin_amdgcn_rcpf(1.0f + fexp(-x)); }
#define LDS_WAIT() asm volatile("s_waitcnt lgkmcnt(0)" ::: "memory")
#define VM_WAIT() asm volatile("s_waitcnt vmcnt(0)" ::: "memory")

struct Args { const float* in[24]; float* out; unsigned char* ws; };
typedef const float* cfptr_t;
__device__ __forceinline__ const float* in_ptr(int i) { return ((const __attribute__((address_space(4))) cfptr_t*)__builtin_amdgcn_kernarg_segment_ptr())[i]; }

namespace pg8 {
constexpr int BM = 256, BK = 64, HALF = 128, HTB = HALF * BK * 2, STAGE_BYTES = 8 * HTB, NXCD = 8, WGM = 8;
__host__ __device__ __forceinline__ int lds_byte(int r, int c) { const int st = (r >> 4) * 2 + (c >> 5), rr = r & 15, cc = c & 31, ob = rr * 64 + cc * 2; return st * 1024 + (ob ^ (((ob >> 9) & 1) << 5)); }
__host__ __device__ __forceinline__ void stage_rc(int b, int& R, int& C) { const int st = b / 1024, sb = b % 1024, swz = sb ^ (((sb >> 9) & 1) << 5); R = (st >> 1) * 16 + swz / 64; C = (st & 1) * 32 + (swz % 64) / 2; }
__host__ __device__ __forceinline__ int perm32(int rho) { const int n = rho >> 4, i = rho & 15; return 8 * (i >> 2) + 4 * n + (i & 3); }
struct Unit { int pm, pn; };
struct Gemm { const bf16_t* A; const bf16_t* Bt; int M, N, K; };
struct StaticOrder {
    int nM, nN, nwg, G, c;
    __device__ void init(int M, int N, int G_, int c_) { nM = M / BM; nN = N / BM; nwg = nM * nN; G = G_; c = c_; }
    __device__ bool next(int i, Unit& u) const {
        const long L = (long)i * G + c; if (L >= nwg) return false;
        int wgid = (int)L; { const int q = nwg / NXCD, r = nwg % NXCD, xcd = wgid % NXCD, off = wgid / NXCD; wgid = (xcd < r ? xcd * (q + 1) : r * (q + 1) + (xcd - r) * q) + off; }
        const int nig = WGM * nN, gid = wgid / nig, fm = gid * WGM, gsz = (nM - fm) < WGM ? (nM - fm) : WGM;
        u.pm = fm + ((wgid % nig) % gsz); u.pn = (wgid % nig) / gsz; return true;
    }
};

template <bool AFTER_DRAIN, class Epi>
__device__ __forceinline__ void gemm_phase(LAS unsigned char* lds, const Gemm g, const StaticOrder& S, const Epi& E, const int tid) {
    const int wid = __builtin_amdgcn_readfirstlane(tid >> 6), lane = tid & 63, wr = wid >> 2, wc = wid & 3, fr = lane & 15, fq = lane >> 4;
    const int K = g.K, nt = K / BK;
    unsigned voffA[2], voffB[2];
#pragma unroll
    for (int i = 0; i < 2; ++i) { int R, C; stage_rc(tid * 16 + i * 8192, R, C); const int Rb = (R & ~31) + perm32(R & 31);
        voffA[i] = (unsigned)(R * K + C) * 2u; voffB[i] = (unsigned)(Rb * K + C) * 2u; }
    const size_t kstep = (size_t)(BK * 2);
    const size_t hstep = (size_t)HALF * K * 2;
    const size_t tstep = 2 * hstep;
    const unsigned ldsw = (unsigned)wid * 1024u;
    const int aoff = lds_byte(wr * 64 + fr, fq * 8), boff = lds_byte(wc * 32 + fr, fq * 8);
#define PG8_SA(b, h) (((b) * 2 + (h)) * HTB)
#define PG8_SB(b, h) ((4 + (b) * 2 + (h)) * HTB)
#define PG8_STAGE(bufoff, gbase, voff) do { _Pragma("unroll") for (int _i = 0; _i < 2; ++_i) \
        __builtin_amdgcn_global_load_lds((const unsigned*)((const char*)(gbase) + (voff)[_i]), (LAS unsigned*)(lds + (bufoff) + ldsw + _i * 8192), 16, 0, 0); } while (0)
#define PG8_LDA(dst, b, h) do { _Pragma("unroll") for (int m = 0; m < 4; ++m) _Pragma("unroll") for (int k = 0; k < 2; ++k) dst[m][k] = *(const LAS bf16x8*)(lds + PG8_SA(b, h) + aoff + m * 2048 + k * 1024); } while (0)
#define PG8_LDB(dst, b, h) do { _Pragma("unroll") for (int n = 0; n < 2; ++n) _Pragma("unroll") for (int k = 0; k < 2; ++k) dst[n][k] = *(const LAS bf16x8*)(lds + PG8_SB(b, h) + boff + n * 2048 + k * 1024); } while (0)
#define PG8_MMA(ai, bj, At, Bt) do { __builtin_amdgcn_s_setprio(1); _Pragma("unroll") for (int m = 0; m < 4; ++m) _Pragma("unroll") for (int n = 0; n < 2; ++n) _Pragma("unroll") for (int k = 0; k < 2; ++k) \
        acc[ai][bj][m][n] = __builtin_amdgcn_mfma_f32_16x16x32_bf16(Bt[n][k], At[m][k], acc[ai][bj][m][n], 0, 0, 0); __builtin_amdgcn_s_setprio(0); } while (0)
#define PG8_WAIT_V(n) asm volatile("s_waitcnt vmcnt(" #n ")" ::: "memory")
#define PG8_WAIT_L(n) asm volatile("s_waitcnt lgkmcnt(" #n ")" ::: "memory")
#define PG8_BAR __builtin_amdgcn_s_barrier()
#define PG8_SCHED __builtin_amdgcn_sched_barrier(0)
    Unit cur, nxt; int ui = 0;
    if (!S.next(0, cur)) return;
    f32x4 acc[2][2][4][2];
#pragma unroll
    for (int a = 0; a < 2; ++a)
#pragma unroll
        for (int b = 0; b < 2; ++b)
#pragma unroll
            for (int m = 0; m < 4; ++m)
#pragma unroll
                for (int n = 0; n < 2; ++n) acc[a][b][m][n] = zero4();
    bf16x8 At[4][2], B0[2][2], B1[2][2];
    const char* cA = (const char*)g.A + (size_t)cur.pm * tstep; const char* cB = (const char*)g.Bt + (size_t)cur.pn * tstep;
    PG8_STAGE(PG8_SB(0, 0), cB, voffB); PG8_STAGE(PG8_SB(0, 1), cB + hstep, voffB); PG8_STAGE(PG8_SA(0, 0), cA, voffA); PG8_STAGE(PG8_SA(0, 1), cA + hstep, voffA);
    if (wr == 1) PG8_BAR;
    PG8_WAIT_V(2); PG8_BAR;
    PG8_STAGE(PG8_SB(1, 0), cB + kstep, voffB); PG8_STAGE(PG8_SA(1, 0), cA + kstep, voffA); PG8_STAGE(PG8_SB(1, 1), cB + hstep + kstep, voffB);
    PG8_WAIT_V(6); PG8_BAR;
    for (;;) {
        const bool has_next = S.next(ui + 1, nxt);
        const char* nA = has_next ? (const char*)g.A + (size_t)nxt.pm * tstep : cA; const char* nB = has_next ? (const char*)g.Bt + (size_t)nxt.pn * tstep : cB;
        for (int t = 0; t < nt; t += 2) {
            const bool last = (t == nt - 2);
            const char* a1 = cA + (size_t)(t + 1) * kstep;
            const char* a2 = last ? nA : cA + (size_t)(t + 2) * kstep; const char* b2 = last ? nB : cB + (size_t)(t + 2) * kstep;
            const char* a3 = a2 + kstep; const char* b3 = b2 + kstep;
            PG8_LDB(B0, 0, 0); PG8_LDB(B1, 0, 1); PG8_SCHED; PG8_LDA(At, 0, 0); PG8_STAGE(PG8_SA(1, 1), a1 + hstep, voffA);
            PG8_WAIT_V(8); PG8_WAIT_L(0); PG8_BAR; PG8_MMA(0, 0, At, B0); PG8_MMA(0, 1, At, B1); PG8_BAR; PG8_SCHED;
            PG8_LDA(At, 0, 1); PG8_STAGE(PG8_SB(0, 0), b2, voffB); PG8_STAGE(PG8_SB(0, 1), b2 + hstep, voffB); PG8_STAGE(PG8_SA(0, 0), a2, voffA);
            PG8_WAIT_V(8); PG8_WAIT_L(0); PG8_BAR; PG8_MMA(1, 0, At, B0); PG8_MMA(1, 1, At, B1); PG8_BAR; PG8_SCHED;
            PG8_LDB(B0, 1, 0); PG8_LDB(B1, 1, 1); PG8_SCHED; PG8_LDA(At, 1, 0); PG8_STAGE(PG8_SA(0, 1), a2 + hstep, voffA);
            PG8_WAIT_V(8); PG8_WAIT_L(0); PG8_BAR; PG8_MMA(0, 0, At, B0); PG8_MMA(0, 1, At, B1); PG8_BAR; PG8_SCHED;
            PG8_LDA(At, 1, 1); PG8_STAGE(PG8_SB(1, 0), b3, voffB); PG8_STAGE(PG8_SB(1, 1), b3 + hstep, voffB); PG8_STAGE(PG8_SA(1, 0), a3, voffA);
            PG8_WAIT_V(8); PG8_WAIT_L(0); PG8_BAR; PG8_MMA(1, 0, At, B0); PG8_MMA(1, 1, At, B1); PG8_BAR; PG8_SCHED;
        }
        if (wr == 0) PG8_BAR;
        if constexpr (!AFTER_DRAIN) E(acc, cur, wr, wc, fr, fq);
        if (!has_next) break;
#pragma unroll
        for (int a = 0; a < 2; ++a)
#pragma unroll
            for (int b = 0; b < 2; ++b)
#pragma unroll
                for (int m = 0; m < 4; ++m)
#pragma unroll
                    for (int n = 0; n < 2; ++n) acc[a][b][m][n] = zero4();
        cur = nxt; cA = nA; cB = nB; ++ui;
        if (wr == 1) PG8_BAR;
    }
    PG8_WAIT_V(0);
    PG8_BAR;
    if constexpr (AFTER_DRAIN) E.fused(acc, cur, wr, wc, fr, fq, lds, wid, lane);
#undef PG8_SA
#undef PG8_SB
#undef PG8_STAGE
#undef PG8_LDA
#undef PG8_LDB
#undef PG8_MMA
#undef PG8_WAIT_V
#undef PG8_WAIT_L
#undef PG8_BAR
#undef PG8_SCHED
}
}

#define XB_TMO      128
#define XB_XCNT(j)  (256  + 64 * (j))
#define XB_XSUB(j)  (1280 + 64 * (j))
#define XB_XGEN(j)  (2304 + 64 * (j))
#define XB_TOP      3328
#define XB_TOPGEN   3392
#define XCD_BAR_WORDS 3456
#define XB_SPIN_CAP (1u << 18)
__device__ __forceinline__ unsigned xb_ld(unsigned* p)              { return __hip_atomic_load(p, __ATOMIC_RELAXED, __HIP_MEMORY_SCOPE_AGENT); }
__device__ __forceinline__ unsigned xb_add(unsigned* p, unsigned v) { return __hip_atomic_fetch_add(p, v, __ATOMIC_RELAXED, __HIP_MEMORY_SCOPE_AGENT); }
__device__ __forceinline__ unsigned xb_xcc_id() { return (unsigned)__builtin_amdgcn_s_getreg((3 << 11) | 20) & 0xFu; }
#define XB_SPIN(cond, bar) do { unsigned _sp = 0; while (cond) { __builtin_amdgcn_s_sleep(1); \
    if ((++_sp & 255u) == 0u) { if (xb_ld(&(bar)[XB_TMO])) break; if (_sp > XB_SPIN_CAP) { atomicAdd(&(bar)[XB_TMO], 1u); break; } } } } while (0)
struct XcdBarrier { unsigned* bar; unsigned x; volatile LAS unsigned* st; };
__device__ __forceinline__ XcdBarrier xcd_barrier_post(unsigned* bar, volatile LAS unsigned* st) {
    XcdBarrier b; b.bar = bar; b.x = xb_xcc_id(); b.st = st;
    if (threadIdx.x == 0) (void)xb_add(&bar[XB_XCNT(b.x)], 1u);
    return b;
}
__device__ __forceinline__ void xcd_barrier_complete(unsigned* bar, unsigned x, unsigned& nloc, unsigned& nx) {
    const unsigned G = gridDim.x * gridDim.y * gridDim.z;
    unsigned sum, cnt, mine, sp = 0u;
    for (;;) {
        sum = 0u; cnt = 0u; mine = 0u;
#pragma unroll
        for (unsigned j = 0; j < 16; ++j) { const unsigned c = xb_ld(&bar[XB_XCNT(j)]); sum += c; cnt += (c > 0u) ? 1u : 0u; mine = (j == x) ? c : mine; }
        if (sum == G) break;
        __builtin_amdgcn_s_sleep(1);
        if ((++sp & 255u) == 0u) { if (xb_ld(&bar[XB_TMO])) break; if (sp > XB_SPIN_CAP) { atomicAdd(&bar[XB_TMO], 1u); break; } }
    }
    nloc = mine > 0u ? mine : 1u; nx = cnt > 0u ? cnt : 1u;
}
__device__ __forceinline__ void xcd_barrier(const XcdBarrier& b) {
    asm volatile("s_waitcnt vmcnt(0)" ::: "memory");
    __syncthreads();
    if (threadIdx.x == 0) {
        unsigned* bar = b.bar;
        __builtin_amdgcn_s_waitcnt(0);
        unsigned nloc = b.st[0], nx = b.st[1];
        if (nloc == 0u) { xcd_barrier_complete(bar, b.x, nloc, nx); b.st[0] = nloc; b.st[1] = nx; }
        const unsigned old = xb_add(&bar[XB_XSUB(b.x)], 1u);
        const unsigned gen = old / nloc;
        if (old + 1u == (gen + 1u) * nloc) {
            __builtin_amdgcn_fence(__ATOMIC_RELEASE, "agent");
            asm volatile("s_waitcnt vmcnt(0)" ::: "memory");
            const unsigned og = xb_add(&bar[XB_TOP], 1u);
            const unsigned tg = og / nx;
            if (og + 1u == (tg + 1u) * nx) xb_add(&bar[XB_TOPGEN], 1u);
            else XB_SPIN(xb_ld(&bar[XB_TOPGEN]) == tg, bar);
            __builtin_amdgcn_fence(__ATOMIC_ACQUIRE, "agent");
            xb_add(&bar[XB_XGEN(b.x)], 1u);
            asm volatile("s_waitcnt vmcnt(0)" ::: "memory");
        } else {
            XB_SPIN(xb_ld(&bar[XB_XGEN(b.x)]) == gen, bar);
            __builtin_amdgcn_fence(__ATOMIC_ACQUIRE, "agent");
            asm volatile("s_waitcnt vmcnt(0)" ::: "memory");
        }
    }
    __syncthreads();
}

struct Frame {
    LAS unsigned char* lds;
    int tid, lane, wave, vcu, G;
    unsigned char* ws; float* out;
};
#define WSP(T, off) ((T*)(ws + (off)))

struct Seg { int in, off, ld, col0; unsigned long long dst; int row0, nrows, K, gin, goff, flags; };
constexpr int SEG_PERM = 1, SEG_QS = 2;
constexpr int NSEG = 26;
__constant__ Seg c_segs[NSEG] = {
    {9, 0 * 1024 * 512, 512, 0, WS_WMEM, 0, 512, 1024, 8, 0, 0},
    {9, 1 * 1024 * 512, 512, 0, WS_WMEM, 512, 512, 1024, 8, 1024, 0},
    {9, 2 * 1024 * 512, 512, 0, WS_WMEM, 1024, 512, 1024, 8, 2048, 0},
    {9, 3 * 1024 * 512, 512, 0, WS_WMEM, 1536, 512, 1024, 8, 3072, 0},
    {10, 0, NA, 0, WS_WINA, 0, 3072, 1024, 18, 0, 0},
    {10, 0, NA, 3072, WS_WINA, 3072, 256, 1024, 18, 0, SEG_QS},
    {10, 1024 * NA, NA, 0, WS_WINA + SZ_WINA, 0, 3072, 1024, 18, 1024, 0},
    {10, 1024 * NA, NA, 3072, WS_WINA + SZ_WINA, 3072, 256, 1024, 18, 1024, SEG_QS},
    {13, 0, 1024, 0, WS_WINB0, 0, 768, 1024, 18, 2048, SEG_PERM | SEG_QS},
    {13, 0, 1024, 768, WS_WINB0, 768, 256, 1024, 18, 2048, SEG_QS},
    {16, 0, 512, 0, WS_WINB0, 1024, 256, 1024, 15, 0, SEG_PERM},
    {16, 0, 512, 256, WS_WINB0, 1280, 256, 1024, 15, 0, 0},
    {13, 1024 * 1024, 1024, 0, WS_WINB1, 0, 768, 1024, 18, 3072, SEG_PERM | SEG_QS},
    {13, 1024 * 1024, 1024, 768, WS_WINB1, 768, 256, 1024, 18, 3072, SEG_QS},
    {17, 0 * 1024 * 1024, 1024, 0, WS_WOUT + 0 * 2097152ull, 0, 1024, 1024, -1, 0, 0},
    {17, 1 * 1024 * 1024, 1024, 0, WS_WOUT + 1 * 2097152ull, 0, 1024, 1024, -1, 0, 0},
    {17, 2 * 1024 * 1024, 1024, 0, WS_WOUT + 2 * 2097152ull, 0, 1024, 1024, -1, 0, 0},
    {17, 3 * 1024 * 1024, 1024, 0, WS_WOUT + 3 * 2097152ull, 0, 1024, 1024, -1, 0, 0},
    {22, 0 * 4096 * 1024, 4096, 0, WS_WUP + 0 * 8388608ull, 0, 4096, 1024, 20, 0, 0},
    {22, 1 * 4096 * 1024, 4096, 0, WS_WUP + 1 * 8388608ull, 0, 4096, 1024, 20, 1024, 0},
    {22, 2 * 4096 * 1024, 4096, 0, WS_WUP + 2 * 8388608ull, 0, 4096, 1024, 20, 2048, 0},
    {22, 3 * 4096 * 1024, 4096, 0, WS_WUP + 3 * 8388608ull, 0, 4096, 1024, 20, 3072, 0},
    {23, 0 * 4096 * 1024, 1024, 0, WS_WDN + 0 * 8388608ull, 0, 1024, 4096, -1, 0, 0},
    {23, 1 * 4096 * 1024, 1024, 0, WS_WDN + 1 * 8388608ull, 0, 1024, 4096, -1, 0, 0},
    {23, 2 * 4096 * 1024, 1024, 0, WS_WDN + 2 * 8388608ull, 0, 1024, 4096, -1, 0, 0},
    {23, 3 * 4096 * 1024, 1024, 0, WS_WDN + 3 * 8388608ull, 0, 1024, 4096, -1, 0, 0},
};
__constant__ double c_invfreq[32] = {1.0, 0.7498942093324559, 0.5623413251903491, 0.4216965034285822, 0.31622776601683794, 0.23713737056616552, 0.1778279410038923, 0.1333521432163324, 0.1, 0.07498942093324558, 0.05623413251903491, 0.042169650342858224, 0.03162277660168379, 0.023713737056616554, 0.01778279410038923, 0.01333521432163324, 0.01, 0.007498942093324558, 0.005623413251903491, 0.004216965034285823, 0.0031622776601683794, 0.0023713737056616554, 0.0017782794100389228, 0.001333521432163324, 0.001, 0.0007498942093324559, 0.0005623413251903491, 0.00042169650342858224, 0.00031622776601683794, 0.00023713737056616554, 0.00017782794100389227, 0.0001333521432163324};

__device__ __forceinline__ void seg_item(unsigned char* ws, const Seg& s, int item, int lane) {
    const float* W = in_ptr(s.in) + s.off;
    const float* gain = s.gin >= 0 ? in_ptr(s.gin) + s.goff : nullptr;
    const float scale = (s.flags & SEG_QS) ? QSCALE : 1.0f;
    const int nblk = s.nrows / 64, kb = item / nblk, nb = item - kb * nblk, k0 = 64 * kb, n0 = 64 * nb, K = s.K;
    const int src = s.col0 + n0 + ((s.flags & SEG_PERM) ? (lane >> 1) + 32 * (lane & 1) : lane);
    const float* wp = W + (size_t)k0 * s.ld + src;
    float w[64];
#pragma unroll
    for (int kk = 0; kk < 64; ++kk) w[kk] = wp[(size_t)kk * s.ld];
    if (gain) {
#pragma unroll
        for (int kk = 0; kk < 64; ++kk) w[kk] *= gain[k0 + kk] * scale;
    } else {
#pragma unroll
        for (int kk = 0; kk < 64; ++kk) w[kk] *= scale;
    }
    bf16_t* op = (bf16_t*)(ws + s.dst) + (size_t)(s.row0 + n0 + lane) * K + k0;
#pragma unroll
    for (int c = 0; c < 8; ++c) { u32x4 o; o.x = cvtpk(w[8 * c], w[8 * c + 1]); o.y = cvtpk(w[8 * c + 2], w[8 * c + 3]); o.z = cvtpk(w[8 * c + 4], w[8 * c + 5]); o.w = cvtpk(w[8 * c + 6], w[8 * c + 7]);
        *(u32x4*)(op + 8 * c) = o; }
}

__device__ __forceinline__ void rms_row_to_bf16(const float* xrow, bf16_t* orow, float* hcopy, int lane) {
    const f32x4* xr = (const f32x4*)xrow + lane;
    f32x4 v[4]; float s = 0.f;
#pragma unroll
    for (int j = 0; j < 4; ++j) { v[j] = xr[64 * j]; s += (v[j].x * v[j].x + v[j].y * v[j].y) + (v[j].z * v[j].z + v[j].w * v[j].w); }
    const float rstd = rsqrtf(wave_sum(s) * (1.f / D) + EPS);
    u32x2* o8 = (u32x2*)orow + lane;
#pragma unroll
    for (int j = 0; j < 4; ++j) { u32x2 w; w.x = cvtpk(v[j].x * rstd, v[j].y * rstd); w.y = cvtpk(v[j].z * rstd, v[j].w * rstd); o8[64 * j] = w; }
    if (hcopy) { f32x4* hc = (f32x4*)hcopy + lane;
#pragma unroll
        for (int j = 0; j < 4; ++j) hc[64 * j] = v[j]; }
}

__device__ __forceinline__ void p0_prologue(Frame& F) {
    unsigned char* ws = F.ws;
    const int gw = F.vcu * NWAVES + F.wave, NGW = F.G * NWAVES;
    int total = 0;
    for (int s = 0; s < NSEG; ++s) total += (c_segs[s].K / 64) * (c_segs[s].nrows / 64);
#pragma unroll 1
    for (int it = gw; it < total; it += NGW) {
        int r = it, s = 0;
        for (; s < NSEG; ++s) { const int n = (c_segs[s].K / 64) * (c_segs[s].nrows / 64); if (r < n) break; r -= n; }
        seg_item(ws, c_segs[s], r, F.lane);
    }
    bf16_t* XN = WSP(bf16_t, WS_XN);
#pragma unroll 1
    for (int m = gw * 4; m < MP; m += NGW * 4) {
        const f32x4* xr = (const f32x4*)(in_ptr(0) + (size_t)m * D) + F.lane;
        f32x4 v[4][4]; float s[4];
#pragma unroll
        for (int r = 0; r < 4; ++r)
#pragma unroll
            for (int j = 0; j < 4; ++j) v[r][j] = xr[r * 256 + 64 * j];
#pragma unroll
        for (int r = 0; r < 4; ++r) { s[r] = 0.f;
#pragma unroll
            for (int j = 0; j < 4; ++j) s[r] += (v[r][j].x * v[r][j].x + v[r][j].y * v[r][j].y) + (v[r][j].z * v[r][j].z + v[r][j].w * v[r][j].w);
            s[r] = rsqrtf(wave_sum(s[r]) * (1.f / D) + EPS); }
        u32x2* o8 = (u32x2*)(XN + (size_t)m * D) + F.lane;
#pragma unroll
        for (int r = 0; r < 4; ++r)
#pragma unroll
            for (int j = 0; j < 4; ++j) { u32x2 w; w.x = cvtpk(v[r][j].x * s[r], v[r][j].y * s[r]); w.y = cvtpk(v[r][j].z * s[r], v[r][j].w * s[r]); o8[r * 256 + 64 * j] = w; }
    }
    bf16_t* MN = WSP(bf16_t, WS_MN);
    for (int m = gw; m < 512; m += NGW) rms_row_to_bf16(in_ptr(7) + (size_t)m * D, MN + (size_t)m * D, nullptr, F.lane);
    f32x2* rope = WSP(f32x2, WS_ROPE);
    const int gt = F.vcu * NTHR + F.tid, NGT = F.G * NTHR;
    for (int e = gt; e < 8193 * 32; e += NGT) { const int pos = e >> 5, i = e & 31; double rev = (double)pos * c_invfreq[i] * 0.15915494309189535; rev -= __builtin_rint(rev);
        const float rf = (float)rev; rope[e] = (f32x2){__builtin_amdgcn_cosf(rf), __builtin_amdgcn_sinf(rf)}; }
    { float* RS2 = WSP(float, WS_RS2); for (int e = gt; e < MP; e += NGT) RS2[e] = 1.0f; }
    { u32x4* xz = WSP(u32x4, WS_XCH); unsigned z = 0u; asm volatile("" : "+v"(z)); const u32x4 z4 = {z, z, z, z}; for (int e = gt; e < 16 * 65536 / 2; e += NGT) xz[e] = z4; }
    { float* LBS = WSP(float, WS_LBS); const float* lbl = in_ptr(11);
      for (int e = gt; e < HW; e += NGT) { LBS[e] = 0.f; LBS[HW + e] = fsigmoid(lbl[HW + e] - lbl[e]); } }
    bf16_t* KR = WSP(bf16_t, WS_KR); bf16_t* VT = WSP(bf16_t, WS_VT);
    for (int e = gt; e < 8 * 160 * 64; e += NGT) { const int bk = e / (160 * 64), r = (e / 64) % 160, d = e % 64; const int pos = r < 128 ? r : 128 + SEQ + (r - 128);
        KR[((size_t)bk * KVP + pos) * 64 + d] = 0; VT[((size_t)bk * 64 + d) * KVP + pos] = 0; }
}

enum { EK_MEMKV = 0, EK_INA = 1, EK_INB = 2, EK_F32 = 3, EK_UP = 4, EK_FUSED = 5 };
struct Epi {
    int kind, layer; unsigned char* ws; float* out;
    __device__ __forceinline__ void operator()(const f32x4 (&acc)[2][2][4][2], const pg8::Unit& u, int wr, int wc, int fr, int fq) const {
        asm volatile("" : "+v"(fr), "+v"(fq));
        const int row0 = u.pm * 256 + wr * 64 + fr, cl0 = wc * 32 + 8 * fq;
        const float* RS2 = WSP(float, WS_RS2);
        if (kind == EK_F32) {
            float* Y = WSP(float, WS_Y);
#pragma unroll
            for (int ai = 0; ai < 2; ++ai)
#pragma unroll
                for (int m = 0; m < 4; ++m) { float* rp = Y + (size_t)(row0 + ai * 128 + m * 16) * D + u.pn * 256 + cl0;
#pragma unroll
                    for (int bj = 0; bj < 2; ++bj) { *(f32x4*)(rp + bj * 128) = acc[ai][bj][m][0]; *(f32x4*)(rp + bj * 128 + 4) = acc[ai][bj][m][1]; } }
        } else if (kind == EK_UP) {
            bf16_t* HB = WSP(bf16_t, WS_HB);
#pragma unroll
            for (int ai = 0; ai < 2; ++ai)
#pragma unroll
                for (int m = 0; m < 4; ++m) { bf16_t* rp = HB + (size_t)(row0 + ai * 128 + m * 16) * FF + u.pn * 256 + cl0; const float rsc = RS2[row0 + ai * 128 + m * 16];
#pragma unroll
                    for (int bj = 0; bj < 2; ++bj) { f32x4 v0 = acc[ai][bj][m][0] * rsc, v1 = acc[ai][bj][m][1] * rsc;
#pragma unroll
                        for (int e = 0; e < 4; ++e) { const float r0 = fmaxf(v0[e], 0.f), r1 = fmaxf(v1[e], 0.f); v0[e] = r0 * r0; v1[e] = r1 * r1; }
                        u32x4 w; w.x = cvtpk(v0[0], v0[1]); w.y = cvtpk(v0[2], v0[3]); w.z = cvtpk(v1[0], v1[1]); w.w = cvtpk(v1[2], v1[3]);
                        *(u32x4*)(rp + bj * 128) = w; } }
        } else if (kind == EK_MEMKV) {
            const int l = u.pn >> 1, kv = u.pn & 1;
            float* of = out + (kv ? O_MV : O_MK);
            bf16_t* MKB = WSP(bf16_t, WS_MKB); bf16_t* MVT = WSP(bf16_t, WS_MVT);
#pragma unroll
            for (int ai = 0; ai < 2; ++ai)
#pragma unroll
                for (int m = 0; m < 4; ++m) { const int row = row0 + ai * 128 + m * 16, b = row >> 8, mm = row & 255;
#pragma unroll
                    for (int bj = 0; bj < 2; ++bj) { const int cc = bj * 128 + cl0, h = cc >> 6, d = cc & 63; const f32x4 v0 = acc[ai][bj][m][0], v1 = acc[ai][bj][m][1];
                        float* op = of + ((size_t)(l * 2 + b) * 256 + mm) * 256 + cc; *(f32x4*)op = v0; *(f32x4*)(op + 4) = v1;
                        if (kv == 0) { u32x4 w; w.x = cvtpk(v0[0], v0[1]); w.y = cvtpk(v0[2], v0[3]); w.z = cvtpk(v1[0], v1[1]); w.w = cvtpk(v1[2], v1[3]);
                            *(u32x4*)(MKB + ((size_t)((l * 2 + b) * 4 + h) * 256 + mm) * 64 + d) = w; }
                        else { bf16_t* vp = MVT + ((size_t)((l * 2 + b) * 4 + h) * 64 + d) * 256 + mm;
#pragma unroll
                            for (int e = 0; e < 4; ++e) { vp[(size_t)e * 256] = f2bf(v0[e]); vp[(size_t)(e + 4) * 256] = f2bf(v1[e]); } } } }
        } else if (kind == EK_INA) {
            const int sec = u.pn / 3, ct = u.pn % 3;
            bf16_t* QS = WSP(bf16_t, WS_QS); bf16_t* KK = WSP(bf16_t, WS_KK); bf16_t* VV = WSP(bf16_t, WS_VV); bf16_t* GG = WSP(bf16_t, WS_GG); float* LF = WSP(float, WS_LF); bf16_t* CQ = WSP(bf16_t, WS_CQ);
            if (sec == 4) {
#pragma unroll
                for (int ai = 0; ai < 2; ++ai)
#pragma unroll
                    for (int m = 0; m < 4; ++m) { bf16_t* rp = CQ + (size_t)(row0 + ai * 128 + m * 16) * XW + cl0; const float rsc = RS2[row0 + ai * 128 + m * 16];
#pragma unroll
                        for (int bj = 0; bj < 2; ++bj) { const f32x4 v0 = acc[ai][bj][m][0] * rsc, v1 = acc[ai][bj][m][1] * rsc; u32x4 w; w.x = cvtpk(v0[0], v0[1]); w.y = cvtpk(v0[2], v0[3]); w.z = cvtpk(v1[0], v1[1]); w.w = cvtpk(v1[2], v1[3]);
                            *(u32x4*)(rp + bj * 128) = w; } }
            } else if (sec == 1) {
                const float* LBS = WSP(float, WS_LBS) + layer * HW + ct * 256 + cl0;
                f32x4 lb4[2][2];
#pragma unroll
                for (int bj = 0; bj < 2; ++bj) { lb4[bj][0] = *(const f32x4*)(LBS + bj * 128); lb4[bj][1] = *(const f32x4*)(LBS + bj * 128 + 4); }
#pragma unroll
                for (int ai = 0; ai < 2; ++ai)
#pragma unroll
                    for (int m = 0; m < 4; ++m) { const size_t ro = (size_t)(row0 + ai * 128 + m * 16) * HW + ct * 256 + cl0; const float rsc = RS2[row0 + ai * 128 + m * 16];
#pragma unroll
                        for (int bj = 0; bj < 2; ++bj) { float lf[8], kk[8];
#pragma unroll
                            for (int e = 0; e < 8; ++e) { const float z = (e < 4 ? acc[ai][bj][m][0][e] : acc[ai][bj][m][1][e - 4]) * rsc;
                                const float t = fexp(-fabsf(z)), r = __builtin_amdgcn_rcpf(1.0f + t), big = r, small = t * r; const float sp = z >= 0.f ? big : small, sn = z >= 0.f ? small : big;
                                const float l1 = e < 4 ? lb4[bj][0][e] : lb4[bj][1][e - 4], f = l1 + (1.0f - l1) * sp, k = (1.0f - l1) * sn;
                                lf[e] = flog(f); kk[e] = k; }
                            *(f32x4*)(LF + ro + bj * 128) = (f32x4){lf[0], lf[1], lf[2], lf[3]}; *(f32x4*)(LF + ro + bj * 128 + 4) = (f32x4){lf[4], lf[5], lf[6], lf[7]};
                            u32x4 w; w.x = cvtpk(kk[0], kk[1]); w.y = cvtpk(kk[2], kk[3]); w.z = cvtpk(kk[4], kk[5]); w.w = cvtpk(kk[6], kk[7]);
                            *(u32x4*)(KK + ro + bj * 128) = w; } }
            } else {
                bf16_t* dst = sec == 0 ? QS : (sec == 2 ? VV : GG); const bool act = sec != 2;
#pragma unroll
                for (int ai = 0; ai < 2; ++ai)
#pragma unroll
                    for (int m = 0; m < 4; ++m) { bf16_t* rp = dst + (size_t)(row0 + ai * 128 + m * 16) * HW + ct * 256 + cl0; const float rsc = RS2[row0 + ai * 128 + m * 16];
#pragma unroll
                        for (int bj = 0; bj < 2; ++bj) { f32x4 v0 = acc[ai][bj][m][0] * rsc, v1 = acc[ai][bj][m][1] * rsc;
                            if (act) {
#pragma unroll
                                for (int e = 0; e < 4; ++e) { v0[e] = fsilu(v0[e]); v1[e] = fsilu(v1[e]); } }
                            u32x4 w; w.x = cvtpk(v0[0], v0[1]); w.y = cvtpk(v0[2], v0[3]); w.z = cvtpk(v1[0], v1[1]); w.w = cvtpk(v1[2], v1[3]);
                            *(u32x4*)(rp + bj * 128) = w; } }
            }
        } else {
            bf16_t* QR = WSP(bf16_t, WS_QS); bf16_t* CQ = WSP(bf16_t, WS_CQ); bf16_t* KR = WSP(bf16_t, WS_KR); bf16_t* VT = WSP(bf16_t, WS_VT);
            float* KSN = WSP(float, WS_KSN); float* VSN = WSP(float, WS_VSN); const f32x2* rope = WSP(f32x2, WS_ROPE);
            const int pn = u.pn;
#pragma unroll
            for (int ai = 0; ai < 2; ++ai)
#pragma unroll
                for (int m = 0; m < 4; ++m) { const int row = row0 + ai * 128 + m * 16; const int pos = row < MP ? (row & (SEQ - 1)) : SEQ; const int b = row >> 13, t = row & (SEQ - 1);
#pragma unroll
                    for (int bj = 0; bj < 2; ++bj) { const int cc = bj * 128 + cl0; const float rsc = RS2[row < MP ? row : 0]; f32x4 v0 = acc[ai][bj][m][0] * rsc, v1 = acc[ai][bj][m][1] * rsc;
                        if (pn == 3) { u32x4 w; w.x = cvtpk(v0[0], v0[1]); w.y = cvtpk(v0[2], v0[3]); w.z = cvtpk(v1[0], v1[1]); w.w = cvtpk(v1[2], v1[3]); *(u32x4*)(CQ + (size_t)row * XW + cc) = w; }
                        else if (pn == 5) {
                            const int kvh = cc >> 6, d = cc & 63;
                            if (row < MP) { bf16_t* vp = VT + ((size_t)((b * 4 + kvh) * 64 + d)) * KVP + 128 + t;
#pragma unroll
                                for (int e = 0; e < 4; ++e) { vp[(size_t)e * KVP] = f2bf(v0[e]); vp[(size_t)(e + 4) * KVP] = f2bf(v1[e]); }
                                if (t >= SEQ - 128) { float* op = out + O_SVP + ((size_t)(b * 128 + (t - (SEQ - 128))) * 4 + kvh) * 64 + d; *(f32x4*)op = v0; *(f32x4*)(op + 4) = v1; } }
                            else if (row < MP + BS) { const int bs = row - MP; float* op = out + O_SVS + ((size_t)(bs * 128 + 127) * 4 + kvh) * 64 + d; *(f32x4*)op = v0; *(f32x4*)(op + 4) = v1;
                                float* sp = VSN + (size_t)(bs * 4 + kvh) * 64 + d; *(f32x4*)sp = v0; *(f32x4*)(sp + 4) = v1; }
                        } else {
                            const int hh = cc >> 6, i0 = (cc & 63) >> 1; const f32x2* rp = rope + (size_t)pos * 32 + i0;
                            float o[8];
#pragma unroll
                            for (int p = 0; p < 4; ++p) { const f32x2 cs = rp[p]; const float x1 = p < 2 ? v0[2 * p] : v1[2 * p - 4], x2 = p < 2 ? v0[2 * p + 1] : v1[2 * p - 3];
                                o[2 * p] = x1 * cs.x - x2 * cs.y; o[2 * p + 1] = x2 * cs.x + x1 * cs.y; }
                            u32x4 w; w.x = cvtpk(o[0], o[1]); w.y = cvtpk(o[2], o[3]); w.z = cvtpk(o[4], o[5]); w.w = cvtpk(o[6], o[7]);
                            if (pn < 3) *(u32x4*)(QR + (size_t)row * HW + pn * 256 + cc) = w;
                            else {
                                if (row < MP) { *(u32x4*)(KR + ((size_t)(b * 4 + hh) * KVP + 128 + t) * 64 + (cc & 63)) = w;
                                    if (t >= SEQ - 128) { float* op = out + O_SKP + ((size_t)(b * 128 + (t - (SEQ - 128))) * 4 + hh) * 64;
#pragma unroll
                                        for (int p = 0; p < 4; ++p) { op[i0 + p] = o[2 * p]; op[i0 + p + 32] = o[2 * p + 1]; } } }
                                else if (row < MP + BS) { const int bs = row - MP; float* op = out + O_SKS + ((size_t)(bs * 128 + 127) * 4 + hh) * 64; float* sp = KSN + (size_t)(bs * 4 + hh) * 64;
#pragma unroll
                                    for (int p = 0; p < 4; ++p) { op[i0 + p] = o[2 * p]; op[i0 + p + 32] = o[2 * p + 1]; sp[i0 + p] = o[2 * p]; sp[i0 + p + 32] = o[2 * p + 1]; } }
                            }
                        } } }
        }
    }
};

struct PanelSq {
    unsigned long long* xbuf;
    unsigned tag;
    unsigned* tmo;
    __device__ __forceinline__ void run(const f32x4 (&v)[2][2][4][2], const pg8::Unit& u, int wr, int wc, int fr, int fq, LAS unsigned char* lds, int wid, int lane) const {
        LAS float* P = (LAS float*)lds;
        LAS float* S = (LAS float*)(lds + 8192);
#pragma unroll
        for (int ai = 0; ai < 2; ++ai)
#pragma unroll
            for (int m = 0; m < 4; ++m) { float s = 0.f;
#pragma unroll
                for (int bj = 0; bj < 2; ++bj)
#pragma unroll
                    for (int n = 0; n < 2; ++n) { const f32x4 x = v[ai][bj][m][n]; s += (x[0] * x[0] + x[1] * x[1]) + (x[2] * x[2] + x[3] * x[3]); }
                s += __shfl_xor(s, 16); s += __shfl_xor(s, 32);
                if (fq == 0) P[(ai * 128 + wr * 64 + m * 16 + fr) * 4 + wc] = s; }
        asm volatile("s_waitcnt lgkmcnt(0)" ::: "memory"); __builtin_amdgcn_s_barrier(); asm volatile("" ::: "memory");
        if (lane < 32) { const int row = wid * 32 + lane;
            const f32x4 p = *(const LAS f32x4*)(P + row * 4); const float t = (p[0] + p[1]) + (p[2] + p[3]);
            unsigned long long* slot = xbuf + (size_t)(u.pm * 256 + row) * 4;
            __hip_atomic_store(slot + u.pn, ((unsigned long long)tag << 32) | __float_as_uint(t), __ATOMIC_RELAXED, __HIP_MEMORY_SCOPE_AGENT);
            unsigned spins = 0; float q;
            for (;;) { bool ok = true; q = 0.f;
#pragma unroll
                for (int t4 = 0; t4 < 4; ++t4) { const unsigned long long x = __hip_atomic_load(slot + t4, __ATOMIC_RELAXED, __HIP_MEMORY_SCOPE_AGENT); ok = ok && (unsigned)(x >> 32) == tag; q += __uint_as_float((unsigned)x); }
                if (__all(ok)) break;
                if (++spins > (1u << 16)) { if (lane == 0) __hip_atomic_store(tmo, 1u, __ATOMIC_RELAXED, __HIP_MEMORY_SCOPE_AGENT); break; }
                __builtin_amdgcn_s_sleep(1);
            }
            S[row] = rsqrtf(q * (1.f / 1024.f) + EPS); }
        asm volatile("s_waitcnt vmcnt(0) lgkmcnt(0)" ::: "memory"); __builtin_amdgcn_s_barrier(); asm volatile("" ::: "memory");
    }
};
struct EpiFused {
    const float* base; const bf16_t* hb_in; float* hout; bf16_t* hb_out; bf16_t* xn; const float* gpost; PanelSq st1, st2;
    __device__ __forceinline__ void fused(f32x4 (&acc)[2][2][4][2], const pg8::Unit& u, int wr, int wc, int fr, int fq, LAS unsigned char* lds, int wid, int lane) const {
        asm volatile("" : "+v"(fr), "+v"(fq));
        const LAS float* S = (const LAS float*)(lds + 8192);
        const int col0 = u.pn * 256 + wc * 32 + 8 * fq;
        u32x2 bpk[1][4][2][2];
#pragma unroll
        for (int ai = 0; ai < 1; ++ai)
#pragma unroll
            for (int m = 0; m < 4; ++m) { const size_t off = (size_t)(u.pm * 256 + ai * 128 + wr * 64 + m * 16 + fr) * D + col0;
#pragma unroll
                for (int bj = 0; bj < 2; ++bj)
#pragma unroll
                    for (int n = 0; n < 2; ++n) {
                        if (base) { const f32x4 bs = *(const f32x4*)(base + off + bj * 128 + 4 * n); bpk[ai][m][bj][n] = (u32x2){cvtpk(bs[0], bs[1]), cvtpk(bs[2], bs[3])}; }
                        else bpk[ai][m][bj][n] = *(const u32x2*)(hb_in + off + bj * 128 + 4 * n); } }
        st1.run(acc, u, wr, wc, fr, fq, lds, wid, lane);
        f32x4 gp[2][2];
#pragma unroll
        for (int bj = 0; bj < 2; ++bj)
#pragma unroll
            for (int n = 0; n < 2; ++n) gp[bj][n] = *(const f32x4*)(gpost + col0 + bj * 128 + 4 * n);
#pragma unroll
        for (int ai = 0; ai < 2; ++ai)
#pragma unroll
            for (int m = 0; m < 4; ++m) { const int r = ai * 128 + wr * 64 + m * 16 + fr; const float rs = S[r]; const size_t off = (size_t)(u.pm * 256 + r) * D + col0;
#pragma unroll
                for (int bj = 0; bj < 2; ++bj)
#pragma unroll
                    for (int n = 0; n < 2; ++n) { f32x4 bs;
                        if (ai == 0) { const u32x2 hw = bpk[0][m][bj][n]; bs = (f32x4){bflo(hw.x), bfhi(hw.x), bflo(hw.y), bfhi(hw.y)}; }
                        else if (base) bs = *(const f32x4*)(base + off + bj * 128 + 4 * n);
                        else { const u32x2 hw = *(const u32x2*)(hb_in + off + bj * 128 + 4 * n); bs = (f32x4){bflo(hw.x), bfhi(hw.x), bflo(hw.y), bfhi(hw.y)}; }
                        acc[ai][bj][m][n] = bs + acc[ai][bj][m][n] * rs * gp[bj][n]; }
                asm volatile("" : "+v"(acc[ai][0][m][0]), "+v"(acc[ai][0][m][1]), "+v"(acc[ai][1][m][0]), "+v"(acc[ai][1][m][1]));
                if (m & 1) asm volatile("" ::: "memory"); }
        if (xn) st2.run(acc, u, wr, wc, fr, fq, lds, wid, lane);
#pragma unroll
        for (int ai = 0; ai < 2; ++ai)
#pragma unroll
            for (int m = 0; m < 4; ++m) { const int r = ai * 128 + wr * 64 + m * 16 + fr; const size_t off = (size_t)(u.pm * 256 + r) * D + col0;
                if (xn && u.pn == 0 && wc == 0 && fq == 0) ((float*)xn)[u.pm * 256 + r] = S[r];
#pragma unroll
                for (int bj = 0; bj < 2; ++bj) { const f32x4 x0 = acc[ai][bj][m][0], x1 = acc[ai][bj][m][1];
                    if (hout) { *(f32x4*)(hout + off + bj * 128) = x0; *(f32x4*)(hout + off + bj * 128 + 4) = x1; }
                    else { u32x4 hw; hw.x = cvtpk(x0[0], x0[1]); hw.y = cvtpk(x0[2], x0[3]); hw.z = cvtpk(x1[0], x1[1]); hw.w = cvtpk(x1[2], x1[3]); *(u32x4*)(hb_out + off + bj * 128) = hw; }
                }
                asm volatile("" ::: "memory"); }
    }
};

__device__ __forceinline__ void norm_phase(Frame& F, const float* gpost, bool final_out) {
    unsigned char* ws = F.ws;
    const int gw = F.vcu * NWAVES + F.wave, NGW = F.G * NWAVES, lane = F.lane;
    float* H = WSP(float, WS_H); const float* Y = WSP(float, WS_Y); bf16_t* XN = WSP(bf16_t, WS_XN);
    f32x4 gp[4];
#pragma unroll
    for (int j = 0; j < 4; ++j) gp[j] = ((const f32x4*)gpost)[lane + 64 * j];
    for (int m = gw; m < MP; m += NGW) {
        const f32x4* yr = (const f32x4*)(Y + (size_t)m * D) + lane; f32x4* hr = (f32x4*)(H + (size_t)m * D) + lane;
        f32x4 y[4], h[4]; float s = 0.f;
#pragma unroll
        for (int j = 0; j < 4; ++j) { y[j] = yr[64 * j]; h[j] = hr[64 * j]; s += (y[j].x * y[j].x + y[j].y * y[j].y) + (y[j].z * y[j].z + y[j].w * y[j].w); }
        const float rstd = rsqrtf(wave_sum(s) * (1.f / D) + EPS); float s2 = 0.f;
#pragma unroll
        for (int j = 0; j < 4; ++j) { h[j] = h[j] + y[j] * rstd * gp[j]; s2 += (h[j].x * h[j].x + h[j].y * h[j].y) + (h[j].z * h[j].z + h[j].w * h[j].w); }
        if (final_out) { f32x4* orow = (f32x4*)(m < MP ? F.out + O_YP + (size_t)m * D : F.out + O_YS + (size_t)(m - MP) * D) + lane;
#pragma unroll
            for (int j = 0; j < 4; ++j) orow[64 * j] = h[j];
        } else {
            const float rstd2 = rsqrtf(wave_sum(s2) * (1.f / D) + EPS);
            u32x2* o8 = (u32x2*)(XN + (size_t)m * D) + lane;
#pragma unroll
            for (int j = 0; j < 4; ++j) { hr[64 * j] = h[j]; u32x2 w; w.x = cvtpk(h[j].x * rstd2, h[j].y * rstd2); w.y = cvtpk(h[j].z * rstd2, h[j].w * rstd2); o8[64 * j] = w; }
        }
    }
}

constexpr int HS_NSEG = 16, HS_CPS = 8, HS_UNITS = 12 * HS_NSEG;
constexpr int HL_RAW_LF = 0, HL_RAW_K = 32768, HL_RAW_V = 49152, HL_RAW_Q = 65536;
constexpr int HL_TOT = 81920;
constexpr int HL_A = HL_TOT + 4096;
constexpr int HL_KT = HL_A + 512;
constexpr int HL_VTT = HL_KT + 128 * 144;
constexpr int HL_QH = 0;
constexpr int HL_QT = HL_QH + 64 * 272, HL_KTL = HL_QT + 64 * 272, HL_P = HL_KTL + 64 * 272;
constexpr int HL_O = HL_P + 64 * 144;
static_assert(HL_O + 64 * 272 <= HL_TOT && HL_VTT + 128 * 144 <= RING_BYTES, "hgrn lds");

__device__ __forceinline__ f32x4 mfma16(bf16x8 a, bf16x8 b, f32x4 c) { return __builtin_amdgcn_mfma_f32_16x16x32_bf16(a, b, c, 0, 0, 0); }
__device__ __forceinline__ void st16_lds(LAS unsigned char* p, const float (&v)[16]) {
    u32x4 w0, w1; w0.x = cvtpk(v[0], v[1]); w0.y = cvtpk(v[2], v[3]); w0.z = cvtpk(v[4], v[5]); w0.w = cvtpk(v[6], v[7]);
    w1.x = cvtpk(v[8], v[9]); w1.y = cvtpk(v[10], v[11]); w1.z = cvtpk(v[12], v[13]); w1.w = cvtpk(v[14], v[15]);
    *(LAS u32x4*)p = w0; *(LAS u32x4*)(p + 16) = w1;
}
struct HRaw { f32x4 lf[4]; u32x4 k[2], v[2], q[2]; };
struct HPair { f32x2 lf[8]; unsigned k[8], v[8], q[8]; };
template <bool WITHQ> __device__ __forceinline__ void hpair_load(HPair& r, unsigned char* ws, int row0, int h, int cp, int tg) {
    const size_t e = (size_t)(row0 + tg * 8) * HW + h * 128 + 2 * cp;
    const float* LF = WSP(float, WS_LF) + e; const bf16_t* KK = WSP(bf16_t, WS_KK) + e; const bf16_t* VV = WSP(bf16_t, WS_VV) + e; const bf16_t* QS = WSP(bf16_t, WS_QS) + e;
#pragma unroll
    for (int i = 0; i < 8; ++i) { r.lf[i] = *(const f32x2*)(LF + (size_t)i * HW); r.k[i] = *(const unsigned*)(KK + (size_t)i * HW); r.v[i] = *(const unsigned*)(VV + (size_t)i * HW); if (WITHQ) r.q[i] = *(const unsigned*)(QS + (size_t)i * HW); }
}
template <bool WITHQ> __device__ __forceinline__ void hraw_load(HRaw& r, unsigned char* ws, int row0, int h, int tid) {
    const size_t e = (size_t)(row0 + (tid >> 3)) * HW + h * 128 + (tid & 7) * 16;
    const float* LF = WSP(float, WS_LF) + e; const bf16_t* KK = WSP(bf16_t, WS_KK) + e; const bf16_t* VV = WSP(bf16_t, WS_VV) + e; const bf16_t* QS = WSP(bf16_t, WS_QS) + e;
#pragma unroll
    for (int j = 0; j < 4; ++j) r.lf[j] = *(const f32x4*)(LF + 4 * j);
#pragma unroll
    for (int j = 0; j < 2; ++j) { r.k[j] = *(const u32x4*)(KK + 8 * j); r.v[j] = *(const u32x4*)(VV + 8 * j); if (WITHQ) r.q[j] = *(const u32x4*)(QS + 8 * j); }
}
template <bool WITHQ> __device__ __forceinline__ void hraw_store(const HRaw& r, LAS unsigned char* lds, int tid) {
    const int o = (tid >> 3) * 128 + (tid & 7) * 16;
#pragma unroll
    for (int j = 0; j < 4; ++j) *(LAS f32x4*)(lds + HL_RAW_LF + (o + 4 * j) * 4) = r.lf[j];
#pragma unroll
    for (int j = 0; j < 2; ++j) { *(LAS u32x4*)(lds + HL_RAW_K + (o + 8 * j) * 2) = r.k[j]; *(LAS u32x4*)(lds + HL_RAW_V + (o + 8 * j) * 2) = r.v[j]; if (WITHQ) *(LAS u32x4*)(lds + HL_RAW_Q + (o + 8 * j) * 2) = r.q[j]; }
}
__device__ __forceinline__ void hgrn_state_update(f32x4 (&acc)[8], LAS unsigned char* lds, int w, int fr, int g) {
    bf16x8 bf[2];
#pragma unroll
    for (int ks = 0; ks < 2; ++ks) bf[ks] = *(const LAS bf16x8*)(lds + HL_VTT + (16 * w + fr) * 144 + ks * 64 + g * 16);
#pragma unroll
    for (int nb = 0; nb < 8; ++nb) { const f32x4 a4 = *(const LAS f32x4*)(lds + HL_A + (16 * nb + 4 * g) * 4); acc[nb] = acc[nb] * a4;
#pragma unroll
        for (int ks = 0; ks < 2; ++ks) { const bf16x8 af = *(const LAS bf16x8*)(lds + HL_KT + (16 * nb + fr) * 144 + ks * 64 + g * 16); acc[nb] = mfma16(af, bf[ks], acc[nb]); } }
}

__device__ __forceinline__ void hgrn_pass1_unit(Frame& F, int unit) {
    unsigned char* ws = F.ws; LAS unsigned char* lds = F.lds;
    const int bh = unit >> 4, seg = unit & 15, b_ = bh / 6, h = bh % 6;
    const int tid = F.tid, cp = tid & 63, tg = tid >> 6, lane = F.lane, w = F.wave, fr = lane & 15, g = lane >> 4;
    f32x4 acc[8];
#pragma unroll
    for (int nb = 0; nb < 8; ++nb) acc[nb] = zero4();
    float bsum0 = 0.f, bsum1 = 0.f;
    HPair r; hpair_load<false>(r, ws, b_ * SEQ + seg * (HS_CPS * 64), h, cp, tg);
#pragma unroll 1
    for (int cc = 0; cc < HS_CPS; ++cc) {
        float b0[8], b1[8], k0[8], k1[8], v0[8], v1[8]; float run0 = 0.f, run1 = 0.f;
#pragma unroll
        for (int i = 0; i < 8; ++i) { run0 += r.lf[i].x; run1 += r.lf[i].y; b0[i] = run0; b1[i] = run1; k0[i] = bflo(r.k[i]); k1[i] = bfhi(r.k[i]); v0[i] = bflo(r.v[i]); v1[i] = bfhi(r.v[i]); }
        if (cc + 1 < HS_CPS) hpair_load<false>(r, ws, b_ * SEQ + (seg * HS_CPS + cc + 1) * 64, h, cp, tg);
        LAS float* tot = (LAS float*)(lds + HL_TOT);
        *(LAS f32x2*)(tot + tg * 128 + 2 * cp) = (f32x2){run0, run1};
        { u32x4 w0, w1; w0.x = cvtpk(v0[0], v0[1]); w0.y = cvtpk(v0[2], v0[3]); w0.z = cvtpk(v0[4], v0[5]); w0.w = cvtpk(v0[6], v0[7]); w1.x = cvtpk(v1[0], v1[1]); w1.y = cvtpk(v1[2], v1[3]); w1.z = cvtpk(v1[4], v1[5]); w1.w = cvtpk(v1[6], v1[7]);
          *(LAS u32x4*)(lds + HL_VTT + (2 * cp) * 144 + tg * 16) = w0; *(LAS u32x4*)(lds + HL_VTT + (2 * cp + 1) * 144 + tg * 16) = w1; }
        __syncthreads();
        float pre0 = 0.f, pre1 = 0.f, bt0 = 0.f, bt1 = 0.f;
#pragma unroll
        for (int q = 0; q < 8; ++q) { const f32x2 t = *(const LAS f32x2*)(tot + q * 128 + 2 * cp); if (q < tg) { pre0 += t.x; pre1 += t.y; } bt0 += t.x; bt1 += t.y; }
#pragma unroll
        for (int i = 0; i < 8; ++i) { k0[i] *= fexp(bt0 - (b0[i] + pre0)); k1[i] *= fexp(bt1 - (b1[i] + pre1)); }
        { u32x4 w0, w1; w0.x = cvtpk(k0[0], k0[1]); w0.y = cvtpk(k0[2], k0[3]); w0.z = cvtpk(k0[4], k0[5]); w0.w = cvtpk(k0[6], k0[7]); w1.x = cvtpk(k1[0], k1[1]); w1.y = cvtpk(k1[2], k1[3]); w1.z = cvtpk(k1[4], k1[5]); w1.w = cvtpk(k1[6], k1[7]);
          *(LAS u32x4*)(lds + HL_KT + (2 * cp) * 144 + tg * 16) = w0; *(LAS u32x4*)(lds + HL_KT + (2 * cp + 1) * 144 + tg * 16) = w1; }
        if (tg == 0) *(LAS f32x2*)(lds + HL_A + 2 * cp * 4) = (f32x2){fexp(bt0), fexp(bt1)};
        bsum0 += bt0; bsum1 += bt1;
        __syncthreads();
        hgrn_state_update(acc, lds, w, fr, g);
        __syncthreads();
    }
    float* US = WSP(float, WS_USEG) + (size_t)unit * 16384;
#pragma unroll
    for (int nb = 0; nb < 8; ++nb)
#pragma unroll
        for (int i = 0; i < 4; ++i) US[(nb * 4 + i) * 512 + tid] = acc[nb][i];
    if (tg == 0) *(f32x2*)(WSP(float, WS_ASEG) + (size_t)unit * 128 + 2 * cp) = (f32x2){fexp(bsum0), fexp(bsum1)};
}

__device__ __forceinline__ void hgrn_pass2(Frame& F, int layer) {
    unsigned char* ws = F.ws;
    const int gt = F.vcu * NTHR + F.tid, NGT = F.G * NTHR;
    for (int e = gt; e < 12 * 16384; e += NGT) {
        const int bh = e >> 14, idx = e & 16383, nbi = idx >> 9, t = idx & 511, g = (t >> 4) & 3, fr = t & 15, w = t >> 6;
        const int ch = 16 * (nbi >> 2) + 4 * g + (nbi & 3), v = 16 * w + fr;
        const float* US = WSP(float, WS_USEG) + (size_t)bh * HS_NSEG * 16384 + idx; float* SS = WSP(float, WS_SST) + (size_t)bh * HS_NSEG * 16384 + idx;
        const float* AS = WSP(float, WS_ASEG) + (size_t)bh * HS_NSEG * 128 + ch;
        float u[HS_NSEG], a[HS_NSEG];
#pragma unroll
        for (int s = 0; s < HS_NSEG; ++s) { u[s] = US[(size_t)s * 16384]; a[s] = AS[s * 128]; }
        float st = 0.f;
#pragma unroll
        for (int s = 0; s < HS_NSEG; ++s) { SS[(size_t)s * 16384] = st; st = a[s] * st + u[s]; }
        const int b_ = bh / 6, h = bh % 6;
        F.out[O_HP + ((size_t)((layer * 2 + b_) * 6 + h)) * 16384 + (size_t)ch * 128 + v] = st;
    }
}

__device__ __forceinline__ void hgrn_pass3_unit(Frame& F, int unit, int layer) {
    unsigned char* ws = F.ws; LAS unsigned char* lds = F.lds;
    const int bh = unit >> 4, seg = unit & 15, b_ = bh / 6, h = bh % 6;
    const int tid = F.tid, cp = tid & 63, tg = tid >> 6, lane = F.lane, w = F.wave, fr = lane & 15, g = lane >> 4;
    f32x4 acc[8];
    { const float* SS = WSP(float, WS_SST) + (size_t)unit * 16384;
#pragma unroll
      for (int nb = 0; nb < 8; ++nb)
#pragma unroll
          for (int i = 0; i < 4; ++i) acc[nb][i] = SS[(nb * 4 + i) * 512 + tid]; }
    const bf16_t* GG = WSP(bf16_t, WS_GG); bf16_t* MIX = WSP(bf16_t, WS_MIX);
    const int etok = tid >> 3, ec = (tid & 7) * 16;
    HPair r; hpair_load<true>(r, ws, b_ * SEQ + seg * (HS_CPS * 64), h, cp, tg);
#pragma unroll 1
    for (int cc = 0; cc < HS_CPS; ++cc) {
        const int row0 = b_ * SEQ + (seg * HS_CPS + cc) * 64;
        float b0[8], b1[8], k0[8], k1[8], q0[8], q1[8]; float run0 = 0.f, run1 = 0.f;
        {
            float v0[8], v1[8];
#pragma unroll
            for (int i = 0; i < 8; ++i) { run0 += r.lf[i].x; run1 += r.lf[i].y; b0[i] = run0; b1[i] = run1;
                k0[i] = bflo(r.k[i]); k1[i] = bfhi(r.k[i]); v0[i] = bflo(r.v[i]); v1[i] = bfhi(r.v[i]); q0[i] = bflo(r.q[i]); q1[i] = bfhi(r.q[i]); }
            if (cc + 1 < HS_CPS) hpair_load<true>(r, ws, row0 + 64, h, cp, tg);
            u32x4 w0, w1; w0.x = cvtpk(v0[0], v0[1]); w0.y = cvtpk(v0[2], v0[3]); w0.z = cvtpk(v0[4], v0[5]); w0.w = cvtpk(v0[6], v0[7]); w1.x = cvtpk(v1[0], v1[1]); w1.y = cvtpk(v1[2], v1[3]); w1.z = cvtpk(v1[4], v1[5]); w1.w = cvtpk(v1[6], v1[7]);
            *(LAS u32x4*)(lds + HL_VTT + (2 * cp) * 144 + tg * 16) = w0; *(LAS u32x4*)(lds + HL_VTT + (2 * cp + 1) * 144 + tg * 16) = w1;
        }
        LAS float* tot = (LAS float*)(lds + HL_TOT);
        *(LAS f32x2*)(tot + tg * 128 + 2 * cp) = (f32x2){run0, run1};
        __syncthreads();
        {
            float pre0 = 0.f, pre1 = 0.f, bt0 = 0.f, bt1 = 0.f, bm0 = 0.f, bm1 = 0.f;
#pragma unroll
            for (int q = 0; q < 8; ++q) { const f32x2 t = *(const LAS f32x2*)(tot + q * 128 + 2 * cp); if (q < tg) { pre0 += t.x; pre1 += t.y; } if (q < 4) { bm0 += t.x; bm1 += t.y; } bt0 += t.x; bt1 += t.y; }
            const float c10 = fexp(bm0), c11 = fexp(bm1), c20 = fexp(bt0 - bm0), c21 = fexp(bt1 - bm1);
            LAS unsigned* qh = (LAS unsigned*)(lds + HL_QH); LAS unsigned* qt = (LAS unsigned*)(lds + HL_QT); LAS unsigned* kt = (LAS unsigned*)(lds + HL_KTL);
#pragma unroll
            for (int i = 0; i < 8; ++i) { const float d0 = b0[i] + pre0 - bm0, d1 = b1[i] + pre1 - bm1; const int o = ((tg * 8 + i) * 136 + 2 * cp) >> 1;
                const float qt0 = q0[i] * fexp(fminf(d0, 80.f)), qt1 = q1[i] * fexp(fminf(d1, 80.f)), kt0 = k0[i] * fexp(fminf(-d0, 80.f)), kt1 = k1[i] * fexp(fminf(-d1, 80.f));
                qt[o] = cvtpk(qt0, qt1); kt[o] = cvtpk(kt0, kt1); qh[o] = cvtpk(qt0 * c10, qt1 * c11); k0[i] = kt0 * c20; k1[i] = kt1 * c21; }
            u32x4 w0, w1; w0.x = cvtpk(k0[0], k0[1]); w0.y = cvtpk(k0[2], k0[3]); w0.z = cvtpk(k0[4], k0[5]); w0.w = cvtpk(k0[6], k0[7]); w1.x = cvtpk(k1[0], k1[1]); w1.y = cvtpk(k1[2], k1[3]); w1.z = cvtpk(k1[4], k1[5]); w1.w = cvtpk(k1[6], k1[7]);
            *(LAS u32x4*)(lds + HL_KT + (2 * cp) * 144 + tg * 16) = w0; *(LAS u32x4*)(lds + HL_KT + (2 * cp + 1) * 144 + tg * 16) = w1;
            if (tg == 0) *(LAS f32x2*)(lds + HL_A + 2 * cp * 4) = (f32x2){fexp(bt0), fexp(bt1)};
        }
        __syncthreads();
        u32x4 gg[2];
#pragma unroll
        for (int j = 0; j < 2; ++j) gg[j] = *(const u32x4*)(GG + (size_t)(row0 + etok) * HW + h * 128 + ec + 8 * j);
        {
            const int tb = w >> 1;
#pragma unroll
            for (int q2 = 0; q2 < 2; ++q2) { const int sb = 2 * (w & 1) + q2; f32x4 pa = {0.f, 0.f, 0.f, 0.f};
                if (sb <= tb) {
#pragma unroll
                    for (int ks = 0; ks < 4; ++ks) { const bf16x8 af = *(const LAS bf16x8*)(lds + HL_QT + (16 * tb + fr) * 272 + ks * 64 + g * 16);
                        const bf16x8 bf = *(const LAS bf16x8*)(lds + HL_KTL + (16 * sb + fr) * 272 + ks * 64 + g * 16); pa = mfma16(af, bf, pa); } }
                LAS bf16_t* P = (LAS bf16_t*)(lds + HL_P);
#pragma unroll
                for (int i = 0; i < 4; ++i) { const int t = 16 * tb + 4 * g + i, s = 16 * sb + fr; P[t * 72 + s] = f2bf((sb <= tb && s <= t) ? pa[i] : 0.f); } }
        }
        __syncthreads();
        {
            f32x4 o[4];
#pragma unroll
            for (int tb = 0; tb < 4; ++tb) o[tb] = zero4();
#pragma unroll
            for (int ks = 0; ks < 4; ++ks) { u32x4 sw; sw.x = cvtpk(acc[2 * ks][0], acc[2 * ks][1]); sw.y = cvtpk(acc[2 * ks][2], acc[2 * ks][3]); sw.z = cvtpk(acc[2 * ks + 1][0], acc[2 * ks + 1][1]); sw.w = cvtpk(acc[2 * ks + 1][2], acc[2 * ks + 1][3]);
                const bf16x8 bf = __builtin_bit_cast(bf16x8, sw);
#pragma unroll
                for (int tb = 0; tb < 4; ++tb) { const LAS unsigned char* qp = lds + HL_QH + (16 * tb + fr) * 272 + (32 * ks + 4 * g) * 2;
                    const u32x2 lo = *(const LAS u32x2*)qp, hi = *(const LAS u32x2*)(qp + 32); u32x4 aw; aw.x = lo.x; aw.y = lo.y; aw.z = hi.x; aw.w = hi.y;
                    o[tb] = mfma16(__builtin_bit_cast(bf16x8, aw), bf, o[tb]); } }
#pragma unroll
            for (int ks = 0; ks < 2; ++ks) { const bf16x8 bf = *(const LAS bf16x8*)(lds + HL_VTT + (16 * w + fr) * 144 + ks * 64 + g * 16);
#pragma unroll
                for (int tb = 0; tb < 4; ++tb) { const bf16x8 af = *(const LAS bf16x8*)(lds + HL_P + (16 * tb + fr) * 144 + ks * 64 + g * 16); o[tb] = mfma16(af, bf, o[tb]); } }
            LAS bf16_t* O = (LAS bf16_t*)(lds + HL_O);
#pragma unroll
            for (int tb = 0; tb < 4; ++tb)
#pragma unroll
                for (int i = 0; i < 4; ++i) O[(16 * tb + 4 * g + i) * 136 + 16 * w + fr] = f2bf(o[tb][i]);
        }
        hgrn_state_update(acc, lds, w, fr, g);
        __syncthreads();
        {
            const u32x4 o0 = *(const LAS u32x4*)(lds + HL_O + etok * 272 + ec * 2), o1 = *(const LAS u32x4*)(lds + HL_O + etok * 272 + ec * 2 + 16);
            float ov[16] = {bflo(o0.x), bfhi(o0.x), bflo(o0.y), bfhi(o0.y), bflo(o0.z), bfhi(o0.z), bflo(o0.w), bfhi(o0.w), bflo(o1.x), bfhi(o1.x), bflo(o1.y), bfhi(o1.y), bflo(o1.z), bfhi(o1.z), bflo(o1.w), bfhi(o1.w)};
            float ss = 0.f;
#pragma unroll
            for (int e = 0; e < 16; ++e) ss += ov[e] * ov[e];
            ss += __shfl_xor(ss, 1); ss += __shfl_xor(ss, 2); ss += __shfl_xor(ss, 4);
            const float rstd = rsqrtf(ss * (1.f / 128.f) + EPS);
            f32x4 gain[4];
#pragma unroll
            for (int j = 0; j < 4; ++j) gain[j] = *(const f32x4*)(in_ptr(12) + layer * HW + h * 128 + ec + 4 * j);
            const unsigned gw_[8] = {gg[0].x, gg[0].y, gg[0].z, gg[0].w, gg[1].x, gg[1].y, gg[1].z, gg[1].w};
            unsigned res[8];
#pragma unroll
            for (int e = 0; e < 8; ++e) { const float ga = gain[e >> 1][(e & 1) * 2], gb = gain[e >> 1][(e & 1) * 2 + 1];
                res[e] = cvtpk(ov[2 * e] * rstd * ga * bflo(gw_[e]), ov[2 * e + 1] * rstd * gb * bfhi(gw_[e])); }
            bf16_t* mp = MIX + (size_t)(row0 + etok) * D + h * 128 + ec;
            *(u32x4*)mp = (u32x4){res[0], res[1], res[2], res[3]}; *(u32x4*)(mp + 8) = (u32x4){res[4], res[5], res[6], res[7]};
        }
        __syncthreads();
    }
}

__device__ __forceinline__ void hgrn_sample_bs(Frame& F, int bs, int layer) {
    unsigned char* ws = F.ws;
    const int row = bs, tid = F.tid, v4 = tid & 31, chg = tid >> 5;
    const float* LF = SBUF(float, SB_LF) + (size_t)row * HW; const bf16_t* KK = SBUF(bf16_t, SB_KK) + (size_t)row * HW; const bf16_t* VV = SBUF(bf16_t, SB_VV) + (size_t)row * HW;
    const bf16_t* QS = SBUF(bf16_t, SB_QS) + (size_t)row * HW; const bf16_t* GG = SBUF(bf16_t, SB_GG) + (size_t)row * HW;
    const float* S0 = in_ptr(4) + ((size_t)(layer * BS + bs) * 6) * 16384 + 4 * v4; float* SN = F.out + O_HS + ((size_t)(layer * BS + bs) * 6) * 16384 + 4 * v4;
    LAS float* red = (LAS float*)F.lds;
    f32x4 s0[8];
#pragma unroll
    for (int i = 0; i < 8; ++i) s0[i] = __builtin_nontemporal_load((const f32x4*)(S0 + (size_t)(chg + 16 * i) * 128));
#pragma unroll 1
    for (int h = 0; h < 6; ++h) {
        const int e0 = h * 128; LAS float* rb = red + (h & 1) * 2304;
        f32x4 vv; { const u32x2 w = *(const u32x2*)(VV + e0 + 4 * v4); vv = (f32x4){bflo(w.x), bfhi(w.x), bflo(w.y), bfhi(w.y)}; }
        f32x4 oacc = zero4(); f32x4 sn[8];
#pragma unroll
        for (int i = 0; i < 8; ++i) { const int ch = chg + 16 * i; const float f = fexp(LF[e0 + ch]), k = bf2f(KK[e0 + ch]), q = bf2f(QS[e0 + ch]); sn[i] = s0[i] * f + vv * k; oacc = oacc + sn[i] * q; }
        if (h < 5) {
#pragma unroll
            for (int i = 0; i < 8; ++i) s0[i] = __builtin_nontemporal_load((const f32x4*)(S0 + (size_t)(h + 1) * 16384 + (size_t)(chg + 16 * i) * 128)); }
#pragma unroll
        for (int i = 0; i < 8; ++i) __builtin_nontemporal_store(sn[i], (f32x4*)(SN + (size_t)h * 16384 + (size_t)(chg + 16 * i) * 128));
        *(LAS f32x4*)(rb + chg * 128 + 4 * v4) = oacc;
        __syncthreads();
        if (tid < 128) { float o = 0.f;
#pragma unroll
            for (int j = 0; j < 16; ++j) o += rb[j * 128 + tid];
            const float ss = wave_sum(o * o); if (F.lane == 0) rb[2048 + F.wave] = ss;
            rb[2064 + tid] = o; }
        __syncthreads();
        if (tid < 128) { const float ss = rb[2048] + rb[2049]; const float rstd = rsqrtf(ss * (1.f / 128.f) + EPS);
            SBUF(bf16_t, SB_MIX)[(size_t)row * D + e0 + tid] = f2bf(rb[2064 + tid] * rstd * in_ptr(12)[layer * HW + e0 + tid] * bf2f(GG[e0 + tid])); }
    }
    __syncthreads();
}

constexpr int AL_K = 0, AL_KROW = 144, AL_NK = 400;
constexpr int AL_V = AL_K + AL_NK * AL_KROW, AL_VROW = 816;
static_assert(AL_V + 64 * AL_VROW <= RING_BYTES, "attention lds");
__device__ __forceinline__ void attn_stage(LAS unsigned char* lds, const bf16_t* Kg, const bf16_t* Vg, int ldv, int nk, int tid) {
    for (int p = tid; p < nk * 8; p += NTHR) { const int row = p >> 3, c = p & 7; *(LAS u32x4*)(lds + AL_K + row * AL_KROW + c * 16) = *(const u32x4*)(Kg + (size_t)row * 64 + c * 8); }
    const int ppr = nk >> 3;
    for (int p = tid; p < 64 * ppr; p += NTHR) { const int row = p / ppr, c = p - row * ppr; *(LAS u32x4*)(lds + AL_V + row * AL_VROW + c * 16) = *(const u32x4*)(Vg + (size_t)row * ldv + c * 8); }
}
template <int NKB, bool SWA>
__device__ __forceinline__ void attn16(const bf16x8 (&qf)[2], LAS const unsigned char* lds, int koff, bf16_t* Orow0, int o_ld, float sink2, bool has_sink, int t0, int lane) {
    constexpr int NKS = (NKB + 1) / 2, NKP = 2 * NKS;
    const int fr = lane & 15, g = lane >> 4;
    LAS const unsigned char* Kl = lds + AL_K + (koff + fr) * AL_KROW + g * 16;
    LAS const unsigned char* Vl = lds + AL_V + fr * AL_VROW + (koff + 4 * g) * 2;
    f32x4 s[NKP];
#pragma unroll
    for (int blk = 0; blk < NKP; ++blk) { s[blk] = zero4();
        if (blk < NKB) {
#pragma unroll
            for (int ks = 0; ks < 2; ++ks) { const bf16x8 kf = *(const LAS bf16x8*)(Kl + blk * 16 * AL_KROW + ks * 64); s[blk] = mfma16(kf, qf[ks], s[blk]); } }
        if ((blk & 3) == 3) asm volatile("" ::: "memory"); }
    float m = -1e30f;
    if (SWA) { const int lo = max(fr + 1, 128 - t0), hi = fr + 128;
#pragma unroll
        for (int blk = 0; blk < NKP; ++blk)
#pragma unroll
            for (int i = 0; i < 4; ++i) { const int kidx = 16 * blk + 4 * g + i; if (blk >= NKB || kidx < lo || kidx > hi) s[blk][i] = -1e30f; } }
#pragma unroll
    for (int blk = 0; blk < NKB; ++blk)
#pragma unroll
        for (int i = 0; i < 4; ++i) m = fmaxf(m, s[blk][i]);
    m = fmaxf(m, __shfl_xor(m, 16)); m = fmaxf(m, __shfl_xor(m, 32));
    if (has_sink) m = fmaxf(m, sink2);
    float l = 0.f;
#pragma unroll
    for (int blk = 0; blk < NKP; ++blk)
#pragma unroll
        for (int i = 0; i < 4; ++i) { const float p = (blk < NKB) ? __builtin_amdgcn_exp2f(s[blk][i] - m) : 0.f; s[blk][i] = p; l += p; }
    l += __shfl_xor(l, 16); l += __shfl_xor(l, 32);
    if (has_sink) l += __builtin_amdgcn_exp2f(sink2 - m);
    const float inv = __builtin_amdgcn_rcpf(l);
    f32x4 o[4];
#pragma unroll
    for (int db = 0; db < 4; ++db) o[db] = zero4();
#pragma unroll
    for (int ks = 0; ks < NKS; ++ks) {
        u32x4 pw; pw.x = cvtpk(s[2 * ks][0], s[2 * ks][1]); pw.y = cvtpk(s[2 * ks][2], s[2 * ks][3]); pw.z = cvtpk(s[2 * ks + 1][0], s[2 * ks + 1][1]); pw.w = cvtpk(s[2 * ks + 1][2], s[2 * ks + 1][3]);
        const bf16x8 pf = __builtin_bit_cast(bf16x8, pw);
#pragma unroll
        for (int db = 0; db < 4; ++db) { LAS const unsigned char* vp = Vl + db * 16 * AL_VROW + ks * 64;
            const u32x2 lo = *(const LAS u32x2*)vp, hi = *(const LAS u32x2*)(vp + 32); u32x4 vw; vw.x = lo.x; vw.y = lo.y; vw.z = hi.x; vw.w = hi.y;
            o[db] = mfma16(__builtin_bit_cast(bf16x8, vw), pf, o[db]); }
        asm volatile("" ::: "memory"); }
#pragma unroll
    for (int db = 0; db < 4; ++db) { u32x2 wv; wv.x = cvtpk(o[db][0] * inv, o[db][1] * inv); wv.y = cvtpk(o[db][2] * inv, o[db][3] * inv);
        *(u32x2*)(Orow0 + (size_t)fr * o_ld + 16 * db + 4 * g) = wv; }
}

__device__ __forceinline__ void memattn_wg(Frame& F, int u, int layer) {
    unsigned char* ws = F.ws;
    const int qc = u & 31, h = (u >> 5) & 3, b = u >> 7;
    const bf16_t* Kb = WSP(bf16_t, WS_MKB) + (size_t)((layer * 2 + b) * 4 + h) * 256 * 64; const bf16_t* Vb = WSP(bf16_t, WS_MVT) + (size_t)((layer * 2 + b) * 4 + h) * 64 * 256;
    const bf16_t* CQ = WSP(bf16_t, WS_CQ); bf16_t* MIX = WSP(bf16_t, WS_MIX);
    const int fr = F.lane & 15, g = F.lane >> 4;
    bf16x8 qf[2][2];
#pragma unroll
    for (int j = 0; j < 2; ++j)
#pragma unroll
        for (int ks = 0; ks < 2; ++ks) qf[j][ks] = *(const bf16x8*)(CQ + (size_t)(b * SEQ + qc * 256 + (F.wave + 8 * j) * 16 + fr) * XW + h * 64 + ks * 32 + g * 8);
    attn_stage(F.lds, Kb, Vb, 256, 256, F.tid);
    __syncthreads();
#pragma unroll
    for (int j = 0; j < 2; ++j) { const int row0 = b * SEQ + qc * 256 + (F.wave + 8 * j) * 16;
        attn16<16, false>(qf[j], F.lds, 0, MIX + (size_t)row0 * D + HW + h * 64, D, 0.f, false, 0, F.lane); }
    __syncthreads();
}
__device__ __forceinline__ void swa_wg(Frame& F, int u, int j) {
    unsigned char* ws = F.ws;
    const int qc = u & 31, kvh = (u >> 5) & 3, b = u >> 7, tq0 = qc * 256;
    const bf16_t* Kb = WSP(bf16_t, WS_KR) + ((size_t)(b * 4 + kvh) * KVP + tq0) * 64; const bf16_t* Vb = WSP(bf16_t, WS_VT) + (size_t)(b * 4 + kvh) * 64 * KVP + tq0;
    const bf16_t* QR = WSP(bf16_t, WS_QS); bf16_t* MIX = WSP(bf16_t, WS_MIX);
    const int fr = F.lane & 15, g = F.lane >> 4;
    bf16x8 qf[2][3][2]; float sk2[3];
#pragma unroll
    for (int gi = 0; gi < 3; ++gi) sk2[gi] = in_ptr(14)[j * 12 + kvh * 3 + gi] * LOG2E;
#pragma unroll
    for (int qb = 0; qb < 2; ++qb)
#pragma unroll
        for (int gi = 0; gi < 3; ++gi)
#pragma unroll
            for (int ks = 0; ks < 2; ++ks) qf[qb][gi][ks] = *(const bf16x8*)(QR + (size_t)(b * SEQ + tq0 + F.wave * 16 + qb * 128 + fr) * HW + (kvh * 3 + gi) * 64 + ks * 32 + g * 8);
    attn_stage(F.lds, Kb, Vb, KVP, AL_NK, F.tid);
    __syncthreads();
#pragma unroll
    for (int qb = 0; qb < 2; ++qb) { const int koff = F.wave * 16 + qb * 128, t0 = tq0 + koff, row0 = b * SEQ + t0;
#pragma unroll
        for (int gi = 0; gi < 3; ++gi) { const int hq = kvh * 3 + gi;
            attn16<9, true>(qf[qb][gi], F.lds, koff, MIX + (size_t)row0 * D + hq * 64, D, sk2[gi], true, t0, F.lane); } }
    __syncthreads();
}

__device__ __forceinline__ void memattn_sample_bs(Frame& F, int bs, int layer) {
    unsigned char* ws = F.ws; LAS float* L = (LAS float*)F.lds;
    const int lane = F.lane, w = F.wave, hh = lane >> 4, dl = lane & 15;
    const bf16_t* CQ = SBUF(bf16_t, SB_CQ) + (size_t)bs * XW + hh * 64 + 4 * dl;
    const u32x2 qw = *(const u32x2*)CQ; const f32x4 q4 = {bflo(qw.x), bfhi(qw.x), bflo(qw.y), bfhi(qw.y)};
    const float* Kc = in_ptr(2) + ((size_t)(layer * BS + bs) * 256 + 32 * w) * 256 + 4 * lane; const float* Vc = in_ptr(3) + ((size_t)(layer * BS + bs) * 256 + 32 * w) * 256 + 4 * lane;
    f32x4 kv[32]; float s[32];
#pragma unroll
    for (int i = 0; i < 32; ++i) kv[i] = __builtin_nontemporal_load((const f32x4*)(Kc + (size_t)i * 256));
    float m = -1e30f;
#pragma unroll
    for (int i = 0; i < 32; ++i) { float d = (kv[i].x * q4.x + kv[i].y * q4.y) + (kv[i].z * q4.z + kv[i].w * q4.w); d += __shfl_xor(d, 1); d += __shfl_xor(d, 2); d += __shfl_xor(d, 4); d += __shfl_xor(d, 8); s[i] = d; m = fmaxf(m, d); }
#pragma unroll
    for (int i = 0; i < 32; ++i) kv[i] = __builtin_nontemporal_load((const f32x4*)(Vc + (size_t)i * 256));
    if (dl == 0) L[w * 4 + hh] = m;
    __syncthreads();
#pragma unroll
    for (int j = 0; j < 8; ++j) m = fmaxf(m, L[j * 4 + hh]);
    float l = 0.f; f32x4 o = {0.f, 0.f, 0.f, 0.f};
#pragma unroll
    for (int i = 0; i < 32; ++i) { const float p = __builtin_amdgcn_exp2f(s[i] - m); l += p; o = o + kv[i] * p; }
    if (dl == 0) L[32 + w * 4 + hh] = l;
    *(LAS f32x4*)(L + 64 + w * 256 + 4 * lane) = o;
    __syncthreads();
    if (F.tid < 256) { const int t = F.tid, h2 = t >> 6; float acc = 0.f, ls = 0.f;
#pragma unroll
        for (int j = 0; j < 8; ++j) { acc += L[64 + j * 256 + t]; ls += L[32 + j * 4 + h2]; }
        SBUF(bf16_t, SB_MIX)[(size_t)bs * D + HW + t] = f2bf(acc * __builtin_amdgcn_rcpf(ls)); }
    __syncthreads();
}

__device__ __forceinline__ void swa_sample_bs(Frame& F, int bs, int j) {
    unsigned char* ws = F.ws; LAS float* L = (LAS float*)F.lds;
    const int lane = F.lane, w = F.wave, kvh = lane >> 4, dl = lane & 15;
    const bf16_t* QR = SBUF(bf16_t, SB_QS) + (size_t)bs * HW;
    f32x4 q4[3];
#pragma unroll
    for (int gi = 0; gi < 3; ++gi)
#pragma unroll
        for (int e = 0; e < 4; ++e) { const int d = 4 * dl + e; q4[gi][e] = bf2f(QR[(kvh * 3 + gi) * 64 + 2 * (d & 31) + (d >> 5)]); }
    const float* KSN = WSP(float, WS_KSN) + (size_t)bs * 256 + 4 * lane; const float* VSN = WSP(float, WS_VSN) + (size_t)bs * 256 + 4 * lane;
    f32x4 kv[16]; float s[3][16];
#pragma unroll
    for (int i = 0; i < 16; ++i) { const int key = 16 * w + i; kv[i] = key < 127 ? __builtin_nontemporal_load((const f32x4*)(in_ptr(5) + ((size_t)(bs * 128 + key + 1)) * 256 + 4 * lane)) : *(const f32x4*)KSN; }
    float m[3] = {-1e30f, -1e30f, -1e30f};
#pragma unroll
    for (int i = 0; i < 16; ++i) { const int key = 16 * w + i;
        if (j == 0 && key < 127) __builtin_nontemporal_store(kv[i], (f32x4*)(F.out + O_SKS + ((size_t)(bs * 128 + key)) * 256 + 4 * lane));
#pragma unroll
        for (int gi = 0; gi < 3; ++gi) { float d = (kv[i].x * q4[gi].x + kv[i].y * q4[gi].y) + (kv[i].z * q4[gi].z + kv[i].w * q4[gi].w); d += __shfl_xor(d, 1); d += __shfl_xor(d, 2); d += __shfl_xor(d, 4); d += __shfl_xor(d, 8); s[gi][i] = d; m[gi] = fmaxf(m[gi], d); } }
#pragma unroll
    for (int i = 0; i < 16; ++i) { const int key = 16 * w + i; kv[i] = key < 127 ? __builtin_nontemporal_load((const f32x4*)(in_ptr(6) + ((size_t)(bs * 128 + key + 1)) * 256 + 4 * lane)) : *(const f32x4*)VSN; }
    if (dl == 0) {
#pragma unroll
        for (int gi = 0; gi < 3; ++gi) L[w * 12 + kvh * 3 + gi] = m[gi]; }
    __syncthreads();
    float l[3]; f32x4 o[3];
#pragma unroll
    for (int gi = 0; gi < 3; ++gi) { const float sink2 = in_ptr(14)[j * 12 + kvh * 3 + gi] * LOG2E; float mm = sink2;
#pragma unroll
        for (int jw = 0; jw < 8; ++jw) mm = fmaxf(mm, L[jw * 12 + kvh * 3 + gi]);
        m[gi] = mm; l[gi] = w == 0 ? __builtin_amdgcn_exp2f(sink2 - mm) : 0.f; o[gi] = zero4(); }
#pragma unroll
    for (int i = 0; i < 16; ++i) { const int key = 16 * w + i;
        if (j == 0 && key < 127) __builtin_nontemporal_store(kv[i], (f32x4*)(F.out + O_SVS + ((size_t)(bs * 128 + key)) * 256 + 4 * lane));
#pragma unroll
        for (int gi = 0; gi < 3; ++gi) { const float p = __builtin_amdgcn_exp2f(s[gi][i] - m[gi]); l[gi] += p; o[gi] = o[gi] + kv[i] * p; } }
#pragma unroll
    for (int gi = 0; gi < 3; ++gi) { if (dl == 0) L[96 + w * 12 + kvh * 3 + gi] = l[gi]; *(LAS f32x4*)(L + 192 + (w * 3 + gi) * 256 + 4 * lane) = o[gi]; }
    __syncthreads();
    for (int t = F.tid; t < 768; t += NTHR) { const int gi = t >> 8, r = t & 255, kv2 = r >> 6, d = r & 63; float acc = 0.f, ls = 0.f;
#pragma unroll
        for (int jw = 0; jw < 8; ++jw) { acc += L[192 + (jw * 3 + gi) * 256 + r]; ls += L[96 + jw * 12 + kv2 * 3 + gi]; }
        SBUF(bf16_t, SB_MIX)[(size_t)bs * D + (kv2 * 3 + gi) * 64 + d] = f2bf(acc * __builtin_amdgcn_rcpf(ls)); }
    __syncthreads();
}

__device__ __forceinline__ int q_pull(Frame& F, unsigned* ctr) {
    volatile LAS int* slot = (volatile LAS int*)(F.lds + MISC_OFF + 64);
    __syncthreads();
    if (F.tid == 0) *slot = (int)__hip_atomic_fetch_add(ctr, 1u, __ATOMIC_RELAXED, __HIP_MEMORY_SCOPE_AGENT);
    __syncthreads();
    { int t_ = F.tid; asm volatile("" : "+v"(t_)); F.tid = t_; F.lane = t_ & 63; }
    return *slot;
}

constexpr int SL_X = 0, SL_XROW = 2064;
enum { SK_NONE = 0, SK_INA, SK_INB, SK_MIXA, SK_MIXB, SK_WO, SK_UP, SK_DOWN, SK_FINAL };

__device__ __forceinline__ void sample_norm_slab(Frame& F, int rg, const float* Hin, float* Hout, const float* Y, int nparts, const float* gpost, bool write_h) {
    const int tid = F.tid, r = tid >> 5, c = tid & 31, row = 16 * rg + r;
    f32x4 h[8]; float ss1 = 0.f;
    if (Y) {
        f32x4 y[8];
#pragma unroll
        for (int j = 0; j < 8; ++j) { y[j] = zero4();
            for (int p = 0; p < nparts; ++p) y[j] = y[j] + *(const f32x4*)(Y + ((size_t)p * BS + row) * D + 4 * c + 128 * j);
            ss1 += (y[j].x * y[j].x + y[j].y * y[j].y) + (y[j].z * y[j].z + y[j].w * y[j].w); }
        ss1 += __shfl_xor(ss1, 1); ss1 += __shfl_xor(ss1, 2); ss1 += __shfl_xor(ss1, 4); ss1 += __shfl_xor(ss1, 8); ss1 += __shfl_xor(ss1, 16);
        const float rstd1 = rsqrtf(ss1 * (1.f / D) + EPS);
#pragma unroll
        for (int j = 0; j < 8; ++j) h[j] = *(const f32x4*)(Hin + (size_t)row * D + 4 * c + 128 * j) + y[j] * rstd1 * *(const f32x4*)(gpost + 4 * c + 128 * j);
    } else {
#pragma unroll
        for (int j = 0; j < 8; ++j) h[j] = *(const f32x4*)(Hin + (size_t)row * D + 4 * c + 128 * j);
    }
    float ss2 = 0.f;
#pragma unroll
    for (int j = 0; j < 8; ++j) { ss2 += (h[j].x * h[j].x + h[j].y * h[j].y) + (h[j].z * h[j].z + h[j].w * h[j].w); if (write_h) *(f32x4*)(Hout + (size_t)row * D + 4 * c + 128 * j) = h[j]; }
    ss2 += __shfl_xor(ss2, 1); ss2 += __shfl_xor(ss2, 2); ss2 += __shfl_xor(ss2, 4); ss2 += __shfl_xor(ss2, 8); ss2 += __shfl_xor(ss2, 16);
    const float rstd2 = rsqrtf(ss2 * (1.f / D) + EPS);
#pragma unroll
    for (int j = 0; j < 8; ++j) { u32x2 w; w.x = cvtpk(h[j].x * rstd2, h[j].y * rstd2); w.y = cvtpk(h[j].z * rstd2, h[j].w * rstd2); *(LAS u32x2*)(F.lds + SL_X + r * SL_XROW + (4 * c + 128 * j) * 2) = w; }
}
__device__ __forceinline__ void sample_copy_slab(Frame& F, const bf16_t* A, int lda) {
#pragma unroll
    for (int j = 0; j < 4; ++j) { const int p = F.tid + NTHR * j, r = p >> 7, c = p & 127; *(LAS u32x4*)(F.lds + SL_X + r * SL_XROW + c * 16) = *(const u32x4*)(A + (size_t)r * lda + c * 8); }
}
__device__ __forceinline__ void sample_wave_gemm(f32x4& acc, LAS const unsigned char* lds, const bf16_t* Wt, int ldw, int n0, int lane) {
    const int fr = lane & 15, g = lane >> 4;
    acc = zero4();
    const bf16_t* wp = Wt + (size_t)(n0 + fr) * ldw + g * 8; LAS const unsigned char* xp = lds + SL_X + fr * SL_XROW + g * 16;
    bf16x8 wf[32];
#pragma unroll
    for (int k = 0; k < 32; ++k) wf[k] = *(const bf16x8*)(wp + k * 32);
#pragma unroll
    for (int k = 0; k < 32; ++k) { const bf16x8 xf = *(const LAS bf16x8*)(xp + k * 64); acc = mfma16(wf[k], xf, acc); }
}

__device__ __forceinline__ void sample_epi_ina(Frame& F, const f32x4& v, int row, int c, int layer) {
    unsigned char* ws = F.ws;
    if (c >= 3072) { u32x2 w; w.x = cvtpk(v[0], v[1]); w.y = cvtpk(v[2], v[3]); *(u32x2*)(SBUF(bf16_t, SB_CQ) + (size_t)row * XW + (c - 3072)) = w; return; }
    const int sec = c / HW, cl = c - sec * HW; const size_t o = (size_t)row * HW + cl;
    if (sec == 1) { const f32x4 lb = *(const f32x4*)(WSP(float, WS_LBS) + layer * HW + cl); float lf[4], kk[4];
#pragma unroll
        for (int e = 0; e < 4; ++e) { const float z = v[e], t = fexp(-fabsf(z)), r = __builtin_amdgcn_rcpf(1.0f + t), big = r, small = t * r; const float sp = z >= 0.f ? big : small, sn = z >= 0.f ? small : big;
            const float f = lb[e] + (1.0f - lb[e]) * sp; lf[e] = flog(f); kk[e] = (1.0f - lb[e]) * sn; }
        *(f32x4*)(SBUF(float, SB_LF) + o) = (f32x4){lf[0], lf[1], lf[2], lf[3]}; u32x2 w; w.x = cvtpk(kk[0], kk[1]); w.y = cvtpk(kk[2], kk[3]); *(u32x2*)(SBUF(bf16_t, SB_KK) + o) = w;
    } else { f32x4 x = v; if (sec != 2) {
#pragma unroll
            for (int e = 0; e < 4; ++e) x[e] = fsilu(x[e]); }
        bf16_t* dst = sec == 0 ? SBUF(bf16_t, SB_QS) : (sec == 2 ? SBUF(bf16_t, SB_VV) : SBUF(bf16_t, SB_GG));
        u32x2 w; w.x = cvtpk(x[0], x[1]); w.y = cvtpk(x[2], x[3]); *(u32x2*)(dst + o) = w; }
}
__device__ __forceinline__ void sample_epi_inb(Frame& F, const f32x4& v, int row, int c) {
    unsigned char* ws = F.ws;
    if (c >= 768 && c < 1024) { u32x2 w; w.x = cvtpk(v[0], v[1]); w.y = cvtpk(v[2], v[3]); *(u32x2*)(SBUF(bf16_t, SB_CQ) + (size_t)row * XW + (c - 768)) = w; return; }
    if (c >= 1280) { const int cc = c - 1280; float* op = F.out + O_SVS + ((size_t)(row * 128 + 127) * 4) * 64 + cc; *(f32x4*)op = v; *(f32x4*)(WSP(float, WS_VSN) + (size_t)row * 256 + cc) = v; return; }
    const int cc = c < 768 ? c : c - 1024, i0 = (cc & 63) >> 1; const f32x2* rp = WSP(f32x2, WS_ROPE) + (size_t)SEQ * 32 + i0;
    float o[4];
#pragma unroll
    for (int p = 0; p < 2; ++p) { const f32x2 cs = rp[p]; const float x1 = v[2 * p], x2 = v[2 * p + 1]; o[2 * p] = x1 * cs.x - x2 * cs.y; o[2 * p + 1] = x2 * cs.x + x1 * cs.y; }
    if (c < 768) { u32x2 w; w.x = cvtpk(o[0], o[1]); w.y = cvtpk(o[2], o[3]); *(u32x2*)(SBUF(bf16_t, SB_QS) + (size_t)row * HW + c) = w; }
    else { const int hh = cc >> 6; float* op = F.out + O_SKS + ((size_t)(row * 128 + 127) * 4 + hh) * 64; float* sp = WSP(float, WS_KSN) + (size_t)(row * 4 + hh) * 64;
#pragma unroll
        for (int p = 0; p < 2; ++p) { op[i0 + p] = o[2 * p]; op[i0 + p + 32] = o[2 * p + 1]; sp[i0 + p] = o[2 * p]; sp[i0 + p + 32] = o[2 * p + 1]; } }
}

__device__ __forceinline__ void sample_gemm_a(Frame& F, int u, int kind, int layer) {
    unsigned char* ws = F.ws;
    const int N = kind == SK_INA ? NA : (kind == SK_UP ? FF : (layer == 2 ? 1536 : 1024)), NC = N / 128, rg = u / NC, cc = u - rg * NC;
    const int upd = kind == SK_UP ? 2 * layer + 1 : 2 * layer;
    const float* Hin = upd == 0 ? in_ptr(1) : SBUF(float, (upd & 1) ? SB_H0 : SB_H1); float* Hout = SBUF(float, (upd & 1) ? SB_H1 : SB_H0);
    const float* Y = upd == 0 ? nullptr : (kind == SK_UP ? SBUF(float, SB_Y1) : SBUF(float, SB_Y2));
    const float* gpost = kind == SK_UP ? in_ptr(19) + layer * D : in_ptr(21) + (layer - 1) * D;
    sample_norm_slab(F, rg, Hin, Hout, Y, kind == SK_UP ? 1 : 4, gpost, cc == 0);
    __syncthreads();
    const bf16_t* Wt = kind == SK_INA ? WSP(bf16_t, WS_WINA + (size_t)layer * SZ_WINA) : (kind == SK_UP ? WSP(bf16_t, WS_WUP + (size_t)layer * 8388608) : (layer == 2 ? WSP(bf16_t, WS_WINB0) : WSP(bf16_t, WS_WINB1)));
    const int n0 = cc * 128 + F.wave * 16, fr = F.lane & 15, g = F.lane >> 4, row = 16 * rg + fr;
    f32x4 acc[1]; sample_wave_gemm(acc[0], F.lds, Wt, D, n0, F.lane);
#pragma unroll
    for (int t = 0; t < 1; ++t) { const int c = n0 + 16 * t + 4 * g;
        if (kind == SK_UP) { f32x4 x = acc[t];
#pragma unroll
            for (int e = 0; e < 4; ++e) { const float r = fmaxf(x[e], 0.f); x[e] = r * r; }
            u32x2 w; w.x = cvtpk(x[0], x[1]); w.y = cvtpk(x[2], x[3]); *(u32x2*)(SBUF(bf16_t, SB_HB) + (size_t)row * FF + c) = w; }
        else if (kind == SK_INA) sample_epi_ina(F, acc[t], row, c, layer);
        else sample_epi_inb(F, acc[t], row, c); }
    __syncthreads();
}
__device__ __forceinline__ void sample_gemm_b(Frame& F, int u, int kind, int layer) {
    unsigned char* ws = F.ws;
    const int ks = kind == SK_DOWN ? (u & 3) : 0, uu = kind == SK_DOWN ? (u >> 2) : u, rg = uu >> 3, cc = uu & 7;
    const bf16_t* A = kind == SK_DOWN ? SBUF(bf16_t, SB_HB) + (size_t)(16 * rg) * FF + ks * 1024 : SBUF(bf16_t, SB_MIX) + (size_t)(16 * rg) * D;
    sample_copy_slab(F, A, kind == SK_DOWN ? FF : D);
    __syncthreads();
    const bf16_t* Wt = kind == SK_DOWN ? WSP(bf16_t, WS_WDN + (size_t)layer * 8388608) + ks * 1024 : WSP(bf16_t, WS_WOUT + (size_t)layer * 2097152);
    const int n0 = cc * 128 + F.wave * 16, fr = F.lane & 15, g = F.lane >> 4, row = 16 * rg + fr;
    f32x4 acc[1]; sample_wave_gemm(acc[0], F.lds, Wt, kind == SK_DOWN ? FF : D, n0, F.lane);
    float* Yo = kind == SK_DOWN ? SBUF(float, SB_Y2) + (size_t)ks * BS * D : SBUF(float, SB_Y1);
    *(f32x4*)(Yo + (size_t)row * D + n0 + 4 * g) = acc[0];
    __syncthreads();
}
__device__ __forceinline__ void sample_final(Frame& F, int rg) {
    unsigned char* ws = F.ws;
    sample_norm_slab(F, rg, SBUF(float, SB_H1), F.out + O_YS, SBUF(float, SB_Y2), 4, in_ptr(21) + 3 * D, true);
    __syncthreads();
}

enum { OP_PROLOGUE = 0, OP_GEMM, OP_MIXA, OP_H2, OP_H3, OP_MIXB, OP_NORM, OP_NONE };
struct Phase { int op, layer; unsigned long long aoff, boff; int M, N, K, ekind, cshift, nobar, sk, sl; };
#define PH_GEMM(l, A, B, M, N, K, ek, cs, nb, sk, sl) {OP_GEMM, l, A, B, M, N, K, ek, cs, nb, sk, sl}
#define PH_WO(l, sk, sl) PH_GEMM(l, WS_MIX, WS_WOUT + (size_t)(l) * 2097152, MP, D, D, EK_FUSED, 2 * (l), 0, sk, sl)
#define PH_UP(l, sk, sl) PH_GEMM(l, WS_H, WS_WUP + (size_t)(l) * 8388608, MP, FF, D, EK_UP, 0, 0, sk, sl)
#define PH_DN(l, sk, sl) PH_GEMM(l, WS_HB, WS_WDN + (size_t)(l) * 8388608, MP, D, FF, EK_FUSED, 2 * (l) + 1, 0, sk, sl)
#define PH_N1(l, sk, sl) {OP_NORM, l, 0, 0, 0, 0, 0, 19, 0, 0, sk, sl}
#define PH_N2(l, sk, sl) {OP_NORM, l, 0, 0, (l) == 3, 0, 0, 21, 0, 0, sk, sl}
#define PH_OP(op, l, sk, sl) {op, l, 0, 0, 0, 0, 0, 0, 0, 0, sk, sl}
#define DY(k) ((k) | 16)
__constant__ Phase c_prog[] = {
    PH_OP(OP_PROLOGUE, 0, 0, 0),
    PH_GEMM(0, WS_MN, WS_WMEM, 512, 2048, D, EK_MEMKV, 16, 1, 0, 0),
    PH_GEMM(0, WS_XN, WS_WINA, MP, NA, D, EK_INA, 0, 0, DY(SK_INA), 0),
    PH_OP(OP_MIXA, 0, DY(SK_MIXA), 0), PH_OP(OP_H2, 0, SK_WO, 0), PH_OP(OP_H3, 0, DY(SK_UP), 0),
    PH_WO(0, SK_DOWN, 0), PH_UP(0, 0, 0), PH_DN(0, 0, 0),
    PH_GEMM(1, WS_H, WS_WINA + SZ_WINA, MP, NA, D, EK_INA, 0, 0, DY(SK_INA), 1),
    PH_OP(OP_MIXA, 1, DY(SK_MIXA), 1), PH_OP(OP_H2, 1, SK_WO, 1), PH_OP(OP_H3, 1, DY(SK_UP), 1),
    PH_WO(1, SK_DOWN, 1), PH_UP(1, SK_INB, 2), PH_DN(1, 0, 0),
    PH_GEMM(0, WS_H, WS_WINB0, MP, 1536, D, EK_INB, 0, 0, DY(SK_MIXB), 2),
    PH_OP(OP_MIXB, 2, DY(SK_WO), 2),
    PH_WO(2, SK_UP, 2), PH_UP(2, SK_DOWN, 2), PH_DN(2, SK_INB, 3),
    PH_GEMM(1, WS_H, WS_WINB1, MP, 1024, D, EK_INB, 0, 0, 0, 0),
    PH_OP(OP_MIXB, 3, DY(SK_MIXB), 3),
    PH_WO(3, SK_WO, 3), PH_UP(3, SK_UP, 3), PH_DN(3, SK_DOWN, 3),
    PH_OP(OP_NONE, 0, SK_FINAL, 0),
};
constexpr int NPHASE = sizeof(c_prog) / sizeof(Phase);

__global__ void __launch_bounds__(NTHR, 2) yoco_fwd(Args args) {
    extern __shared__ __attribute__((aligned(16))) unsigned char lds_raw[];
    Frame F;
    F.lds = (LAS unsigned char*)lds_raw;
    F.tid = threadIdx.x; F.lane = F.tid & 63; F.wave = __builtin_amdgcn_readfirstlane(F.tid >> 6);
    F.G = gridDim.x; { const int bx = blockIdx.x; F.vcu = (F.G % 8 == 0) ? (bx % 8) * (F.G / 8) + bx / 8 : bx; }
    F.ws = args.ws; F.out = args.out;
    unsigned char* ws = F.ws;
    for (int u = F.tid; u < (LDS_BYTES - LDSCTL_OFF) / 4; u += NTHR) ((LAS unsigned*)(F.lds + LDSCTL_OFF))[u] = 0u;
    __syncthreads();
    XcdBarrier bar = xcd_barrier_post((unsigned*)(ws + WS_CTL) + 4096, (volatile LAS unsigned*)(F.lds + MISC_OFF) + 8);
#define GRID_BAR() xcd_barrier(bar)
    const int G = F.G, bx = blockIdx.x;

#pragma unroll 1
    for (int ph = 0; ph < NPHASE; ++ph) {
        const Phase P = c_prog[ph];
        const int l = P.layer;
        unsigned* qctr = (unsigned*)(ws + WS_CTL) + 8192 + 64 * ph;
        { int t_ = threadIdx.x; asm volatile("" : "+v"(t_)); F.tid = t_; F.lane = t_ & 63; F.wave = __builtin_amdgcn_readfirstlane(t_ >> 6); }
#ifndef PROBE_DUP_MASK
#define PROBE_DUP_MASK 0
#endif
#ifndef PROBE_DUP_EK
#define PROBE_DUP_EK 0
#endif
        const int reps_ = (((PROBE_DUP_MASK >> P.op) & 1) || (P.op == OP_GEMM && ((PROBE_DUP_EK >> P.ekind) & 1))) ? 2 : 1;
#pragma unroll 1
        for (int rep_ = 0; rep_ < reps_; ++rep_) {
        switch (P.op) {
        case OP_PROLOGUE: p0_prologue(F); break;
        case OP_GEMM: {
            pg8::Gemm g{(const bf16_t*)(ws + P.aoff), (const bf16_t*)(ws + P.boff), P.M, P.N, P.K}; pg8::StaticOrder S; S.init(P.M, P.N, G, (bx + P.cshift) % G);
            if (P.ekind == EK_FUSED) {
                const int inst = P.cshift; unsigned* ctl = (unsigned*)(ws + WS_CTL); unsigned long long* xb = WSP(unsigned long long, WS_XCH) + (size_t)inst * 2 * 65536;
                const bool last = inst == 7; bf16_t* H = WSP(bf16_t, WS_H);
                EpiFused E{inst == 0 ? in_ptr(0) : (const float*)nullptr, H, last ? F.out + O_YP : (float*)nullptr, H, last ? (bf16_t*)nullptr : WSP(bf16_t, WS_RS2), in_ptr((inst & 1) ? 21 : 19) + l * D,
                           PanelSq{xb, (unsigned)(inst * 2 + 1), ctl}, PanelSq{xb + 65536, (unsigned)(inst * 2 + 2), ctl}};
                pg8::StaticOrder S2; S2.init(P.M, P.N, G, bx);
                pg8::gemm_phase<true>(F.lds, g, S2, E, F.tid);
            } else { Epi E{P.ekind, l, F.ws, F.out}; pg8::gemm_phase<false>(F.lds, g, S, E, F.tid); }
        } break;
        case OP_MIXA:
            if (F.vcu < HS_UNITS) hgrn_pass1_unit(F, F.vcu);
            else { memattn_wg(F, F.vcu - HS_UNITS, l); memattn_wg(F, F.vcu - HS_UNITS + 64, l); }
            break;
        case OP_H2: hgrn_pass2(F, l); break;
        case OP_H3:
            if (F.vcu < HS_UNITS) hgrn_pass3_unit(F, F.vcu, l);
            else { memattn_wg(F, F.vcu - HS_UNITS + 128, l); memattn_wg(F, F.vcu - HS_UNITS + 192, l); }
            break;
        case OP_MIXB:
            swa_wg(F, F.vcu, l - 2); memattn_wg(F, F.vcu, l);
            break;
        case OP_NORM: norm_phase(F, in_ptr(P.ekind) + l * D, P.M != 0); break;
        default: break;
        }
        if (P.sk != SK_NONE && rep_ == 0) {
            const int sk = P.sk & 15, sl = P.sl, dyn = P.sk >> 4;
            const int nu = sk == SK_INA ? 208 : sk == SK_INB ? (sl == 2 ? 96 : 64) : sk == SK_MIXA ? 256 : sk == SK_MIXB ? 256 : sk == SK_WO ? 64 : sk == SK_UP ? 256 : sk == SK_DOWN ? 256 : 8;
            int i = dyn ? 0 : F.vcu;
            __syncthreads();
            for (;;) { if (dyn) i = q_pull(F, qctr + 32); if (i >= nu) break;
                if (sk == SK_INA || sk == SK_INB || sk == SK_UP) sample_gemm_a(F, i, sk, sl);
                else if (sk == SK_WO || sk == SK_DOWN) sample_gemm_b(F, i, sk, sl);
                else if (sk == SK_MIXA) { if (i < 128) hgrn_sample_bs(F, i, sl); else memattn_sample_bs(F, i - 128, sl); }
                else if (sk == SK_MIXB) { if (i < 128) swa_sample_bs(F, i, sl - 2); else memattn_sample_bs(F, i - 128, sl); }
                else sample_final(F, i);
                if (!dyn) i += G; }
        }
        if (!P.nobar || reps_ > 1) GRID_BAR();
        }
    }
}

extern "C" void kernel_launch(void* const* d_in, const int* in_sizes, int n_in, void* d_out, int out_size, void* d_ws, size_t ws_size, hipStream_t stream) {
    static int grid = 0;
    if (grid == 0) {
        if (n_in != 24 || (size_t)out_size != O_END || ws_size < WS_END) { fprintf(stderr, "kernel_launch: unexpected shapes: n_in %d out %d ws %zu (need %zu)\n", n_in, out_size, ws_size, (size_t)WS_END); grid = -1; return; }
        int dev = 0, cus = 0, per_cu = 0;
        if (hipGetDevice(&dev) != hipSuccess || hipDeviceGetAttribute(&cus, hipDeviceAttributeMultiprocessorCount, dev) != hipSuccess) { grid = -1; return; }
        if (hipFuncSetAttribute((const void*)yoco_fwd, hipFuncAttributeMaxDynamicSharedMemorySize, LDS_BYTES) != hipSuccess) { fprintf(stderr, "kernel_launch: hipFuncSetAttribute failed\n"); grid = -1; return; }
        if (hipOccupancyMaxActiveBlocksPerMultiprocessor(&per_cu, (const void*)yoco_fwd, NTHR, LDS_BYTES) != hipSuccess || per_cu < 1) { fprintf(stderr, "kernel_launch: occupancy query says %d blocks per CU\n", per_cu); (void)hipGetLastError(); grid = -1; return; }
        grid = cus;
    }
    if (grid < 0) return;
    (void)hipMemsetAsync((char*)d_ws + WS_CTL, 0, CTL_BYTES, stream);
    Args a{};
    for (int i = 0; i < 24; ++i) a.in[i] = (const float*)d_in[i];
    a.out = (float*)d_out; a.ws = (unsigned char*)d_ws;
    void* params[] = {&a};
    hipError_t e = hipLaunchCooperativeKernel((const void*)yoco_fwd, dim3(grid), dim3(NTHR), params, LDS_BYTES, stream);
    if (e != hipSuccess) fprintf(stderr, "kernel_launch: cooperative launch failed: %s (grid %d)\n", hipGetErrorString(e), grid);
}
```

```cpp
#include <hip/hip_runtime.h>
#include <cstdio>
#include <cstdint>

#define LAS __attribute__((address_space(3)))
#define GAS __attribute__((address_space(1)))
typedef unsigned short bf16_t;
typedef short bf16x8 __attribute__((ext_vector_type(8)));
typedef short s16x4 __attribute__((ext_vector_type(4)));
typedef float f32x4 __attribute__((ext_vector_type(4)));
typedef float f32x2 __attribute__((ext_vector_type(2)));
typedef unsigned u32x4 __attribute__((ext_vector_type(4)));
typedef unsigned u32x2 __attribute__((ext_vector_type(2)));
typedef __bf16 bf16x2_t __attribute__((ext_vector_type(2)));

constexpr int D = 1024, SEQ = 8192, BP = 2, MP = BP * SEQ, BS = 128, MT = 16640  ;
constexpr int FF = 4096, NA = 3328, HW = 768, XW = 256, NMEM = 256;
constexpr int KVP = 128 + SEQ + 32;
constexpr float QSCALE = 0.18033688011112042f;
constexpr float LOG2E = 1.4426950408889634f;
constexpr float EPS = 1e-6f;
constexpr int NWAVES = 8, NTHR = 512;

constexpr size_t O_YP = 0, O_YS = O_YP + (size_t)MP * D, O_MK = O_YS + (size_t)BS * D, O_MV = O_MK + 524288, O_HP = O_MV + 524288,
                 O_SKP = O_HP + 393216, O_SVP = O_SKP + 65536, O_HS = O_SVP + 65536, O_SKS = O_HS + 25165824, O_SVS = O_SKS + 4194304, O_END = O_SVS + 4194304;

constexpr size_t al256(size_t x) { return (x + 255) & ~(size_t)255; }
constexpr size_t WS_CTL = 0, CTL_BYTES = 1u << 20;
constexpr size_t WS_WMEM = WS_CTL + CTL_BYTES;
constexpr size_t WS_WINA = WS_WMEM + (size_t)2048 * 1024 * 2;
constexpr size_t SZ_WINA = (size_t)NA * 1024 * 2;
constexpr size_t WS_WINB0 = WS_WINA + 2 * SZ_WINA;
constexpr size_t WS_WINB1 = WS_WINB0 + (size_t)1536 * 1024 * 2;
constexpr size_t WS_WOUT = WS_WINB1 + (size_t)1024 * 1024 * 2;
constexpr size_t WS_WUP = WS_WOUT + (size_t)4 * 1024 * 1024 * 2;
constexpr size_t WS_WDN = WS_WUP + (size_t)4 * 4096 * 1024 * 2;
constexpr size_t WS_H = WS_WDN + (size_t)4 * 4096 * 1024 * 2;
constexpr size_t WS_XN = WS_H + (size_t)MT * D * 4;
constexpr size_t WS_MN = WS_XN + (size_t)MT * D * 2;
constexpr size_t WS_ROPE = WS_MN + (size_t)512 * D * 2;
constexpr size_t WS_MKB = al256(WS_ROPE + (size_t)8193 * 32 * 8);
constexpr size_t WS_MVT = WS_MKB + (size_t)4 * 2 * 4 * 256 * 64 * 2;
constexpr size_t WS_KR = WS_MVT + (size_t)4 * 2 * 4 * 256 * 64 * 2;
constexpr size_t WS_VT = WS_KR + (size_t)2 * 4 * KVP * 64 * 2;
constexpr size_t WS_KSN = WS_VT + (size_t)2 * 4 * KVP * 64 * 2;
constexpr size_t WS_VSN = WS_KSN + (size_t)128 * 256 * 4;
constexpr size_t WS_ASEG = WS_VSN + (size_t)128 * 256 * 4;
constexpr size_t WS_RS2 = WS_ASEG + (size_t)12 * 16 * 128 * 4;
constexpr size_t WS_LBS = WS_RS2 + (size_t)MP * 16 * 4;
constexpr size_t WS_XCH = al256(WS_LBS + (size_t)2 * 768 * 4);
constexpr size_t WS_SMP = WS_XCH + (size_t)16 * 65536 * 8;
#define SBUF(T, off) ((T*)(ws + WS_SMP + (off)))
constexpr size_t SB_H0 = 0, SB_H1 = SB_H0 + (size_t)BS * D * 4, SB_Y1 = SB_H1 + (size_t)BS * D * 4, SB_Y2 = SB_Y1 + (size_t)BS * D * 4;
constexpr size_t SB_QS = SB_Y2 + (size_t)4 * BS * D * 4, SB_KK = SB_QS + (size_t)BS * HW * 2, SB_VV = SB_KK + (size_t)BS * HW * 2, SB_GG = SB_VV + (size_t)BS * HW * 2;
constexpr size_t SB_LF = SB_GG + (size_t)BS * HW * 2, SB_CQ = SB_LF + (size_t)BS * HW * 4, SB_MIX = SB_CQ + (size_t)BS * XW * 2, SB_HB = SB_MIX + (size_t)BS * D * 2, SB_END = SB_HB + (size_t)BS * FF * 2;

constexpr size_t WS_OV = al256(WS_SMP + SB_END);
constexpr size_t WS_MIX = WS_OV;
constexpr size_t WS_Y = WS_MIX + (size_t)MT * D * 2;
constexpr size_t WS_HB = WS_Y + (size_t)MT * D * 4;
constexpr size_t WS_QS = WS_MIX + (size_t)MT * D * 2;
constexpr size_t SZ_P768 = (size_t)MT * HW * 2;
constexpr size_t WS_KK = WS_QS + SZ_P768, WS_VV = WS_KK + SZ_P768, WS_GG = WS_VV + SZ_P768;
constexpr size_t WS_LF = WS_GG + SZ_P768;
constexpr size_t WS_CQ = WS_LF + (size_t)MT * HW * 4;
constexpr size_t WS_USEG = WS_CQ + (size_t)MT * XW * 2;
constexpr size_t WS_SST = WS_USEG + (size_t)12 * 16 * 16384 * 4;
constexpr size_t WS_END_A = WS_SST + (size_t)12 * 16 * 16384 * 4;
constexpr size_t WS_END_B = WS_HB + (size_t)MT * FF * 2;
constexpr size_t WS_END = WS_END_A > WS_END_B ? WS_END_A : WS_END_B;

constexpr int RING_BYTES = 131072, LDSCTL_OFF = RING_BYTES, MISC_OFF = LDSCTL_OFF + 320, LDS_BYTES = 147456;

__device__ __forceinline__ unsigned cvtpk(float lo, float hi) { f32x2 v = {lo, hi}; bf16x2_t b = __builtin_convertvector(v, bf16x2_t); return __builtin_bit_cast(unsigned, b); }
__device__ __forceinline__ bf16_t f2bf(float f) { return (bf16_t)(cvtpk(f, 0.f) & 0xffffu); }
__device__ __forceinline__ float bf2f(bf16_t x) { return __uint_as_float((unsigned)x << 16); }
__device__ __forceinline__ float bflo(unsigned w) { return __uint_as_float(w << 16); }
__device__ __forceinline__ float bfhi(unsigned w) { return __uint_as_float(w & 0xffff0000u); }
__device__ __forceinline__ f32x4 zero4() { float z = 0.f; asm volatile("" : "+v"(z)); return (f32x4){z, z, z, z}; }
__device__ __forceinline__ float wave_sum(float v) {
#pragma unroll
    for (int o = 1; o < 64; o <<= 1) v += __shfl_xor(v, o);
    return v;
}
__device__ __forceinline__ float fexp(float x) { return __builtin_amdgcn_exp2f(x * 1.4426950408889634f); }
__device__ __forceinline__ float flog(float x) { return __builtin_amdgcn_logf(x) * 0.6931471805599453f; }
__device__ __forceinline__ float fsigmoid(float x) { return __builtin_amdgcn_rcpf(1.0f + fexp(-x)); }
__device__ __forceinline__ float fsilu(float x) { return x * __builtin_amdgcn_rcpf(1.0f + fexp(-x)); }
#define LDS_WAIT() asm volatile("s_waitcnt lgkmcnt(0)" ::: "memory")
#define VM_WAIT() asm volatile("s_waitcnt vmcnt(0)" ::: "memory")

struct Args { const float* in[24]; float* out; unsigned char* ws; };
typedef const float* cfptr_t;
__device__ __forceinline__ const float* in_ptr(int i) { return ((const __attribute__((address_space(4))) cfptr_t*)__builtin_amdgcn_kernarg_segment_ptr())[i]; }

namespace pg8 {
constexpr int BM = 256, BK = 64, HALF = 128, HTB = HALF * BK * 2, STAGE_BYTES = 8 * HTB, NXCD = 8, WGM = 8;
__host__ __device__ __forceinline__ int lds_byte(int r, int c) { const int st = (r >> 4) * 2 + (c >> 5), rr = r & 15, cc = c & 31, ob = rr * 64 + cc * 2; return st * 1024 + (ob ^ (((ob >> 9) & 1) << 5)); }
__host__ __device__ __forceinline__ void stage_rc(int b, int& R, int& C) { const int st = b / 1024, sb = b % 1024, swz = sb ^ (((sb >> 9) & 1) << 5); R = (st >> 1) * 16 + swz / 64; C = (st & 1) * 32 + (swz % 64) / 2; }
__host__ __device__ __forceinline__ int perm32(int rho) { const int n = rho >> 4, i = rho & 15; return 8 * (i >> 2) + 4 * n + (i & 3); }
struct Unit { int pm, pn; };
struct Gemm { const bf16_t* A; const bf16_t* Bt; int M, N, K; };
struct StaticOrder {
    int nM, nN, nwg, G, c;
    __device__ void init(int M, int N, int G_, int c_) { nM = M / BM; nN = N / BM; nwg = nM * nN; G = G_; c = c_; }
    __device__ bool next(int i, Unit& u) const {
        const long L = (long)i * G + c; if (L >= nwg) return false;
        int wgid = (int)L; { const int q = nwg / NXCD, r = nwg % NXCD, xcd = wgid % NXCD, off = wgid / NXCD; wgid = (xcd < r ? xcd * (q + 1) : r * (q + 1) + (xcd - r) * q) + off; }
        const int nig = WGM * nN, gid = wgid / nig, fm = gid * WGM, gsz = (nM - fm) < WGM ? (nM - fm) : WGM;
        u.pm = fm + ((wgid % nig) % gsz); u.pn = (wgid % nig) / gsz; return true;
    }
};

template <bool AFTER_DRAIN, class Epi>
__device__ __forceinline__ void gemm_phase(LAS unsigned char* lds, const Gemm g, const StaticOrder& S, const Epi& E, const int tid) {
    const int wid = __builtin_amdgcn_readfirstlane(tid >> 6), lane = tid & 63, wr = wid >> 2, wc = wid & 3, fr = lane & 15, fq = lane >> 4;
    const int K = g.K, nt = K / BK;
    unsigned voffA[2], voffB[2];
#pragma unroll
    for (int i = 0; i < 2; ++i) { int R, C; stage_rc(tid * 16 + i * 8192, R, C); const int Rb = (R & ~31) + perm32(R & 31);
        voffA[i] = (unsigned)(R * K + C) * 2u; voffB[i] = (unsigned)(Rb * K + C) * 2u; }
    const size_t kstep = (size_t)(BK * 2);
    const size_t hstep = (size_t)HALF * K * 2;
    const size_t tstep = 2 * hstep;
    const unsigned ldsw = (unsigned)wid * 1024u;
    const int aoff = lds_byte(wr * 64 + fr, fq * 8), boff = lds_byte(wc * 32 + fr, fq * 8);
#define PG8_SA(b, h) (((b) * 2 + (h)) * HTB)
#define PG8_SB(b, h) ((4 + (b) * 2 + (h)) * HTB)
#define PG8_STAGE(bufoff, gbase, voff) do { _Pragma("unroll") for (int _i = 0; _i < 2; ++_i) \
        __builtin_amdgcn_global_load_lds((const unsigned*)((const char*)(gbase) + (voff)[_i]), (LAS unsigned*)(lds + (bufoff) + ldsw + _i * 8192), 16, 0, 0); } while (0)
#define PG8_LDA(dst, b, h) do { _Pragma("unroll") for (int m = 0; m < 4; ++m) _Pragma("unroll") for (int k = 0; k < 2; ++k) dst[m][k] = *(const LAS bf16x8*)(lds + PG8_SA(b, h) + aoff + m * 2048 + k * 1024); } while (0)
#define PG8_LDB(dst, b, h) do { _Pragma("unroll") for (int n = 0; n < 2; ++n) _Pragma("unroll") for (int k = 0; k < 2; ++k) dst[n][k] = *(const LAS bf16x8*)(lds + PG8_SB(b, h) + boff + n * 2048 + k * 1024); } while (0)
#define PG8_MMA(ai, bj, At, Bt) do { __builtin_amdgcn_s_setprio(1); _Pragma("unroll") for (int m = 0; m < 4; ++m) _Pragma("unroll") for (int n = 0; n < 2; ++n) _Pragma("unroll") for (int k = 0; k < 2; ++k) \
        acc[ai][bj][m][n] = __builtin_amdgcn_mfma_f32_16x16x32_bf16(Bt[n][k], At[m][k], acc[ai][bj][m][n], 0, 0, 0); __builtin_amdgcn_s_setprio(0); } while (0)
#define PG8_WAIT_V(n) asm volatile("s_waitcnt vmcnt(" #n ")" ::: "memory")
#define PG8_WAIT_L(n) asm volatile("s_waitcnt lgkmcnt(" #n ")" ::: "memory")
#define PG8_BAR __builtin_amdgcn_s_barrier()
#define PG8_SCHED __builtin_amdgcn_sched_barrier(0)
    Unit cur, nxt; int ui = 0;
    if (!S.next(0, cur)) return;
    f32x4 acc[2][2][4][2];
#pragma unroll
    for (int a = 0; a < 2; ++a)
#pragma unroll
        for (int b = 0; b < 2; ++b)
#pragma unroll
            for (int m = 0; m < 4; ++m)
#pragma unroll
                for (int n = 0; n < 2; ++n) acc[a][b][m][n] = zero4();
    bf16x8 At[4][2], B0[2][2], B1[2][2];
    const char* cA = (const char*)g.A + (size_t)cur.pm * tstep; const char* cB = (const char*)g.Bt + (size_t)cur.pn * tstep;
    PG8_STAGE(PG8_SB(0, 0), cB, voffB); PG8_STAGE(PG8_SB(0, 1), cB + hstep, voffB); PG8_STAGE(PG8_SA(0, 0), cA, voffA); PG8_STAGE(PG8_SA(0, 1), cA + hstep, voffA);
    if (wr == 1) PG8_BAR;
    PG8_WAIT_V(2); PG8_BAR;
    PG8_STAGE(PG8_SB(1, 0), cB + kstep, voffB); PG8_STAGE(PG8_SA(1, 0), cA + kstep, voffA); PG8_STAGE(PG8_SB(1, 1), cB + hstep + kstep, voffB);
    PG8_WAIT_V(6); PG8_BAR;
    for (;;) {
        const bool has_next = S.next(ui + 1, nxt);
        const char* nA = has_next ? (const char*)g.A + (size_t)nxt.pm * tstep : cA; const char* nB = has_next ? (const char*)g.Bt + (size_t)nxt.pn * tstep : cB;
        for (int t = 0; t < nt; t += 2) {
            const bool last = (t == nt - 2);
            const char* a1 = cA + (size_t)(t + 1) * kstep;
            const char* a2 = last ? nA : cA + (size_t)(t + 2) * kstep; const char* b2 = last ? nB : cB + (size_t)(t + 2) * kstep;
            const char* a3 = a2 + kstep; const char* b3 = b2 + kstep;
            PG8_LDB(B0, 0, 0); PG8_LDB(B1, 0, 1); PG8_SCHED; PG8_LDA(At, 0, 0); PG8_STAGE(PG8_SA(1, 1), a1 + hstep, voffA);
            PG8_WAIT_V(8); PG8_WAIT_L(0); PG8_BAR; PG8_MMA(0, 0, At, B0); PG8_MMA(0, 1, At, B1); PG8_BAR; PG8_SCHED;
            PG8_LDA(At, 0, 1); PG8_STAGE(PG8_SB(0, 0), b2, voffB); PG8_STAGE(PG8_SB(0, 1), b2 + hstep, voffB); PG8_STAGE(PG8_SA(0, 0), a2, voffA);
            PG8_WAIT_V(8); PG8_WAIT_L(0); PG8_BAR; PG8_MMA(1, 0, At, B0); PG8_MMA(1, 1, At, B1); PG8_BAR; PG8_SCHED;
            PG8_LDB(B0, 1, 0); PG8_LDB(B1, 1, 1); PG8_SCHED; PG8_LDA(At, 1, 0); PG8_STAGE(PG8_SA(0, 1), a2 + hstep, voffA);
            PG8_WAIT_V(8); PG8_WAIT_L(0); PG8_BAR; PG8_MMA(0, 0, At, B0); PG8_MMA(0, 1, At, B1); PG8_BAR; PG8_SCHED;
            PG8_LDA(At, 1, 1); PG8_STAGE(PG8_SB(1, 0), b3, voffB); PG8_STAGE(PG8_SB(1, 1), b3 + hstep, voffB); PG8_STAGE(PG8_SA(1, 0), a3, voffA);
            PG8_WAIT_V(8); PG8_WAIT_L(0); PG8_BAR; PG8_MMA(1, 0, At, B0); PG8_MMA(1, 1, At, B1); PG8_BAR; PG8_SCHED;
        }
        if (wr == 0) PG8_BAR;
        if constexpr (!AFTER_DRAIN) E(acc, cur, wr, wc, fr, fq);
        if (!has_next) break;
#pragma unroll
        for (int a = 0; a < 2; ++a)
#pragma unroll
            for (int b = 0; b < 2; ++b)
#pragma unroll
                for (int m = 0; m < 4; ++m)
#pragma unroll
                    for (int n = 0; n < 2; ++n) acc[a][b][m][n] = zero4();
        cur = nxt; cA = nA; cB = nB; ++ui;
        if (wr == 1) PG8_BAR;
    }
    PG8_WAIT_V(0);
    PG8_BAR;
    if constexpr (AFTER_DRAIN) E.fused(acc, cur, wr, wc, fr, fq, lds, wid, lane);
#undef PG8_SA
#undef PG8_SB
#undef PG8_STAGE
#undef PG8_LDA
#undef PG8_LDB
#undef PG8_MMA
#undef PG8_WAIT_V
#undef PG8_WAIT_L
#undef PG8_BAR
#undef PG8_SCHED
}
}

#define XB_TMO      128
#define XB_XCNT(j)  (256  + 64 * (j))
#define XB_XSUB(j)  (1280 + 64 * (j))
#define XB_XGEN(j)  (2304 + 64 * (j))
#define XB_TOP      3328
#define XB_TOPGEN   3392
#define XCD_BAR_WORDS 3456
#define XB_SPIN_CAP (1u << 18)
__device__ __forceinline__ unsigned xb_ld(unsigned* p)              { return __hip_atomic_load(p, __ATOMIC_RELAXED, __HIP_MEMORY_SCOPE_AGENT); }
__device__ __forceinline__ unsigned xb_add(unsigned* p, unsigned v) { return __hip_atomic_fetch_add(p, v, __ATOMIC_RELAXED, __HIP_MEMORY_SCOPE_AGENT); }
__device__ __forceinline__ unsigned xb_xcc_id() { return (unsigned)__builtin_amdgcn_s_getreg((3 << 11) | 20) & 0xFu; }
#define XB_SPIN(cond, bar) do { unsigned _sp = 0; while (cond) { __builtin_amdgcn_s_sleep(1); \
    if ((++_sp & 255u) == 0u) { if (xb_ld(&(bar)[XB_TMO])) break; if (_sp > XB_SPIN_CAP) { atomicAdd(&(bar)[XB_TMO], 1u); break; } } } } while (0)
struct XcdBarrier { unsigned* bar; unsigned x; volatile LAS unsigned* st; };
__device__ __forceinline__ XcdBarrier xcd_barrier_post(unsigned* bar, volatile LAS unsigned* st) {
    XcdBarrier b; b.bar = bar; b.x = xb_xcc_id(); b.st = st;
    if (threadIdx.x == 0) (void)xb_add(&bar[XB_XCNT(b.x)], 1u);
    return b;
}
__device__ __forceinline__ void xcd_barrier_complete(unsigned* bar, unsigned x, unsigned& nloc, unsigned& nx) {
    const unsigned G = gridDim.x * gridDim.y * gridDim.z;
    unsigned sum, cnt, mine, sp = 0u;
    for (;;) {
        sum = 0u; cnt = 0u; mine = 0u;
#pragma unroll
        for (unsigned j = 0; j < 16; ++j) { const unsigned c = xb_ld(&bar[XB_XCNT(j)]); sum += c; cnt += (c > 0u) ? 1u : 0u; mine = (j == x) ? c : mine; }
        if (sum == G) break;
        __builtin_amdgcn_s_sleep(1);
        if ((++sp & 255u) == 0u) { if (xb_ld(&bar[XB_TMO])) break; if (sp > XB_SPIN_CAP) { atomicAdd(&bar[XB_TMO], 1u); break; } }
    }
    nloc = mine > 0u ? mine : 1u; nx = cnt > 0u ? cnt : 1u;
}
__device__ __forceinline__ void xcd_barrier(const XcdBarrier& b) {
    asm volatile("s_waitcnt vmcnt(0)" ::: "memory");
    __syncthreads();
    if (threadIdx.x == 0) {
        unsigned* bar = b.bar;
        __builtin_amdgcn_s_waitcnt(0);
        unsigned nloc = b.st[0], nx = b.st[1];
        if (nloc == 0u) { xcd_barrier_complete(bar, b.x, nloc, nx); b.st[0] = nloc; b.st[1] = nx; }
        const unsigned old = xb_add(&bar[XB_XSUB(b.x)], 1u);
        const unsigned gen = old / nloc;
        if (old + 1u == (gen + 1u) * nloc) {
            __builtin_amdgcn_fence(__ATOMIC_RELEASE, "agent");
            asm volatile("s_waitcnt vmcnt(0)" ::: "memory");
            const unsigned og = xb_add(&bar[XB_TOP], 1u);
            const unsigned tg = og / nx;
            if (og + 1u == (tg + 1u) * nx) xb_add(&bar[XB_TOPGEN], 1u);
            else XB_SPIN(xb_ld(&bar[XB_TOPGEN]) == tg, bar);
            __builtin_amdgcn_fence(__ATOMIC_ACQUIRE, "agent");
            xb_add(&bar[XB_XGEN(b.x)], 1u);
            asm volatile("s_waitcnt vmcnt(0)" ::: "memory");
        } else {
            XB_SPIN(xb_ld(&bar[XB_XGEN(b.x)]) == gen, bar);
            __builtin_amdgcn_fence(__ATOMIC_ACQUIRE, "agent");
            asm volatile("s_waitcnt vmcnt(0)" ::: "memory");
        }
    }
    __syncthreads();
}

struct Frame {
    LAS unsigned char* lds;
    int tid, lane, wave, vcu, G;
    unsigned char* ws; float* out;
};
#define WSP(T, off) ((T*)(ws + (off)))

struct Seg { int in, off, ld, col0; unsigned long long dst; int row0, nrows, K, gin, goff, flags; };
constexpr int SEG_PERM = 1, SEG_QS = 2;
constexpr int NSEG = 26;
__constant__ Seg c_segs[NSEG] = {
    {9, 0 * 1024 * 512, 512, 0, WS_WMEM, 0, 512, 1024, 8, 0, 0},
    {9, 1 * 1024 * 512, 512, 0, WS_WMEM, 512, 512, 1024, 8, 1024, 0},
    {9, 2 * 1024 * 512, 512, 0, WS_WMEM, 1024, 512, 1024, 8, 2048, 0},
    {9, 3 * 1024 * 512, 512, 0, WS_WMEM, 1536, 512, 1024, 8, 3072, 0},
    {10, 0, NA, 0, WS_WINA, 0, 3072, 1024, 18, 0, 0},
    {10, 0, NA, 3072, WS_WINA, 3072, 256, 1024, 18, 0, SEG_QS},
    {10, 1024 * NA, NA, 0, WS_WINA + SZ_WINA, 0, 3072, 1024, 18, 1024, 0},
    {10, 1024 * NA, NA, 3072, WS_WINA + SZ_WINA, 3072, 256, 1024, 18, 1024, SEG_QS},
    {13, 0, 1024, 0, WS_WINB0, 0, 768, 1024, 18, 2048, SEG_PERM | SEG_QS},
    {13, 0, 1024, 768, WS_WINB0, 768, 256, 1024, 18, 2048, SEG_QS},
    {16, 0, 512, 0, WS_WINB0, 1024, 256, 1024, 15, 0, SEG_PERM},
    {16, 0, 512, 256, WS_WINB0, 1280, 256, 1024, 15, 0, 0},
    {13, 1024 * 1024, 1024, 0, WS_WINB1, 0, 768, 1024, 18, 3072, SEG_PERM | SEG_QS},
    {13, 1024 * 1024, 1024, 768, WS_WINB1, 768, 256, 1024, 18, 3072, SEG_QS},
    {17, 0 * 1024 * 1024, 1024, 0, WS_WOUT + 0 * 2097152ull, 0, 1024, 1024, -1, 0, 0},
    {17, 1 * 1024 * 1024, 1024, 0, WS_WOUT + 1 * 2097152ull, 0, 1024, 1024, -1, 0, 0},
    {17, 2 * 1024 * 1024, 1024, 0, WS_WOUT + 2 * 2097152ull, 0, 1024, 1024, -1, 0, 0},
    {17, 3 * 1024 * 1024, 1024, 0, WS_WOUT + 3 * 2097152ull, 0, 1024, 1024, -1, 0, 0},
    {22, 0 * 4096 * 1024, 4096, 0, WS_WUP + 0 * 8388608ull, 0, 4096, 1024, 20, 0, 0},
    {22, 1 * 4096 * 1024, 4096, 0, WS_WUP + 1 * 8388608ull, 0, 4096, 1024, 20, 1024, 0},
    {22, 2 * 4096 * 1024, 4096, 0, WS_WUP + 2 * 8388608ull, 0, 4096, 1024, 20, 2048, 0},
    {22, 3 * 4096 * 1024, 4096, 0, WS_WUP + 3 * 8388608ull, 0, 4096, 1024, 20, 3072, 0},
    {23, 0 * 4096 * 1024, 1024, 0, WS_WDN + 0 * 8388608ull, 0, 1024, 4096, -1, 0, 0},
    {23, 1 * 4096 * 1024, 1024, 0, WS_WDN + 1 * 8388608ull, 0, 1024, 4096, -1, 0, 0},
    {23, 2 * 4096 * 1024, 1024, 0, WS_WDN + 2 * 8388608ull, 0, 1024, 4096, -1, 0, 0},
    {23, 3 * 4096 * 1024, 1024, 0, WS_WDN + 3 * 8388608ull, 0, 1024, 4096, -1, 0, 0},
};
__constant__ double c_invfreq[32] = {1.0, 0.7498942093324559, 0.5623413251903491, 0.4216965034285822, 0.31622776601683794, 0.23713737056616552, 0.1778279410038923, 0.1333521432163324, 0.1, 0.07498942093324558, 0.05623413251903491, 0.042169650342858224, 0.03162277660168379, 0.023713737056616554, 0.01778279410038923, 0.01333521432163324, 0.01, 0.007498942093324558, 0.005623413251903491, 0.004216965034285823, 0.0031622776601683794, 0.0023713737056616554, 0.0017782794100389228, 0.001333521432163324, 0.001, 0.0007498942093324559, 0.0005623413251903491, 0.00042169650342858224, 0.00031622776601683794, 0.00023713737056616554, 0.00017782794100389227, 0.0001333521432163324};

__device__ __forceinline__ void seg_item(unsigned char* ws, const Seg& s, int item, int lane) {
    const float* W = in_ptr(s.in) + s.off;
    const float* gain = s.gin >= 0 ? in_ptr(s.gin) + s.goff : nullptr;
    const float scale = (s.flags & SEG_QS) ? QSCALE : 1.0f;
    const int nblk = s.nrows / 64, kb = item / nblk, nb = item - kb * nblk, k0 = 64 * kb, n0 = 64 * nb, K = s.K;
    const int src = s.col0 + n0 + ((s.flags & SEG_PERM) ? (lane >> 1) + 32 * (lane & 1) : lane);
    const float* wp = W + (size_t)k0 * s.ld + src;
    float w[64];
#pragma unroll
    for (int kk = 0; kk < 64; ++kk) w[kk] = wp[(size_t)kk * s.ld];
    if (gain) {
#pragma unroll
        for (int kk = 0; kk < 64; ++kk) w[kk] *= gain[k0 + kk] * scale;
    } else {
#pragma unroll
        for (int kk = 0; kk < 64; ++kk) w[kk] *= scale;
    }
    bf16_t* op = (bf16_t*)(ws + s.dst) + (size_t)(s.row0 + n0 + lane) * K + k0;
#pragma unroll
    for (int c = 0; c < 8; ++c) { u32x4 o; o.x = cvtpk(w[8 * c], w[8 * c + 1]); o.y = cvtpk(w[8 * c + 2], w[8 * c + 3]); o.z = cvtpk(w[8 * c + 4], w[8 * c + 5]); o.w = cvtpk(w[8 * c + 6], w[8 * c + 7]);
        *(u32x4*)(op + 8 * c) = o; }
}

__device__ __forceinline__ void rms_row_to_bf16(const float* xrow, bf16_t* orow, float* hcopy, int lane) {
    const f32x4* xr = (const f32x4*)xrow + lane;
    f32x4 v[4]; float s = 0.f;
#pragma unroll
    for (int j = 0; j < 4; ++j) { v[j] = xr[64 * j]; s += (v[j].x * v[j].x + v[j].y * v[j].y) + (v[j].z * v[j].z + v[j].w * v[j].w); }
    const float rstd = rsqrtf(wave_sum(s) * (1.f / D) + EPS);
    u32x2* o8 = (u32x2*)orow + lane;
#pragma unroll
    for (int j = 0; j < 4; ++j) { u32x2 w; w.x = cvtpk(v[j].x * rstd, v[j].y * rstd); w.y = cvtpk(v[j].z * rstd, v[j].w * rstd); o8[64 * j] = w; }
    if (hcopy) { f32x4* hc = (f32x4*)hcopy + lane;
#pragma unroll
        for (int j = 0; j < 4; ++j) hc[64 * j] = v[j]; }
}

__device__ __forceinline__ void p0_prologue(Frame& F) {
    unsigned char* ws = F.ws;
    const int gw = F.vcu * NWAVES + F.wave, NGW = F.G * NWAVES;
    int total = 0;
    for (int s = 0; s < NSEG; ++s) total += (c_segs[s].K / 64) * (c_segs[s].nrows / 64);
#pragma unroll 1
    for (int it = gw; it < total; it += NGW) {
        int r = it, s = 0;
        for (; s < NSEG; ++s) { const int n = (c_segs[s].K / 64) * (c_segs[s].nrows / 64); if (r < n) break; r -= n; }
        seg_item(ws, c_segs[s], r, F.lane);
    }
    bf16_t* XN = WSP(bf16_t, WS_XN);
#pragma unroll 1
    for (int m = gw * 4; m < MP; m += NGW * 4) {
        const f32x4* xr = (const f32x4*)(in_ptr(0) + (size_t)m * D) + F.lane;
        f32x4 v[4][4]; float s[4];
#pragma unroll
        for (int r = 0; r < 4; ++r)
#pragma unroll
            for (int j = 0; j < 4; ++j) v[r][j] = xr[r * 256 + 64 * j];
#pragma unroll
        for (int r = 0; r < 4; ++r) { s[r] = 0.f;
#pragma unroll
            for (int j = 0; j < 4; ++j) s[r] += (v[r][j].x * v[r][j].x + v[r][j].y * v[r][j].y) + (v[r][j].z * v[r][j].z + v[r][j].w * v[r][j].w);
            s[r] = rsqrtf(wave_sum(s[r]) * (1.f / D) + EPS); }
        u32x2* o8 = (u32x2*)(XN + (size_t)m * D) + F.lane;
#pragma unroll
        for (int r = 0; r < 4; ++r)
#pragma unroll
            for (int j = 0; j < 4; ++j) { u32x2 w; w.x = cvtpk(v[r][j].x * s[r], v[r][j].y * s[r]); w.y = cvtpk(v[r][j].z * s[r], v[r][j].w * s[r]); o8[r * 256 + 64 * j] = w; }
    }
    bf16_t* MN = WSP(bf16_t, WS_MN);
    for (int m = gw; m < 512; m += NGW) rms_row_to_bf16(in_ptr(7) + (size_t)m * D, MN + (size_t)m * D, nullptr, F.lane);
    f32x2* rope = WSP(f32x2, WS_ROPE);
    const int gt = F.vcu * NTHR + F.tid, NGT = F.G * NTHR;
    for (int e = gt; e < 8193 * 32; e += NGT) { const int pos = e >> 5, i = e & 31; double rev = (double)pos * c_invfreq[i] * 0.15915494309189535; rev -= __builtin_rint(rev);
        const float rf = (float)rev; rope[e] = (f32x2){__builtin_amdgcn_cosf(rf), __builtin_amdgcn_sinf(rf)}; }
    { float* RS2 = WSP(float, WS_RS2); for (int e = gt; e < MP * 16; e += NGT) RS2[e] = (e & 15) == 0 ? 1024.0f * (1.0f - EPS) : 0.f; }
    { u32x4* xz = WSP(u32x4, WS_XCH); unsigned z = 0u; asm volatile("" : "+v"(z)); const u32x4 z4 = {z, z, z, z}; for (int e = gt; e < 16 * 65536 / 2; e += NGT) xz[e] = z4; }
    { float* LBS = WSP(float, WS_LBS); const float* lbl = in_ptr(11);
      for (int e = gt; e < HW; e += NGT) { LBS[e] = 0.f; LBS[HW + e] = fsigmoid(lbl[HW + e] - lbl[e]); } }
    bf16_t* KR = WSP(bf16_t, WS_KR); bf16_t* VT = WSP(bf16_t, WS_VT);
    for (int e = gt; e < 8 * 160 * 64; e += NGT) { const int bk = e / (160 * 64), r = (e / 64) % 160, d = e % 64; const int pos = r < 128 ? r : 128 + SEQ + (r - 128);
        KR[((size_t)bk * KVP + pos) * 64 + d] = 0; VT[((size_t)bk * 64 + d) * KVP + pos] = 0; }
}

enum { EK_MEMKV = 0, EK_INA = 1, EK_INB = 2, EK_F32 = 3, EK_UP = 4, EK_FUSED = 5 };
struct Epi {
    int kind, layer; unsigned char* ws; float* out;
    __device__ __forceinline__ void operator()(const f32x4 (&acc)[2][2][4][2], const pg8::Unit& u, int wr, int wc, int fr, int fq) const {
        asm volatile("" : "+v"(fr), "+v"(fq));
        const int row0 = u.pm * 256 + wr * 64 + fr, cl0 = wc * 32 + 8 * fq;
        const float* RS2 = WSP(float, WS_RS2);
#define ROW_SCALE(row_) ({ const f32x4* p4_ = (const f32x4*)(RS2 + (size_t)(row_) * 16); const f32x4 q4_ = (p4_[0] + p4_[1]) + (p4_[2] + p4_[3]); rsqrtf(((q4_[0] + q4_[1]) + (q4_[2] + q4_[3])) * (1.f / 1024.f) + EPS); })
        if (kind == EK_F32) {
            float* Y = WSP(float, WS_Y);
#pragma unroll
            for (int ai = 0; ai < 2; ++ai)
#pragma unroll
                for (int m = 0; m < 4; ++m) { float* rp = Y + (size_t)(row0 + ai * 128 + m * 16) * D + u.pn * 256 + cl0;
#pragma unroll
                    for (int bj = 0; bj < 2; ++bj) { *(f32x4*)(rp + bj * 128) = acc[ai][bj][m][0]; *(f32x4*)(rp + bj * 128 + 4) = acc[ai][bj][m][1]; } }
        } else if (kind == EK_UP) {
            bf16_t* HB = WSP(bf16_t, WS_HB);
#pragma unroll
            for (int ai = 0; ai < 2; ++ai)
#pragma unroll
                for (int m = 0; m < 4; ++m) { bf16_t* rp = HB + (size_t)(row0 + ai * 128 + m * 16) * FF + u.pn * 256 + cl0; const float rsc = ROW_SCALE(row0 + ai * 128 + m * 16);
#pragma unroll
                    for (int bj = 0; bj < 2; ++bj) { f32x4 v0 = acc[ai][bj][m][0] * rsc, v1 = acc[ai][bj][m][1] * rsc;
#pragma unroll
                        for (int e = 0; e < 4; ++e) { const float r0 = fmaxf(v0[e], 0.f), r1 = fmaxf(v1[e], 0.f); v0[e] = r0 * r0; v1[e] = r1 * r1; }
                        u32x4 w; w.x = cvtpk(v0[0], v0[1]); w.y = cvtpk(v0[2], v0[3]); w.z = cvtpk(v1[0], v1[1]); w.w = cvtpk(v1[2], v1[3]);
                        *(u32x4*)(rp + bj * 128) = w; } }
        } else if (kind == EK_MEMKV) {
            const int l = u.pn >> 1, kv = u.pn & 1;
            float* of = out + (kv ? O_MV : O_MK);
            bf16_t* MKB = WSP(bf16_t, WS_MKB); bf16_t* MVT = WSP(bf16_t, WS_MVT);
#pragma unroll
            for (int ai = 0; ai < 2; ++ai)
#pragma unroll
                for (int m = 0; m < 4; ++m) { const int row = row0 + ai * 128 + m * 16, b = row >> 8, mm = row & 255;
#pragma unroll
                    for (int bj = 0; bj < 2; ++bj) { const int cc = bj * 128 + cl0, h = cc >> 6, d = cc & 63; const f32x4 v0 = acc[ai][bj][m][0], v1 = acc[ai][bj][m][1];
                        float* op = of + ((size_t)(l * 2 + b) * 256 + mm) * 256 + cc; *(f32x4*)op = v0; *(f32x4*)(op + 4) = v1;
                        if (kv == 0) { u32x4 w; w.x = cvtpk(v0[0], v0[1]); w.y = cvtpk(v0[2], v0[3]); w.z = cvtpk(v1[0], v1[1]); w.w = cvtpk(v1[2], v1[3]);
                            *(u32x4*)(MKB + ((size_t)((l * 2 + b) * 4 + h) * 256 + mm) * 64 + d) = w; }
                        else { bf16_t* vp = MVT + ((size_t)((l * 2 + b) * 4 + h) * 64 + d) * 256 + mm;
#pragma unroll
                            for (int e = 0; e < 4; ++e) { vp[(size_t)e * 256] = f2bf(v0[e]); vp[(size_t)(e + 4) * 256] = f2bf(v1[e]); } } } }
        } else if (kind == EK_INA) {
            const int sec = u.pn / 3, ct = u.pn % 3;
            bf16_t* QS = WSP(bf16_t, WS_QS); bf16_t* KK = WSP(bf16_t, WS_KK); bf16_t* VV = WSP(bf16_t, WS_VV); bf16_t* GG = WSP(bf16_t, WS_GG); float* LF = WSP(float, WS_LF); bf16_t* CQ = WSP(bf16_t, WS_CQ);
            if (sec == 4) {
#pragma unroll
                for (int ai = 0; ai < 2; ++ai)
#pragma unroll
                    for (int m = 0; m < 4; ++m) { bf16_t* rp = CQ + (size_t)(row0 + ai * 128 + m * 16) * XW + cl0; const float rsc = ROW_SCALE(row0 + ai * 128 + m * 16);
#pragma unroll
                        for (int bj = 0; bj < 2; ++bj) { const f32x4 v0 = acc[ai][bj][m][0] * rsc, v1 = acc[ai][bj][m][1] * rsc; u32x4 w; w.x = cvtpk(v0[0], v0[1]); w.y = cvtpk(v0[2], v0[3]); w.z = cvtpk(v1[0], v1[1]); w.w = cvtpk(v1[2], v1[3]);
                            *(u32x4*)(rp + bj * 128) = w; } }
            } else if (sec == 1) {
                const float* LBS = WSP(float, WS_LBS) + layer * HW + ct * 256 + cl0;
                f32x4 lb4[2][2];
#pragma unroll
                for (int bj = 0; bj < 2; ++bj) { lb4[bj][0] = *(const f32x4*)(LBS + bj * 128); lb4[bj][1] = *(const f32x4*)(LBS + bj * 128 + 4); }
#pragma unroll
                for (int ai = 0; ai < 2; ++ai)
#pragma unroll
                    for (int m = 0; m < 4; ++m) { const size_t ro = (size_t)(row0 + ai * 128 + m * 16) * HW + ct * 256 + cl0; const float rsc = ROW_SCALE(row0 + ai * 128 + m * 16);
#pragma unroll
                        for (int bj = 0; bj < 2; ++bj) { float lf[8], kk[8];
#pragma unroll
                            for (int e = 0; e < 8; ++e) { const float z = (e < 4 ? acc[ai][bj][m][0][e] : acc[ai][bj][m][1][e - 4]) * rsc;
                                const float t = fexp(-fabsf(z)), r = __builtin_amdgcn_rcpf(1.0f + t), big = r, small = t * r; const float sp = z >= 0.f ? big : small, sn = z >= 0.f ? small : big;
                                const float l1 = e < 4 ? lb4[bj][0][e] : lb4[bj][1][e - 4], f = l1 + (1.0f - l1) * sp, k = (1.0f - l1) * sn;
                                lf[e] = flog(f); kk[e] = k; }
                            *(f32x4*)(LF + ro + bj * 128) = (f32x4){lf[0], lf[1], lf[2], lf[3]}; *(f32x4*)(LF + ro + bj * 128 + 4) = (f32x4){lf[4], lf[5], lf[6], lf[7]};
                            u32x4 w; w.x = cvtpk(kk[0], kk[1]); w.y = cvtpk(kk[2], kk[3]); w.z = cvtpk(kk[4], kk[5]); w.w = cvtpk(kk[6], kk[7]);
                            *(u32x4*)(KK + ro + bj * 128) = w; } }
            } else {
                bf16_t* dst = sec == 0 ? QS : (sec == 2 ? VV : GG); const bool act = sec != 2;
#pragma unroll
                for (int ai = 0; ai < 2; ++ai)
#pragma unroll
                    for (int m = 0; m < 4; ++m) { bf16_t* rp = dst + (size_t)(row0 + ai * 128 + m * 16) * HW + ct * 256 + cl0; const float rsc = ROW_SCALE(row0 + ai * 128 + m * 16);
#pragma unroll
                        for (int bj = 0; bj < 2; ++bj) { f32x4 v0 = acc[ai][bj][m][0] * rsc, v1 = acc[ai][bj][m][1] * rsc;
                            if (act) {
#pragma unroll
                                for (int e = 0; e < 4; ++e) { v0[e] = fsilu(v0[e]); v1[e] = fsilu(v1[e]); } }
                            u32x4 w; w.x = cvtpk(v0[0], v0[1]); w.y = cvtpk(v0[2], v0[3]); w.z = cvtpk(v1[0], v1[1]); w.w = cvtpk(v1[2], v1[3]);
                            *(u32x4*)(rp + bj * 128) = w; } }
            }
        } else {
            bf16_t* QR = WSP(bf16_t, WS_QS); bf16_t* CQ = WSP(bf16_t, WS_CQ); bf16_t* KR = WSP(bf16_t, WS_KR); bf16_t* VT = WSP(bf16_t, WS_VT);
            float* KSN = WSP(float, WS_KSN); float* VSN = WSP(float, WS_VSN); const f32x2* rope = WSP(f32x2, WS_ROPE);
            const int pn = u.pn;
#pragma unroll
            for (int ai = 0; ai < 2; ++ai)
#pragma unroll
                for (int m = 0; m < 4; ++m) { const int row = row0 + ai * 128 + m * 16; const int pos = row < MP ? (row & (SEQ - 1)) : SEQ; const int b = row >> 13, t = row & (SEQ - 1);
#pragma unroll
                    for (int bj = 0; bj < 2; ++bj) { const int cc = bj * 128 + cl0; const float rsc = ROW_SCALE(row < MP ? row : 0); f32x4 v0 = acc[ai][bj][m][0] * rsc, v1 = acc[ai][bj][m][1] * rsc;
                        if (pn == 3) { u32x4 w; w.x = cvtpk(v0[0], v0[1]); w.y = cvtpk(v0[2], v0[3]); w.z = cvtpk(v1[0], v1[1]); w.w = cvtpk(v1[2], v1[3]); *(u32x4*)(CQ + (size_t)row * XW + cc) = w; }
                        else if (pn == 5) {
                            const int kvh = cc >> 6, d = cc & 63;
                            if (row < MP) { bf16_t* vp = VT + ((size_t)((b * 4 + kvh) * 64 + d)) * KVP + 128 + t;
#pragma unroll
                                for (int e = 0; e < 4; ++e) { vp[(size_t)e * KVP] = f2bf(v0[e]); vp[(size_t)(e + 4) * KVP] = f2bf(v1[e]); }
                                if (t >= SEQ - 128) { float* op = out + O_SVP + ((size_t)(b * 128 + (t - (SEQ - 128))) * 4 + kvh) * 64 + d; *(f32x4*)op = v0; *(f32x4*)(op + 4) = v1; } }
                            else if (row < MP + BS) { const int bs = row - MP; float* op = out + O_SVS + ((size_t)(bs * 128 + 127) * 4 + kvh) * 64 + d; *(f32x4*)op = v0; *(f32x4*)(op + 4) = v1;
                                float* sp = VSN + (size_t)(bs * 4 + kvh) * 64 + d; *(f32x4*)sp = v0; *(f32x4*)(sp + 4) = v1; }
                        } else {
                            const int hh = cc >> 6, i0 = (cc & 63) >> 1; const f32x2* rp = rope + (size_t)pos * 32 + i0;
                            float o[8];
#pragma unroll
                            for (int p = 0; p < 4; ++p) { const f32x2 cs = rp[p]; const float x1 = p < 2 ? v0[2 * p] : v1[2 * p - 4], x2 = p < 2 ? v0[2 * p + 1] : v1[2 * p - 3];
                                o[2 * p] = x1 * cs.x - x2 * cs.y; o[2 * p + 1] = x2 * cs.x + x1 * cs.y; }
                            u32x4 w; w.x = cvtpk(o[0], o[1]); w.y = cvtpk(o[2], o[3]); w.z = cvtpk(o[4], o[5]); w.w = cvtpk(o[6], o[7]);
                            if (pn < 3) *(u32x4*)(QR + (size_t)row * HW + pn * 256 + cc) = w;
                            else {
                                if (row < MP) { *(u32x4*)(KR + ((size_t)(b * 4 + hh) * KVP + 128 + t) * 64 + (cc & 63)) = w;
                                    if (t >= SEQ - 128) { float* op = out + O_SKP + ((size_t)(b * 128 + (t - (SEQ - 128))) * 4 + hh) * 64;
#pragma unroll
                                        for (int p = 0; p < 4; ++p) { op[i0 + p] = o[2 * p]; op[i0 + p + 32] = o[2 * p + 1]; } } }
                                else if (row < MP + BS) { const int bs = row - MP; float* op = out + O_SKS + ((size_t)(bs * 128 + 127) * 4 + hh) * 64; float* sp = KSN + (size_t)(bs * 4 + hh) * 64;
#pragma unroll
                                    for (int p = 0; p < 4; ++p) { op[i0 + p] = o[2 * p]; op[i0 + p + 32] = o[2 * p + 1]; sp[i0 + p] = o[2 * p]; sp[i0 + p + 32] = o[2 * p + 1]; } }
                            }
                        } } }
        }
    }
};

struct PanelSq {
    unsigned long long* xbuf;
    unsigned tag;
    unsigned* tmo;
    __device__ __forceinline__ void run(const f32x4 (&v)[2][2][4][2], const pg8::Unit& u, int wr, int wc, int fr, int fq, LAS unsigned char* lds, int wid, int lane) const {
        LAS float* P = (LAS float*)lds;
        LAS float* S = (LAS float*)(lds + 8192);
#pragma unroll
        for (int ai = 0; ai < 2; ++ai)
#pragma unroll
            for (int m = 0; m < 4; ++m) { float s = 0.f;
#pragma unroll
                for (int bj = 0; bj < 2; ++bj)
#pragma unroll
                    for (int n = 0; n < 2; ++n) { const f32x4 x = v[ai][bj][m][n]; s += (x[0] * x[0] + x[1] * x[1]) + (x[2] * x[2] + x[3] * x[3]); }
                s += __shfl_xor(s, 16); s += __shfl_xor(s, 32);
                if (fq == 0) P[(ai * 128 + wr * 64 + m * 16 + fr) * 4 + wc] = s; }
        asm volatile("s_waitcnt lgkmcnt(0)" ::: "memory"); __builtin_amdgcn_s_barrier(); asm volatile("" ::: "memory");
        if (lane < 32) { const int row = wid * 32 + lane;
            const f32x4 p = *(const LAS f32x4*)(P + row * 4); const float t = (p[0] + p[1]) + (p[2] + p[3]);
            unsigned long long* slot = xbuf + (size_t)(u.pm * 256 + row) * 4;
            __hip_atomic_store(slot + u.pn, ((unsigned long long)tag << 32) | __float_as_uint(t), __ATOMIC_RELAXED, __HIP_MEMORY_SCOPE_AGENT);
            unsigned spins = 0; float q;
            for (;;) { bool ok = true; q = 0.f;
#pragma unroll
                for (int t4 = 0; t4 < 4; ++t4) { const unsigned long long x = __hip_atomic_load(slot + t4, __ATOMIC_RELAXED, __HIP_MEMORY_SCOPE_AGENT); ok = ok && (unsigned)(x >> 32) == tag; q += __uint_as_float((unsigned)x); }
                if (__all(ok)) break;
                if (++spins > (1u << 16)) { if (lane == 0) __hip_atomic_store(tmo, 1u, __ATOMIC_RELAXED, __HIP_MEMORY_SCOPE_AGENT); break; }
                __builtin_amdgcn_s_sleep(1);
            }
            S[row] = rsqrtf(q * (1.f / 1024.f) + EPS); }
        asm volatile("s_waitcnt vmcnt(0) lgkmcnt(0)" ::: "memory"); __builtin_amdgcn_s_barrier(); asm volatile("" ::: "memory");
    }
};
struct EpiFused {
    const float* base; const bf16_t* hb_in; float* hout; bf16_t* hb_out; bf16_t* xn; const float* gpost; PanelSq st1, st2;
    __device__ __forceinline__ void fused(f32x4 (&acc)[2][2][4][2], const pg8::Unit& u, int wr, int wc, int fr, int fq, LAS unsigned char* lds, int wid, int lane) const {
        asm volatile("" : "+v"(fr), "+v"(fq));
        const LAS float* S = (const LAS float*)(lds + 8192);
        const int col0 = u.pn * 256 + wc * 32 + 8 * fq;
        u32x2 bpk[1][4][2][2];
#pragma unroll
        for (int ai = 0; ai < 1; ++ai)
#pragma unroll
            for (int m = 0; m < 4; ++m) { const size_t off = (size_t)(u.pm * 256 + ai * 128 + wr * 64 + m * 16 + fr) * D + col0;
#pragma unroll
                for (int bj = 0; bj < 2; ++bj)
#pragma unroll
                    for (int n = 0; n < 2; ++n) {
                        if (base) { const f32x4 bs = *(const f32x4*)(base + off + bj * 128 + 4 * n); bpk[ai][m][bj][n] = (u32x2){cvtpk(bs[0], bs[1]), cvtpk(bs[2], bs[3])}; }
                        else bpk[ai][m][bj][n] = *(const u32x2*)(hb_in + off + bj * 128 + 4 * n); } }
        st1.run(acc, u, wr, wc, fr, fq, lds, wid, lane);
        f32x4 gp[2][2];
#pragma unroll
        for (int bj = 0; bj < 2; ++bj)
#pragma unroll
            for (int n = 0; n < 2; ++n) gp[bj][n] = *(const f32x4*)(gpost + col0 + bj * 128 + 4 * n);
#pragma unroll
        for (int ai = 0; ai < 2; ++ai)
#pragma unroll
            for (int m = 0; m < 4; ++m) { const int r = ai * 128 + wr * 64 + m * 16 + fr; const float rs = S[r]; const size_t off = (size_t)(u.pm * 256 + r) * D + col0;
#pragma unroll
                for (int bj = 0; bj < 2; ++bj)
#pragma unroll
                    for (int n = 0; n < 2; ++n) { f32x4 bs;
                        if (ai == 0) { const u32x2 hw = bpk[0][m][bj][n]; bs = (f32x4){bflo(hw.x), bfhi(hw.x), bflo(hw.y), bfhi(hw.y)}; }
                        else if (base) bs = *(const f32x4*)(base + off + bj * 128 + 4 * n);
                        else { const u32x2 hw = *(const u32x2*)(hb_in + off + bj * 128 + 4 * n); bs = (f32x4){bflo(hw.x), bfhi(hw.x), bflo(hw.y), bfhi(hw.y)}; }
                        acc[ai][bj][m][n] = bs + acc[ai][bj][m][n] * rs * gp[bj][n]; }
                asm volatile("" : "+v"(acc[ai][0][m][0]), "+v"(acc[ai][0][m][1]), "+v"(acc[ai][1][m][0]), "+v"(acc[ai][1][m][1]));
                if (m & 1) asm volatile("" ::: "memory"); }
        if (xn) {
            float* rp = (float*)xn;
#pragma unroll
            for (int ai = 0; ai < 2; ++ai)
#pragma unroll
                for (int m = 0; m < 4; ++m) { float s = 0.f;
#pragma unroll
                    for (int bj = 0; bj < 2; ++bj)
#pragma unroll
                        for (int n = 0; n < 2; ++n) { const f32x4 x = acc[ai][bj][m][n]; s += (x[0] * x[0] + x[1] * x[1]) + (x[2] * x[2] + x[3] * x[3]); }
                    s += __shfl_xor(s, 16); s += __shfl_xor(s, 32);
                    if (fq == 0) rp[(size_t)(u.pm * 256 + ai * 128 + wr * 64 + m * 16 + fr) * 16 + u.pn * 4 + wc] = s; }
        }
#pragma unroll
        for (int ai = 0; ai < 2; ++ai)
#pragma unroll
            for (int m = 0; m < 4; ++m) { const int r = ai * 128 + wr * 64 + m * 16 + fr; const size_t off = (size_t)(u.pm * 256 + r) * D + col0;

#pragma unroll
                for (int bj = 0; bj < 2; ++bj) { const f32x4 x0 = acc[ai][bj][m][0], x1 = acc[ai][bj][m][1];
                    if (hout) { *(f32x4*)(hout + off + bj * 128) = x0; *(f32x4*)(hout + off + bj * 128 + 4) = x1; }
                    else { u32x4 hw; hw.x = cvtpk(x0[0], x0[1]); hw.y = cvtpk(x0[2], x0[3]); hw.z = cvtpk(x1[0], x1[1]); hw.w = cvtpk(x1[2], x1[3]); *(u32x4*)(hb_out + off + bj * 128) = hw; }
                }
                asm volatile("" ::: "memory"); }
    }
};

__device__ __forceinline__ void norm_phase(Frame& F, const float* gpost, bool final_out) {
    unsigned char* ws = F.ws;
    const int gw = F.vcu * NWAVES + F.wave, NGW = F.G * NWAVES, lane = F.lane;
    float* H = WSP(float, WS_H); const float* Y = WSP(float, WS_Y); bf16_t* XN = WSP(bf16_t, WS_XN);
    f32x4 gp[4];
#pragma unroll
    for (int j = 0; j < 4; ++j) gp[j] = ((const f32x4*)gpost)[lane + 64 * j];
    for (int m = gw; m < MP; m += NGW) {
        const f32x4* yr = (const f32x4*)(Y + (size_t)m * D) + lane; f32x4* hr = (f32x4*)(H + (size_t)m * D) + lane;
        f32x4 y[4], h[4]; float s = 0.f;
#pragma unroll
        for (int j = 0; j < 4; ++j) { y[j] = yr[64 * j]; h[j] = hr[64 * j]; s += (y[j].x * y[j].x + y[j].y * y[j].y) + (y[j].z * y[j].z + y[j].w * y[j].w); }
        const float rstd = rsqrtf(wave_sum(s) * (1.f / D) + EPS); float s2 = 0.f;
#pragma unroll
        for (int j = 0; j < 4; ++j) { h[j] = h[j] + y[j] * rstd * gp[j]; s2 += (h[j].x * h[j].x + h[j].y * h[j].y) + (h[j].z * h[j].z + h[j].w * h[j].w); }
        if (final_out) { f32x4* orow = (f32x4*)(m < MP ? F.out + O_YP + (size_t)m * D : F.out + O_YS + (size_t)(m - MP) * D) + lane;
#pragma unroll
            for (int j = 0; j < 4; ++j) orow[64 * j] = h[j];
        } else {
            const float rstd2 = rsqrtf(wave_sum(s2) * (1.f / D) + EPS);
            u32x2* o8 = (u32x2*)(XN + (size_t)m * D) + lane;
#pragma unroll
            for (int j = 0; j < 4; ++j) { hr[64 * j] = h[j]; u32x2 w; w.x = cvtpk(h[j].x * rstd2, h[j].y * rstd2); w.y = cvtpk(h[j].z * rstd2, h[j].w * rstd2); o8[64 * j] = w; }
        }
    }
}

constexpr int HS_NSEG = 16, HS_CPS = 8, HS_UNITS = 12 * HS_NSEG;
constexpr int HL_RAW_LF = 0, HL_RAW_K = 32768, HL_RAW_V = 49152, HL_RAW_Q = 65536;
constexpr int HL_TOT = 81920;
constexpr int HL_A = HL_TOT + 4096;
constexpr int HL_KT = HL_A + 512;
constexpr int HL_VTT = HL_KT + 128 * 144;
constexpr int HL_QH = 0;
constexpr int HL_QT = HL_QH + 64 * 272, HL_KTL = HL_QT + 64 * 272, HL_P = HL_KTL + 64 * 272;
constexpr int HL_O = HL_P + 64 * 144;
static_assert(HL_O + 64 * 272 <= HL_TOT && HL_VTT + 128 * 144 <= RING_BYTES, "hgrn lds");

__device__ __forceinline__ f32x4 mfma16(bf16x8 a, bf16x8 b, f32x4 c) { return __builtin_amdgcn_mfma_f32_16x16x32_bf16(a, b, c, 0, 0, 0); }
__device__ __forceinline__ void st16_lds(LAS unsigned char* p, const float (&v)[16]) {
    u32x4 w0, w1; w0.x = cvtpk(v[0], v[1]); w0.y = cvtpk(v[2], v[3]); w0.z = cvtpk(v[4], v[5]); w0.w = cvtpk(v[6], v[7]);
    w1.x = cvtpk(v[8], v[9]); w1.y = cvtpk(v[10], v[11]); w1.z = cvtpk(v[12], v[13]); w1.w = cvtpk(v[14], v[15]);
    *(LAS u32x4*)p = w0; *(LAS u32x4*)(p + 16) = w1;
}
struct HRaw { f32x4 lf[4]; u32x4 k[2], v[2], q[2]; };
struct HPair { f32x2 lf[8]; unsigned k[8], v[8], q[8]; };
template <bool WITHQ> __device__ __forceinline__ void hpair_load(HPair& r, unsigned char* ws, int row0, int h, int cp, int tg) {
    const size_t e = (size_t)(row0 + tg * 8) * HW + h * 128 + 2 * cp;
    const float* LF = WSP(float, WS_LF) + e; const bf16_t* KK = WSP(bf16_t, WS_KK) + e; const bf16_t* VV = WSP(bf16_t, WS_VV) + e; const bf16_t* QS = WSP(bf16_t, WS_QS) + e;
#pragma unroll
    for (int i = 0; i < 8; ++i) { r.lf[i] = *(const f32x2*)(LF + (size_t)i * HW); r.k[i] = *(const unsigned*)(KK + (size_t)i * HW); r.v[i] = *(const unsigned*)(VV + (size_t)i * HW); if (WITHQ) r.q[i] = *(const unsigned*)(QS + (size_t)i * HW); }
}
template <bool WITHQ> __device__ __forceinline__ void hraw_load(HRaw& r, unsigned char* ws, int row0, int h, int tid) {
    const size_t e = (size_t)(row0 + (tid >> 3)) * HW + h * 128 + (tid & 7) * 16;
    const float* LF = WSP(float, WS_LF) + e; const bf16_t* KK = WSP(bf16_t, WS_KK) + e; const bf16_t* VV = WSP(bf16_t, WS_VV) + e; const bf16_t* QS = WSP(bf16_t, WS_QS) + e;
#pragma unroll
    for (int j = 0; j < 4; ++j) r.lf[j] = *(const f32x4*)(LF + 4 * j);
#pragma unroll
    for (int j = 0; j < 2; ++j) { r.k[j] = *(const u32x4*)(KK + 8 * j); r.v[j] = *(const u32x4*)(VV + 8 * j); if (WITHQ) r.q[j] = *(const u32x4*)(QS + 8 * j); }
}
template <bool WITHQ> __device__ __forceinline__ void hraw_store(const HRaw& r, LAS unsigned char* lds, int tid) {
    const int o = (tid >> 3) * 128 + (tid & 7) * 16;
#pragma unroll
    for (int j = 0; j < 4; ++j) *(LAS f32x4*)(lds + HL_RAW_LF + (o + 4 * j) * 4) = r.lf[j];
#pragma unroll
    for (int j = 0; j < 2; ++j) { *(LAS u32x4*)(lds + HL_RAW_K + (o + 8 * j) * 2) = r.k[j]; *(LAS u32x4*)(lds + HL_RAW_V + (o + 8 * j) * 2) = r.v[j]; if (WITHQ) *(LAS u32x4*)(lds + HL_RAW_Q + (o + 8 * j) * 2) = r.q[j]; }
}
__device__ __forceinline__ void hgrn_state_update(f32x4 (&acc)[8], LAS unsigned char* lds, int w, int fr, int g) {
    bf16x8 bf[2];
#pragma unroll
    for (int ks = 0; ks < 2; ++ks) bf[ks] = *(const LAS bf16x8*)(lds + HL_VTT + (16 * w + fr) * 144 + ks * 64 + g * 16);
#pragma unroll
    for (int nb = 0; nb < 8; ++nb) { const f32x4 a4 = *(const LAS f32x4*)(lds + HL_A + (16 * nb + 4 * g) * 4); acc[nb] = acc[nb] * a4;
#pragma unroll
        for (int ks = 0; ks < 2; ++ks) { const bf16x8 af = *(const LAS bf16x8*)(lds + HL_KT + (16 * nb + fr) * 144 + ks * 64 + g * 16); acc[nb] = mfma16(af, bf[ks], acc[nb]); } }
}

__device__ __forceinline__ void hgrn_pass1_unit(Frame& F, int unit) {
    unsigned char* ws = F.ws; LAS unsigned char* lds = F.lds;
    const int bh = unit >> 4, seg = unit & 15, b_ = bh / 6, h = bh % 6;
    const int tid = F.tid, cp = tid & 63, tg = tid >> 6, lane = F.lane, w = F.wave, fr = lane & 15, g = lane >> 4;
    f32x4 acc[8];
#pragma unroll
    for (int nb = 0; nb < 8; ++nb) acc[nb] = zero4();
    float bsum0 = 0.f, bsum1 = 0.f;
    HPair r; hpair_load<false>(r, ws, b_ * SEQ + seg * (HS_CPS * 64), h, cp, tg);
#pragma unroll 1
    for (int cc = 0; cc < HS_CPS; ++cc) {
        float b0[8], b1[8], k0[8], k1[8], v0[8], v1[8]; float run0 = 0.f, run1 = 0.f;
#pragma unroll
        for (int i = 0; i < 8; ++i) { run0 += r.lf[i].x; run1 += r.lf[i].y; b0[i] = run0; b1[i] = run1; k0[i] = bflo(r.k[i]); k1[i] = bfhi(r.k[i]); v0[i] = bflo(r.v[i]); v1[i] = bfhi(r.v[i]); }
        if (cc + 1 < HS_CPS) hpair_load<false>(r, ws, b_ * SEQ + (seg * HS_CPS + cc + 1) * 64, h, cp, tg);
        LAS float* tot = (LAS float*)(lds + HL_TOT);
        *(LAS f32x2*)(tot + tg * 128 + 2 * cp) = (f32x2){run0, run1};
        { u32x4 w0, w1; w0.x = cvtpk(v0[0], v0[1]); w0.y = cvtpk(v0[2], v0[3]); w0.z = cvtpk(v0[4], v0[5]); w0.w = cvtpk(v0[6], v0[7]); w1.x = cvtpk(v1[0], v1[1]); w1.y = cvtpk(v1[2], v1[3]); w1.z = cvtpk(v1[4], v1[5]); w1.w = cvtpk(v1[6], v1[7]);
          *(LAS u32x4*)(lds + HL_VTT + (2 * cp) * 144 + tg * 16) = w0; *(LAS u32x4*)(lds + HL_VTT + (2 * cp + 1) * 144 + tg * 16) = w1; }
        __syncthreads();
        float pre0 = 0.f, pre1 = 0.f, bt0 = 0.f, bt1 = 0.f;
#pragma unroll
        for (int q = 0; q < 8; ++q) { const f32x2 t = *(const LAS f32x2*)(tot + q * 128 + 2 * cp); if (q < tg) { pre0 += t.x; pre1 += t.y; } bt0 += t.x; bt1 += t.y; }
#pragma unroll
        for (int i = 0; i < 8; ++i) { k0[i] *= fexp(bt0 - (b0[i] + pre0)); k1[i] *= fexp(bt1 - (b1[i] + pre1)); }
        { u32x4 w0, w1; w0.x = cvtpk(k0[0], k0[1]); w0.y = cvtpk(k0[2], k0[3]); w0.z = cvtpk(k0[4], k0[5]); w0.w = cvtpk(k0[6], k0[7]); w1.x = cvtpk(k1[0], k1[1]); w1.y = cvtpk(k1[2], k1[3]); w1.z = cvtpk(k1[4], k1[5]); w1.w = cvtpk(k1[6], k1[7]);
          *(LAS u32x4*)(lds + HL_KT + (2 * cp) * 144 + tg * 16) = w0; *(LAS u32x4*)(lds + HL_KT + (2 * cp + 1) * 144 + tg * 16) = w1; }
        if (tg == 0) *(LAS f32x2*)(lds + HL_A + 2 * cp * 4) = (f32x2){fexp(bt0), fexp(bt1)};
        bsum0 += bt0; bsum1 += bt1;
        __syncthreads();
        hgrn_state_update(acc, lds, w, fr, g);
        __syncthreads();
    }
    float* US = WSP(float, WS_USEG) + (size_t)unit * 16384;
#pragma unroll
    for (int nb = 0; nb < 8; ++nb)
#pragma unroll
        for (int i = 0; i < 4; ++i) US[(nb * 4 + i) * 512 + tid] = acc[nb][i];
    if (tg == 0) *(f32x2*)(WSP(float, WS_ASEG) + (size_t)unit * 128 + 2 * cp) = (f32x2){fexp(bsum0), fexp(bsum1)};
}

__device__ __forceinline__ void hgrn_pass2(Frame& F, int layer) {
    unsigned char* ws = F.ws;
    const int gt = F.vcu * NTHR + F.tid, NGT = F.G * NTHR;
    for (int e = gt; e < 12 * 16384; e += NGT) {
        const int bh = e >> 14, idx = e & 16383, nbi = idx >> 9, t = idx & 511, g = (t >> 4) & 3, fr = t & 15, w = t >> 6;
        const int ch = 16 * (nbi >> 2) + 4 * g + (nbi & 3), v = 16 * w + fr;
        const float* US = WSP(float, WS_USEG) + (size_t)bh * HS_NSEG * 16384 + idx; float* SS = WSP(float, WS_SST) + (size_t)bh * HS_NSEG * 16384 + idx;
        const float* AS = WSP(float, WS_ASEG) + (size_t)bh * HS_NSEG * 128 + ch;
        float u[HS_NSEG], a[HS_NSEG];
#pragma unroll
        for (int s = 0; s < HS_NSEG; ++s) { u[s] = US[(size_t)s * 16384]; a[s] = AS[s * 128]; }
        float st = 0.f;
#pragma unroll
        for (int s = 0; s < HS_NSEG; ++s) { SS[(size_t)s * 16384] = st; st = a[s] * st + u[s]; }
        const int b_ = bh / 6, h = bh % 6;
        F.out[O_HP + ((size_t)((layer * 2 + b_) * 6 + h)) * 16384 + (size_t)ch * 128 + v] = st;
    }
}

__device__ __forceinline__ void hgrn_pass3_unit(Frame& F, int unit, int layer) {
    unsigned char* ws = F.ws; LAS unsigned char* lds = F.lds;
    const int bh = unit >> 4, seg = unit & 15, b_ = bh / 6, h = bh % 6;
    const int tid = F.tid, cp = tid & 63, tg = tid >> 6, lane = F.lane, w = F.wave, fr = lane & 15, g = lane >> 4;
    f32x4 acc[8];
    { const float* SS = WSP(float, WS_SST) + (size_t)unit * 16384;
#pragma unroll
      for (int nb = 0; nb < 8; ++nb)
#pragma unroll
          for (int i = 0; i < 4; ++i) acc[nb][i] = SS[(nb * 4 + i) * 512 + tid]; }
    const bf16_t* GG = WSP(bf16_t, WS_GG); bf16_t* MIX = WSP(bf16_t, WS_MIX);
    const int etok = tid >> 3, ec = (tid & 7) * 16;
    HPair r; hpair_load<true>(r, ws, b_ * SEQ + seg * (HS_CPS * 64), h, cp, tg);
#pragma unroll 1
    for (int cc = 0; cc < HS_CPS; ++cc) {
        const int row0 = b_ * SEQ + (seg * HS_CPS + cc) * 64;
        float b0[8], b1[8], k0[8], k1[8], q0[8], q1[8]; float run0 = 0.f, run1 = 0.f;
        {
            float v0[8], v1[8];
#pragma unroll
            for (int i = 0; i < 8; ++i) { run0 += r.lf[i].x; run1 += r.lf[i].y; b0[i] = run0; b1[i] = run1;
                k0[i] = bflo(r.k[i]); k1[i] = bfhi(r.k[i]); v0[i] = bflo(r.v[i]); v1[i] = bfhi(r.v[i]); q0[i] = bflo(r.q[i]); q1[i] = bfhi(r.q[i]); }
            if (cc + 1 < HS_CPS) hpair_load<true>(r, ws, row0 + 64, h, cp, tg);
            u32x4 w0, w1; w0.x = cvtpk(v0[0], v0[1]); w0.y = cvtpk(v0[2], v0[3]); w0.z = cvtpk(v0[4], v0[5]); w0.w = cvtpk(v0[6], v0[7]); w1.x = cvtpk(v1[0], v1[1]); w1.y = cvtpk(v1[2], v1[3]); w1.z = cvtpk(v1[4], v1[5]); w1.w = cvtpk(v1[6], v1[7]);
            *(LAS u32x4*)(lds + HL_VTT + (2 * cp) * 144 + tg * 16) = w0; *(LAS u32x4*)(lds + HL_VTT + (2 * cp + 1) * 144 + tg * 16) = w1;
        }
        LAS float* tot = (LAS float*)(lds + HL_TOT);
        *(LAS f32x2*)(tot + tg * 128 + 2 * cp) = (f32x2){run0, run1};
        __syncthreads();
        {
            float pre0 = 0.f, pre1 = 0.f, bt0 = 0.f, bt1 = 0.f, bm0 = 0.f, bm1 = 0.f;
#pragma unroll
            for (int q = 0; q < 8; ++q) { const f32x2 t = *(const LAS f32x2*)(tot + q * 128 + 2 * cp); if (q < tg) { pre0 += t.x; pre1 += t.y; } if (q < 4) { bm0 += t.x; bm1 += t.y; } bt0 += t.x; bt1 += t.y; }
            const float c10 = fexp(bm0), c11 = fexp(bm1), c20 = fexp(bt0 - bm0), c21 = fexp(bt1 - bm1);
            LAS unsigned* qh = (LAS unsigned*)(lds + HL_QH); LAS unsigned* qt = (LAS unsigned*)(lds + HL_QT); LAS unsigned* kt = (LAS unsigned*)(lds + HL_KTL);
#pragma unroll
            for (int i = 0; i < 8; ++i) { const float d0 = b0[i] + pre0 - bm0, d1 = b1[i] + pre1 - bm1; const int o = ((tg * 8 + i) * 136 + 2 * cp) >> 1;
                const float qt0 = q0[i] * fexp(fminf(d0, 80.f)), qt1 = q1[i] * fexp(fminf(d1, 80.f)), kt0 = k0[i] * fexp(fminf(-d0, 80.f)), kt1 = k1[i] * fexp(fminf(-d1, 80.f));
                qt[o] = cvtpk(qt0, qt1); kt[o] = cvtpk(kt0, kt1); qh[o] = cvtpk(qt0 * c10, qt1 * c11); k0[i] = kt0 * c20; k1[i] = kt1 * c21; }
            u32x4 w0, w1; w0.x = cvtpk(k0[0], k0[1]); w0.y = cvtpk(k0[2], k0[3]); w0.z = cvtpk(k0[4], k0[5]); w0.w = cvtpk(k0[6], k0[7]); w1.x = cvtpk(k1[0], k1[1]); w1.y = cvtpk(k1[2], k1[3]); w1.z = cvtpk(k1[4], k1[5]); w1.w = cvtpk(k1[6], k1[7]);
            *(LAS u32x4*)(lds + HL_KT + (2 * cp) * 144 + tg * 16) = w0; *(LAS u32x4*)(lds + HL_KT + (2 * cp + 1) * 144 + tg * 16) = w1;
            if (tg == 0) *(LAS f32x2*)(lds + HL_A + 2 * cp * 4) = (f32x2){fexp(bt0), fexp(bt1)};
        }
        __syncthreads();
        u32x4 gg[2];
#pragma unroll
        for (int j = 0; j < 2; ++j) gg[j] = *(const u32x4*)(GG + (size_t)(row0 + etok) * HW + h * 128 + ec + 8 * j);
        {
            const int tb = w >> 1;
#pragma unroll
            for (int q2 = 0; q2 < 2; ++q2) { const int sb = 2 * (w & 1) + q2; f32x4 pa = {0.f, 0.f, 0.f, 0.f};
                if (sb <= tb) {
#pragma unroll
                    for (int ks = 0; ks < 4; ++ks) { const bf16x8 af = *(const LAS bf16x8*)(lds + HL_QT + (16 * tb + fr) * 272 + ks * 64 + g * 16);
                        const bf16x8 bf = *(const LAS bf16x8*)(lds + HL_KTL + (16 * sb + fr) * 272 + ks * 64 + g * 16); pa = mfma16(af, bf, pa); } }
                LAS bf16_t* P = (LAS bf16_t*)(lds + HL_P);
#pragma unroll
                for (int i = 0; i < 4; ++i) { const int t = 16 * tb + 4 * g + i, s = 16 * sb + fr; P[t * 72 + s] = f2bf((sb <= tb && s <= t) ? pa[i] : 0.f); } }
        }
        __syncthreads();
        {
            f32x4 o[4];
#pragma unroll
            for (int tb = 0; tb < 4; ++tb) o[tb] = zero4();
#pragma unroll
            for (int ks = 0; ks < 4; ++ks) { u32x4 sw; sw.x = cvtpk(acc[2 * ks][0], acc[2 * ks][1]); sw.y = cvtpk(acc[2 * ks][2], acc[2 * ks][3]); sw.z = cvtpk(acc[2 * ks + 1][0], acc[2 * ks + 1][1]); sw.w = cvtpk(acc[2 * ks + 1][2], acc[2 * ks + 1][3]);
                const bf16x8 bf = __builtin_bit_cast(bf16x8, sw);
#pragma unroll
                for (int tb = 0; tb < 4; ++tb) { const LAS unsigned char* qp = lds + HL_QH + (16 * tb + fr) * 272 + (32 * ks + 4 * g) * 2;
                    const u32x2 lo = *(const LAS u32x2*)qp, hi = *(const LAS u32x2*)(qp + 32); u32x4 aw; aw.x = lo.x; aw.y = lo.y; aw.z = hi.x; aw.w = hi.y;
                    o[tb] = mfma16(__builtin_bit_cast(bf16x8, aw), bf, o[tb]); } }
#pragma unroll
            for (int ks = 0; ks < 2; ++ks) { const bf16x8 bf = *(const LAS bf16x8*)(lds + HL_VTT + (16 * w + fr) * 144 + ks * 64 + g * 16);
#pragma unroll
                for (int tb = 0; tb < 4; ++tb) { const bf16x8 af = *(const LAS bf16x8*)(lds + HL_P + (16 * tb + fr) * 144 + ks * 64 + g * 16); o[tb] = mfma16(af, bf, o[tb]); } }
            LAS bf16_t* O = (LAS bf16_t*)(lds + HL_O);
#pragma unroll
            for (int tb = 0; tb < 4; ++tb)
#pragma unroll
                for (int i = 0; i < 4; ++i) O[(16 * tb + 4 * g + i) * 136 + 16 * w + fr] = f2bf(o[tb][i]);
        }
        hgrn_state_update(acc, lds, w, fr, g);
        __syncthreads();
        {
            const u32x4 o0 = *(const LAS u32x4*)(lds + HL_O + etok * 272 + ec * 2), o1 = *(const LAS u32x4*)(lds + HL_O + etok * 272 + ec * 2 + 16);
            float ov[16] = {bflo(o0.x), bfhi(o0.x), bflo(o0.y), bfhi(o0.y), bflo(o0.z), bfhi(o0.z), bflo(o0.w), bfhi(o0.w), bflo(o1.x), bfhi(o1.x), bflo(o1.y), bfhi(o1.y), bflo(o1.z), bfhi(o1.z), bflo(o1.w), bfhi(o1.w)};
            float ss = 0.f;
#pragma unroll
            for (int e = 0; e < 16; ++e) ss += ov[e] * ov[e];
            ss += __shfl_xor(ss, 1); ss += __shfl_xor(ss, 2); ss += __shfl_xor(ss, 4);
            const float rstd = rsqrtf(ss * (1.f / 128.f) + EPS);
            f32x4 gain[4];
#pragma unroll
            for (int j = 0; j < 4; ++j) gain[j] = *(const f32x4*)(in_ptr(12) + layer * HW + h * 128 + ec + 4 * j);
            const unsigned gw_[8] = {gg[0].x, gg[0].y, gg[0].z, gg[0].w, gg[1].x, gg[1].y, gg[1].z, gg[1].w};
            unsigned res[8];
#pragma unroll
            for (int e = 0; e < 8; ++e) { const float ga = gain[e >> 1][(e & 1) * 2], gb = gain[e >> 1][(e & 1) * 2 + 1];
                res[e] = cvtpk(ov[2 * e] * rstd * ga * bflo(gw_[e]), ov[2 * e + 1] * rstd * gb * bfhi(gw_[e])); }
            bf16_t* mp = MIX + (size_t)(row0 + etok) * D + h * 128 + ec;
            *(u32x4*)mp = (u32x4){res[0], res[1], res[2], res[3]}; *(u32x4*)(mp + 8) = (u32x4){res[4], res[5], res[6], res[7]};
        }
        __syncthreads();
    }
}

__device__ __forceinline__ void hgrn_sample_bs(Frame& F, int bs, int layer) {
    unsigned char* ws = F.ws;
    const int row = bs, tid = F.tid, v4 = tid & 31, chg = tid >> 5;
    const float* LF = SBUF(float, SB_LF) + (size_t)row * HW; const bf16_t* KK = SBUF(bf16_t, SB_KK) + (size_t)row * HW; const bf16_t* VV = SBUF(bf16_t, SB_VV) + (size_t)row * HW;
    const bf16_t* QS = SBUF(bf16_t, SB_QS) + (size_t)row * HW; const bf16_t* GG = SBUF(bf16_t, SB_GG) + (size_t)row * HW;
    const float* S0 = in_ptr(4) + ((size_t)(layer * BS + bs) * 6) * 16384 + 4 * v4; float* SN = F.out + O_HS + ((size_t)(layer * BS + bs) * 6) * 16384 + 4 * v4;
    LAS float* red = (LAS float*)F.lds;
    f32x4 s0[8];
#pragma unroll
    for (int i = 0; i < 8; ++i) s0[i] = __builtin_nontemporal_load((const f32x4*)(S0 + (size_t)(chg + 16 * i) * 128));
#pragma unroll 1
    for (int h = 0; h < 6; ++h) {
        const int e0 = h * 128; LAS float* rb = red + (h & 1) * 2304;
        f32x4 vv; { const u32x2 w = *(const u32x2*)(VV + e0 + 4 * v4); vv = (f32x4){bflo(w.x), bfhi(w.x), bflo(w.y), bfhi(w.y)}; }
        f32x4 oacc = zero4(); f32x4 sn[8];
#pragma unroll
        for (int i = 0; i < 8; ++i) { const int ch = chg + 16 * i; const float f = fexp(LF[e0 + ch]), k = bf2f(KK[e0 + ch]), q = bf2f(QS[e0 + ch]); sn[i] = s0[i] * f + vv * k; oacc = oacc + sn[i] * q; }
        if (h < 5) {
#pragma unroll
            for (int i = 0; i < 8; ++i) s0[i] = __builtin_nontemporal_load((const f32x4*)(S0 + (size_t)(h + 1) * 16384 + (size_t)(chg + 16 * i) * 128)); }
#pragma unroll
        for (int i = 0; i < 8; ++i) __builtin_nontemporal_store(sn[i], (f32x4*)(SN + (size_t)h * 16384 + (size_t)(chg + 16 * i) * 128));
        *(LAS f32x4*)(rb + chg * 128 + 4 * v4) = oacc;
        __syncthreads();
        if (tid < 128) { float o = 0.f;
#pragma unroll
            for (int j = 0; j < 16; ++j) o += rb[j * 128 + tid];
            const float ss = wave_sum(o * o); if (F.lane == 0) rb[2048 + F.wave] = ss;
            rb[2064 + tid] = o; }
        __syncthreads();
        if (tid < 128) { const float ss = rb[2048] + rb[2049]; const float rstd = rsqrtf(ss * (1.f / 128.f) + EPS);
            SBUF(bf16_t, SB_MIX)[(size_t)row * D + e0 + tid] = f2bf(rb[2064 + tid] * rstd * in_ptr(12)[layer * HW + e0 + tid] * bf2f(GG[e0 + tid])); }
    }
    __syncthreads();
}

constexpr int AL_K = 0, AL_KROW = 144, AL_NK = 400;
constexpr int AL_V = AL_K + AL_NK * AL_KROW, AL_VROW = 816;
static_assert(AL_V + 64 * AL_VROW <= RING_BYTES, "attention lds");
__device__ __forceinline__ void attn_stage(LAS unsigned char* lds, const bf16_t* Kg, const bf16_t* Vg, int ldv, int nk, int tid) {
    for (int p = tid; p < nk * 8; p += NTHR) { const int row = p >> 3, c = p & 7; *(LAS u32x4*)(lds + AL_K + row * AL_KROW + c * 16) = *(const u32x4*)(Kg + (size_t)row * 64 + c * 8); }
    const int ppr = nk >> 3;
    for (int p = tid; p < 64 * ppr; p += NTHR) { const int row = p / ppr, c = p - row * ppr; *(LAS u32x4*)(lds + AL_V + row * AL_VROW + c * 16) = *(const u32x4*)(Vg + (size_t)row * ldv + c * 8); }
}
template <int NKB, bool SWA>
__device__ __forceinline__ void attn16(const bf16x8 (&qf)[2], LAS const unsigned char* lds, int koff, bf16_t* Orow0, int o_ld, float sink2, bool has_sink, int t0, int lane) {
    constexpr int NKS = (NKB + 1) / 2, NKP = 2 * NKS;
    const int fr = lane & 15, g = lane >> 4;
    LAS const unsigned char* Kl = lds + AL_K + (koff + fr) * AL_KROW + g * 16;
    LAS const unsigned char* Vl = lds + AL_V + fr * AL_VROW + (koff + 4 * g) * 2;
    f32x4 s[NKP];
#pragma unroll
    for (int blk = 0; blk < NKP; ++blk) { s[blk] = zero4();
        if (blk < NKB) {
#pragma unroll
            for (int ks = 0; ks < 2; ++ks) { const bf16x8 kf = *(const LAS bf16x8*)(Kl + blk * 16 * AL_KROW + ks * 64); s[blk] = mfma16(kf, qf[ks], s[blk]); } }
        if ((blk & 3) == 3) asm volatile("" ::: "memory"); }
    float m = -1e30f;
    if (SWA) {
        if (t0 >= 128) {
#pragma unroll
            for (int i = 0; i < 4; ++i) { if (4 * g + i <= fr) s[0][i] = -1e30f; if (4 * g + i > fr) s[8][i] = -1e30f; }
        } else { const int lo = max(fr + 1, 128 - t0), hi = fr + 128;
#pragma unroll
            for (int blk = 0; blk < NKB; ++blk)
#pragma unroll
                for (int i = 0; i < 4; ++i) { const int kidx = 16 * blk + 4 * g + i; if (kidx < lo || kidx > hi) s[blk][i] = -1e30f; } } }
#pragma unroll
    for (int blk = 0; blk < NKB; ++blk)
#pragma unroll
        for (int i = 0; i < 4; ++i) m = fmaxf(m, s[blk][i]);
    m = fmaxf(m, __shfl_xor(m, 16)); m = fmaxf(m, __shfl_xor(m, 32));
    if (has_sink) m = fmaxf(m, sink2);
    float l = 0.f;
#pragma unroll
    for (int blk = 0; blk < NKP; ++blk)
#pragma unroll
        for (int i = 0; i < 4; ++i) { const float p = (blk < NKB) ? __builtin_amdgcn_exp2f(s[blk][i] - m) : 0.f; s[blk][i] = p; l += p; }
    l += __shfl_xor(l, 16); l += __shfl_xor(l, 32);
    if (has_sink) l += __builtin_amdgcn_exp2f(sink2 - m);
    const float inv = __builtin_amdgcn_rcpf(l);
    f32x4 o[4];
#pragma unroll
    for (int db = 0; db < 4; ++db) o[db] = zero4();
#pragma unroll
    for (int ks = 0; ks < NKS; ++ks) {
        u32x4 pw; pw.x = cvtpk(s[2 * ks][0], s[2 * ks][1]); pw.y = cvtpk(s[2 * ks][2], s[2 * ks][3]); pw.z = cvtpk(s[2 * ks + 1][0], s[2 * ks + 1][1]); pw.w = cvtpk(s[2 * ks + 1][2], s[2 * ks + 1][3]);
        const bf16x8 pf = __builtin_bit_cast(bf16x8, pw);
#pragma unroll
        for (int db = 0; db < 4; ++db) { LAS const unsigned char* vp = Vl + db * 16 * AL_VROW + ks * 64;
            const u32x2 lo = *(const LAS u32x2*)vp, hi = *(const LAS u32x2*)(vp + 32); u32x4 vw; vw.x = lo.x; vw.y = lo.y; vw.z = hi.x; vw.w = hi.y;
            o[db] = mfma16(__builtin_bit_cast(bf16x8, vw), pf, o[db]); }
        asm volatile("" ::: "memory"); }
#pragma unroll
    for (int db = 0; db < 4; ++db) { u32x2 wv; wv.x = cvtpk(o[db][0] * inv, o[db][1] * inv); wv.y = cvtpk(o[db][2] * inv, o[db][3] * inv);
        *(u32x2*)(Orow0 + (size_t)fr * o_ld + 16 * db + 4 * g) = wv; }
}

__device__ __forceinline__ void memattn_wg(Frame& F, int u, int layer) {
    unsigned char* ws = F.ws;
    const int qc = u & 31, h = (u >> 5) & 3, b = u >> 7;
    const bf16_t* Kb = WSP(bf16_t, WS_MKB) + (size_t)((layer * 2 + b) * 4 + h) * 256 * 64; const bf16_t* Vb = WSP(bf16_t, WS_MVT) + (size_t)((layer * 2 + b) * 4 + h) * 64 * 256;
    const bf16_t* CQ = WSP(bf16_t, WS_CQ); bf16_t* MIX = WSP(bf16_t, WS_MIX);
    const int fr = F.lane & 15, g = F.lane >> 4;
    bf16x8 qf[2][2];
#pragma unroll
    for (int j = 0; j < 2; ++j)
#pragma unroll
        for (int ks = 0; ks < 2; ++ks) qf[j][ks] = *(const bf16x8*)(CQ + (size_t)(b * SEQ + qc * 256 + (F.wave + 8 * j) * 16 + fr) * XW + h * 64 + ks * 32 + g * 8);
    attn_stage(F.lds, Kb, Vb, 256, 256, F.tid);
    __syncthreads();
#pragma unroll
    for (int j = 0; j < 2; ++j) { const int row0 = b * SEQ + qc * 256 + (F.wave + 8 * j) * 16;
        attn16<16, false>(qf[j], F.lds, 0, MIX + (size_t)row0 * D + HW + h * 64, D, 0.f, false, 0, F.lane); }
    __syncthreads();
}
__device__ __forceinline__ void swa_wg(Frame& F, int u, int j) {
    unsigned char* ws = F.ws;
    const int qc = u & 31, kvh = (u >> 5) & 3, b = u >> 7, tq0 = qc * 256;
    const bf16_t* Kb = WSP(bf16_t, WS_KR) + ((size_t)(b * 4 + kvh) * KVP + tq0) * 64; const bf16_t* Vb = WSP(bf16_t, WS_VT) + (size_t)(b * 4 + kvh) * 64 * KVP + tq0;
    const bf16_t* QR = WSP(bf16_t, WS_QS); bf16_t* MIX = WSP(bf16_t, WS_MIX);
    const int fr = F.lane & 15, g = F.lane >> 4;
    bf16x8 qf[2][3][2]; float sk2[3];
#pragma unroll
    for (int gi = 0; gi < 3; ++gi) sk2[gi] = in_ptr(14)[j * 12 + kvh * 3 + gi] * LOG2E;
#pragma unroll
    for (int qb = 0; qb < 2; ++qb)
#pragma unroll
        for (int gi = 0; gi < 3; ++gi)
#pragma unroll
            for (int ks = 0; ks < 2; ++ks) qf[qb][gi][ks] = *(const bf16x8*)(QR + (size_t)(b * SEQ + tq0 + F.wave * 16 + qb * 128 + fr) * HW + (kvh * 3 + gi) * 64 + ks * 32 + g * 8);
    attn_stage(F.lds, Kb, Vb, KVP, AL_NK, F.tid);
    __syncthreads();
#pragma unroll
    for (int qb = 0; qb < 2; ++qb) { const int koff = F.wave * 16 + qb * 128, t0 = tq0 + koff, row0 = b * SEQ + t0;
#pragma unroll
        for (int gi = 0; gi < 3; ++gi) { const int hq = kvh * 3 + gi;
            attn16<9, true>(qf[qb][gi], F.lds, koff, MIX + (size_t)row0 * D + hq * 64, D, sk2[gi], true, t0, F.lane); } }
    __syncthreads();
}

__device__ __forceinline__ void memattn_sample_bs(Frame& F, int bs, int layer) {
    unsigned char* ws = F.ws; LAS float* L = (LAS float*)F.lds;
    const int lane = F.lane, w = F.wave, hh = lane >> 4, dl = lane & 15;
    const bf16_t* CQ = SBUF(bf16_t, SB_CQ) + (size_t)bs * XW + hh * 64 + 4 * dl;
    const u32x2 qw = *(const u32x2*)CQ; const f32x4 q4 = {bflo(qw.x), bfhi(qw.x), bflo(qw.y), bfhi(qw.y)};
    const float* Kc = in_ptr(2) + ((size_t)(layer * BS + bs) * 256 + 32 * w) * 256 + 4 * lane; const float* Vc = in_ptr(3) + ((size_t)(layer * BS + bs) * 256 + 32 * w) * 256 + 4 * lane;
    f32x4 kv[32]; float s[32];
#pragma unroll
    for (int i = 0; i < 32; ++i) kv[i] = __builtin_nontemporal_load((const f32x4*)(Kc + (size_t)i * 256));
    float m = -1e30f;
#pragma unroll
    for (int i = 0; i < 32; ++i) { float d = (kv[i].x * q4.x + kv[i].y * q4.y) + (kv[i].z * q4.z + kv[i].w * q4.w); d += __shfl_xor(d, 1); d += __shfl_xor(d, 2); d += __shfl_xor(d, 4); d += __shfl_xor(d, 8); s[i] = d; m = fmaxf(m, d); }
#pragma unroll
    for (int i = 0; i < 32; ++i) kv[i] = __builtin_nontemporal_load((const f32x4*)(Vc + (size_t)i * 256));
    if (dl == 0) L[w * 4 + hh] = m;
    __syncthreads();
#pragma unroll
    for (int j = 0; j < 8; ++j) m = fmaxf(m, L[j * 4 + hh]);
    float l = 0.f; f32x4 o = {0.f, 0.f, 0.f, 0.f};
#pragma unroll
    for (int i = 0; i < 32; ++i) { const float p = __builtin_amdgcn_exp2f(s[i] - m); l += p; o = o + kv[i] * p; }
    if (dl == 0) L[32 + w * 4 + hh] = l;
    *(LAS f32x4*)(L + 64 + w * 256 + 4 * lane) = o;
    __syncthreads();
    if (F.tid < 256) { const int t = F.tid, h2 = t >> 6; float acc = 0.f, ls = 0.f;
#pragma unroll
        for (int j = 0; j < 8; ++j) { acc += L[64 + j * 256 + t]; ls += L[32 + j * 4 + h2]; }
        SBUF(bf16_t, SB_MIX)[(size_t)bs * D + HW + t] = f2bf(acc * __builtin_amdgcn_rcpf(ls)); }
    __syncthreads();
}

__device__ __forceinline__ void swa_sample_bs(Frame& F, int bs, int j) {
    unsigned char* ws = F.ws; LAS float* L = (LAS float*)F.lds;
    const int lane = F.lane, w = F.wave, kvh = lane >> 4, dl = lane & 15;
    const bf16_t* QR = SBUF(bf16_t, SB_QS) + (size_t)bs * HW;
    f32x4 q4[3];
#pragma unroll
    for (int gi = 0; gi < 3; ++gi)
#pragma unroll
        for (int e = 0; e < 4; ++e) { const int d = 4 * dl + e; q4[gi][e] = bf2f(QR[(kvh * 3 + gi) * 64 + 2 * (d & 31) + (d >> 5)]); }
    const float* KSN = WSP(float, WS_KSN) + (size_t)bs * 256 + 4 * lane; const float* VSN = WSP(float, WS_VSN) + (size_t)bs * 256 + 4 * lane;
    f32x4 kv[16]; float s[3][16];
#pragma unroll
    for (int i = 0; i < 16; ++i) { const int key = 16 * w + i; kv[i] = key < 127 ? __builtin_nontemporal_load((const f32x4*)(in_ptr(5) + ((size_t)(bs * 128 + key + 1)) * 256 + 4 * lane)) : *(const f32x4*)KSN; }
    float m[3] = {-1e30f, -1e30f, -1e30f};
#pragma unroll
    for (int i = 0; i < 16; ++i) { const int key = 16 * w + i;
        if (j == 0 && key < 127) __builtin_nontemporal_store(kv[i], (f32x4*)(F.out + O_SKS + ((size_t)(bs * 128 + key)) * 256 + 4 * lane));
#pragma unroll
        for (int gi = 0; gi < 3; ++gi) { float d = (kv[i].x * q4[gi].x + kv[i].y * q4[gi].y) + (kv[i].z * q4[gi].z + kv[i].w * q4[gi].w); d += __shfl_xor(d, 1); d += __shfl_xor(d, 2); d += __shfl_xor(d, 4); d += __shfl_xor(d, 8); s[gi][i] = d; m[gi] = fmaxf(m[gi], d); } }
#pragma unroll
    for (int i = 0; i < 16; ++i) { const int key = 16 * w + i; kv[i] = key < 127 ? __builtin_nontemporal_load((const f32x4*)(in_ptr(6) + ((size_t)(bs * 128 + key + 1)) * 256 + 4 * lane)) : *(const f32x4*)VSN; }
    if (dl == 0) {
#pragma unroll
        for (int gi = 0; gi < 3; ++gi) L[w * 12 + kvh * 3 + gi] = m[gi]; }
    __syncthreads();
    float l[3]; f32x4 o[3];
#pragma unroll
    for (int gi = 0; gi < 3; ++gi) { const float sink2 = in_ptr(14)[j * 12 + kvh * 3 + gi] * LOG2E; float mm = sink2;
#pragma unroll
        for (int jw = 0; jw < 8; ++jw) mm = fmaxf(mm, L[jw * 12 + kvh * 3 + gi]);
        m[gi] = mm; l[gi] = w == 0 ? __builtin_amdgcn_exp2f(sink2 - mm) : 0.f; o[gi] = zero4(); }
#pragma unroll
    for (int i = 0; i < 16; ++i) { const int key = 16 * w + i;
        if (j == 0 && key < 127) __builtin_nontemporal_store(kv[i], (f32x4*)(F.out + O_SVS + ((size_t)(bs * 128 + key)) * 256 + 4 * lane));
#pragma unroll
        for (int gi = 0; gi < 3; ++gi) { const float p = __builtin_amdgcn_exp2f(s[gi][i] - m[gi]); l[gi] += p; o[gi] = o[gi] + kv[i] * p; } }
#pragma unroll
    for (int gi = 0; gi < 3; ++gi) { if (dl == 0) L[96 + w * 12 + kvh * 3 + gi] = l[gi]; *(LAS f32x4*)(L + 192 + (w * 3 + gi) * 256 + 4 * lane) = o[gi]; }
    __syncthreads();
    for (int t = F.tid; t < 768; t += NTHR) { const int gi = t >> 8, r = t & 255, kv2 = r >> 6, d = r & 63; float acc = 0.f, ls = 0.f;
#pragma unroll
        for (int jw = 0; jw < 8; ++jw) { acc += L[192 + (jw * 3 + gi) * 256 + r]; ls += L[96 + jw * 12 + kv2 * 3 + gi]; }
        SBUF(bf16_t, SB_MIX)[(size_t)bs * D + (kv2 * 3 + gi) * 64 + d] = f2bf(acc * __builtin_amdgcn_rcpf(ls)); }
    __syncthreads();
}

__device__ __forceinline__ int q_pull(Frame& F, unsigned* ctr) {
    volatile LAS int* slot = (volatile LAS int*)(F.lds + MISC_OFF + 64);
    __syncthreads();
    if (F.tid == 0) *slot = (int)__hip_atomic_fetch_add(ctr, 1u, __ATOMIC_RELAXED, __HIP_MEMORY_SCOPE_AGENT);
    __syncthreads();
    { int t_ = F.tid; asm volatile("" : "+v"(t_)); F.tid = t_; F.lane = t_ & 63; }
    return *slot;
}

constexpr int SL_X = 0, SL_XROW = 2064;
enum { SK_NONE = 0, SK_INA, SK_INB, SK_MIXA, SK_MIXB, SK_WO, SK_UP, SK_DOWN, SK_FINAL };

__device__ __forceinline__ void sample_norm_slab(Frame& F, int rg, const float* Hin, float* Hout, const float* Y, int nparts, const float* gpost, bool write_h) {
    const int tid = F.tid, r = tid >> 5, c = tid & 31, row = 16 * rg + r;
    f32x4 h[8]; float ss1 = 0.f;
    if (Y) {
        f32x4 y[8];
#pragma unroll
        for (int j = 0; j < 8; ++j) { y[j] = zero4();
            for (int p = 0; p < nparts; ++p) y[j] = y[j] + *(const f32x4*)(Y + ((size_t)p * BS + row) * D + 4 * c + 128 * j);
            ss1 += (y[j].x * y[j].x + y[j].y * y[j].y) + (y[j].z * y[j].z + y[j].w * y[j].w); }
        ss1 += __shfl_xor(ss1, 1); ss1 += __shfl_xor(ss1, 2); ss1 += __shfl_xor(ss1, 4); ss1 += __shfl_xor(ss1, 8); ss1 += __shfl_xor(ss1, 16);
        const float rstd1 = rsqrtf(ss1 * (1.f / D) + EPS);
#pragma unroll
        for (int j = 0; j < 8; ++j) h[j] = *(const f32x4*)(Hin + (size_t)row * D + 4 * c + 128 * j) + y[j] * rstd1 * *(const f32x4*)(gpost + 4 * c + 128 * j);
    } else {
#pragma unroll
        for (int j = 0; j < 8; ++j) h[j] = *(const f32x4*)(Hin + (size_t)row * D + 4 * c + 128 * j);
    }
    float ss2 = 0.f;
#pragma unroll
    for (int j = 0; j < 8; ++j) { ss2 += (h[j].x * h[j].x + h[j].y * h[j].y) + (h[j].z * h[j].z + h[j].w * h[j].w); if (write_h) *(f32x4*)(Hout + (size_t)row * D + 4 * c + 128 * j) = h[j]; }
    ss2 += __shfl_xor(ss2, 1); ss2 += __shfl_xor(ss2, 2); ss2 += __shfl_xor(ss2, 4); ss2 += __shfl_xor(ss2, 8); ss2 += __shfl_xor(ss2, 16);
    const float rstd2 = rsqrtf(ss2 * (1.f / D) + EPS);
#pragma unroll
    for (int j = 0; j < 8; ++j) { u32x2 w; w.x = cvtpk(h[j].x * rstd2, h[j].y * rstd2); w.y = cvtpk(h[j].z * rstd2, h[j].w * rstd2); *(LAS u32x2*)(F.lds + SL_X + r * SL_XROW + (4 * c + 128 * j) * 2) = w; }
}
__device__ __forceinline__ void sample_copy_slab(Frame& F, const bf16_t* A, int lda) {
#pragma unroll
    for (int j = 0; j < 4; ++j) { const int p = F.tid + NTHR * j, r = p >> 7, c = p & 127; *(LAS u32x4*)(F.lds + SL_X + r * SL_XROW + c * 16) = *(const u32x4*)(A + (size_t)r * lda + c * 8); }
}
__device__ __forceinline__ void sample_wave_wload(bf16x8 (&wf)[32], const bf16_t* Wt, int ldw, int n0, int lane) {
    const bf16_t* wp = Wt + (size_t)(n0 + (lane & 15)) * ldw + (lane >> 4) * 8;
#pragma unroll
    for (int k = 0; k < 32; ++k) wf[k] = *(const bf16x8*)(wp + k * 32);
}
__device__ __forceinline__ void sample_wave_gemm(f32x4& acc, const bf16x8 (&wf)[32], LAS const unsigned char* lds, int lane) {
    acc = zero4();
    LAS const unsigned char* xp = lds + SL_X + (lane & 15) * SL_XROW + (lane >> 4) * 16;
#pragma unroll
    for (int k = 0; k < 32; ++k) { const bf16x8 xf = *(const LAS bf16x8*)(xp + k * 64); acc = mfma16(wf[k], xf, acc); }
}

__device__ __forceinline__ void sample_epi_ina(Frame& F, const f32x4& v, int row, int c, int layer) {
    unsigned char* ws = F.ws;
    if (c >= 3072) { u32x2 w; w.x = cvtpk(v[0], v[1]); w.y = cvtpk(v[2], v[3]); *(u32x2*)(SBUF(bf16_t, SB_CQ) + (size_t)row * XW + (c - 3072)) = w; return; }
    const int sec = c / HW, cl = c - sec * HW; const size_t o = (size_t)row * HW + cl;
    if (sec == 1) { const f32x4 lb = *(const f32x4*)(WSP(float, WS_LBS) + layer * HW + cl); float lf[4], kk[4];
#pragma unroll
        for (int e = 0; e < 4; ++e) { const float z = v[e], t = fexp(-fabsf(z)), r = __builtin_amdgcn_rcpf(1.0f + t), big = r, small = t * r; const float sp = z >= 0.f ? big : small, sn = z >= 0.f ? small : big;
            const float f = lb[e] + (1.0f - lb[e]) * sp; lf[e] = flog(f); kk[e] = (1.0f - lb[e]) * sn; }
        *(f32x4*)(SBUF(float, SB_LF) + o) = (f32x4){lf[0], lf[1], lf[2], lf[3]}; u32x2 w; w.x = cvtpk(kk[0], kk[1]); w.y = cvtpk(kk[2], kk[3]); *(u32x2*)(SBUF(bf16_t, SB_KK) + o) = w;
    } else { f32x4 x = v; if (sec != 2) {
#pragma unroll
            for (int e = 0; e < 4; ++e) x[e] = fsilu(x[e]); }
        bf16_t* dst = sec == 0 ? SBUF(bf16_t, SB_QS) : (sec == 2 ? SBUF(bf16_t, SB_VV) : SBUF(bf16_t, SB_GG));
        u32x2 w; w.x = cvtpk(x[0], x[1]); w.y = cvtpk(x[2], x[3]); *(u32x2*)(dst + o) = w; }
}
__device__ __forceinline__ void sample_epi_inb(Frame& F, const f32x4& v, int row, int c) {
    unsigned char* ws = F.ws;
    if (c >= 768 && c < 1024) { u32x2 w; w.x = cvtpk(v[0], v[1]); w.y = cvtpk(v[2], v[3]); *(u32x2*)(SBUF(bf16_t, SB_CQ) + (size_t)row * XW + (c - 768)) = w; return; }
    if (c >= 1280) { const int cc = c - 1280; float* op = F.out + O_SVS + ((size_t)(row * 128 + 127) * 4) * 64 + cc; *(f32x4*)op = v; *(f32x4*)(WSP(float, WS_VSN) + (size_t)row * 256 + cc) = v; return; }
    const int cc = c < 768 ? c : c - 1024, i0 = (cc & 63) >> 1; const f32x2* rp = WSP(f32x2, WS_ROPE) + (size_t)SEQ * 32 + i0;
    float o[4];
#pragma unroll
    for (int p = 0; p < 2; ++p) { const f32x2 cs = rp[p]; const float x1 = v[2 * p], x2 = v[2 * p + 1]; o[2 * p] = x1 * cs.x - x2 * cs.y; o[2 * p + 1] = x2 * cs.x + x1 * cs.y; }
    if (c < 768) { u32x2 w; w.x = cvtpk(o[0], o[1]); w.y = cvtpk(o[2], o[3]); *(u32x2*)(SBUF(bf16_t, SB_QS) + (size_t)row * HW + c) = w; }
    else { const int hh = cc >> 6; float* op = F.out + O_SKS + ((size_t)(row * 128 + 127) * 4 + hh) * 64; float* sp = WSP(float, WS_KSN) + (size_t)(row * 4 + hh) * 64;
#pragma unroll
        for (int p = 0; p < 2; ++p) { op[i0 + p] = o[2 * p]; op[i0 + p + 32] = o[2 * p + 1]; sp[i0 + p] = o[2 * p]; sp[i0 + p + 32] = o[2 * p + 1]; } }
}

__device__ __forceinline__ void sample_gemm_a(Frame& F, int u, int kind, int layer) {
    unsigned char* ws = F.ws;
    const int N = kind == SK_INA ? NA : (kind == SK_UP ? FF : (layer == 2 ? 1536 : 1024)), NC = N / 128, rg = u / NC, cc = u - rg * NC;
    const int upd = kind == SK_UP ? 2 * layer + 1 : 2 * layer;
    const float* Hin = upd == 0 ? in_ptr(1) : SBUF(float, (upd & 1) ? SB_H0 : SB_H1); float* Hout = SBUF(float, (upd & 1) ? SB_H1 : SB_H0);
    const float* Y = upd == 0 ? nullptr : (kind == SK_UP ? SBUF(float, SB_Y1) : SBUF(float, SB_Y2));
    const float* gpost = kind == SK_UP ? in_ptr(19) + layer * D : in_ptr(21) + (layer - 1) * D;
    const bf16_t* Wt = kind == SK_INA ? WSP(bf16_t, WS_WINA + (size_t)layer * SZ_WINA) : (kind == SK_UP ? WSP(bf16_t, WS_WUP + (size_t)layer * 8388608) : (layer == 2 ? WSP(bf16_t, WS_WINB0) : WSP(bf16_t, WS_WINB1)));
    const int n0 = cc * 128 + F.wave * 16, fr = F.lane & 15, g = F.lane >> 4, row = 16 * rg + fr;
    bf16x8 wf[32]; sample_wave_wload(wf, Wt, D, n0, F.lane);
    sample_norm_slab(F, rg, Hin, Hout, Y, kind == SK_UP ? 1 : 4, gpost, cc == 0);
    __syncthreads();
    f32x4 acc[1]; sample_wave_gemm(acc[0], wf, F.lds, F.lane);
#pragma unroll
    for (int t = 0; t < 1; ++t) { const int c = n0 + 16 * t + 4 * g;
        if (kind == SK_UP) { f32x4 x = acc[t];
#pragma unroll
            for (int e = 0; e < 4; ++e) { const float r = fmaxf(x[e], 0.f); x[e] = r * r; }
            u32x2 w; w.x = cvtpk(x[0], x[1]); w.y = cvtpk(x[2], x[3]); *(u32x2*)(SBUF(bf16_t, SB_HB) + (size_t)row * FF + c) = w; }
        else if (kind == SK_INA) sample_epi_ina(F, acc[t], row, c, layer);
        else sample_epi_inb(F, acc[t], row, c); }
    __syncthreads();
}
__device__ __forceinline__ void sample_gemm_b(Frame& F, int u, int kind, int layer) {
    unsigned char* ws = F.ws;
    const int ks = kind == SK_DOWN ? (u & 3) : 0, uu = kind == SK_DOWN ? (u >> 2) : u, rg = uu >> 3, cc = uu & 7;
    const bf16_t* A = kind == SK_DOWN ? SBUF(bf16_t, SB_HB) + (size_t)(16 * rg) * FF + ks * 1024 : SBUF(bf16_t, SB_MIX) + (size_t)(16 * rg) * D;
    const bf16_t* Wt = kind == SK_DOWN ? WSP(bf16_t, WS_WDN + (size_t)layer * 8388608) + ks * 1024 : WSP(bf16_t, WS_WOUT + (size_t)layer * 2097152);
    const int n0 = cc * 128 + F.wave * 16, fr = F.lane & 15, g = F.lane >> 4, row = 16 * rg + fr;
    bf16x8 wf[32]; sample_wave_wload(wf, Wt, kind == SK_DOWN ? FF : D, n0, F.lane);
    sample_copy_slab(F, A, kind == SK_DOWN ? FF : D);
    __syncthreads();
    f32x4 acc[1]; sample_wave_gemm(acc[0], wf, F.lds, F.lane);
    float* Yo = kind == SK_DOWN ? SBUF(float, SB_Y2) + (size_t)ks * BS * D : SBUF(float, SB_Y1);
    *(f32x4*)(Yo + (size_t)row * D + n0 + 4 * g) = acc[0];
    __syncthreads();
}
__device__ __forceinline__ void sample_final(Frame& F, int rg) {
    unsigned char* ws = F.ws;
    sample_norm_slab(F, rg, SBUF(float, SB_H1), F.out + O_YS, SBUF(float, SB_Y2), 4, in_ptr(21) + 3 * D, true);
    __syncthreads();
}

enum { OP_PROLOGUE = 0, OP_GEMM, OP_MIXA, OP_H2, OP_H3, OP_MIXB, OP_NORM, OP_NONE };
struct Phase { int op, layer; unsigned long long aoff, boff; int M, N, K, ekind, cshift, nobar, sk, sl; };
#define PH_GEMM(l, A, B, M, N, K, ek, cs, nb, sk, sl) {OP_GEMM, l, A, B, M, N, K, ek, cs, nb, sk, sl}
#define PH_WO(l, sk, sl) PH_GEMM(l, WS_MIX, WS_WOUT + (size_t)(l) * 2097152, MP, D, D, EK_FUSED, 2 * (l), 0, sk, sl)
#define PH_UP(l, sk, sl) PH_GEMM(l, WS_H, WS_WUP + (size_t)(l) * 8388608, MP, FF, D, EK_UP, 0, 0, sk, sl)
#define PH_DN(l, sk, sl) PH_GEMM(l, WS_HB, WS_WDN + (size_t)(l) * 8388608, MP, D, FF, EK_FUSED, 2 * (l) + 1, 0, sk, sl)
#define PH_N1(l, sk, sl) {OP_NORM, l, 0, 0, 0, 0, 0, 19, 0, 0, sk, sl}
#define PH_N2(l, sk, sl) {OP_NORM, l, 0, 0, (l) == 3, 0, 0, 21, 0, 0, sk, sl}
#define PH_OP(op, l, sk, sl) {op, l, 0, 0, 0, 0, 0, 0, 0, 0, sk, sl}
#define DY(k) ((k) | 16)
__constant__ Phase c_prog[] = {
    PH_OP(OP_PROLOGUE, 0, 0, 0),
    PH_GEMM(0, WS_MN, WS_WMEM, 512, 2048, D, EK_MEMKV, 16, 1, 0, 0),
    PH_GEMM(0, WS_XN, WS_WINA, MP, NA, D, EK_INA, 0, 0, DY(SK_INA), 0),
    PH_OP(OP_MIXA, 0, DY(SK_MIXA), 0), PH_OP(OP_H2, 0, SK_WO, 0), PH_OP(OP_H3, 0, DY(SK_UP), 0),
    PH_WO(0, SK_DOWN, 0), PH_UP(0, 0, 0), PH_DN(0, 0, 0),
    PH_GEMM(1, WS_H, WS_WINA + SZ_WINA, MP, NA, D, EK_INA, 0, 0, DY(SK_INA), 1),
    PH_OP(OP_MIXA, 1, DY(SK_MIXA), 1), PH_OP(OP_H2, 1, SK_WO, 1), PH_OP(OP_H3, 1, DY(SK_UP), 1),
    PH_WO(1, SK_DOWN, 1), PH_UP(1, SK_INB, 2), PH_DN(1, 0, 0),
    PH_GEMM(0, WS_H, WS_WINB0, MP, 1536, D, EK_INB, 0, 0, DY(SK_MIXB), 2),
    PH_OP(OP_MIXB, 2, DY(SK_WO), 2),
    PH_WO(2, SK_UP, 2), PH_UP(2, SK_DOWN, 2), PH_DN(2, SK_INB, 3),
    PH_GEMM(1, WS_H, WS_WINB1, MP, 1024, D, EK_INB, 0, 0, 0, 0),
    PH_OP(OP_MIXB, 3, DY(SK_MIXB), 3),
    PH_WO(3, SK_WO, 3), PH_UP(3, SK_UP, 3), PH_DN(3, SK_DOWN, 3),
    PH_OP(OP_NONE, 0, SK_FINAL, 0),
};
constexpr int NPHASE = sizeof(c_prog) / sizeof(Phase);

__global__ void __launch_bounds__(NTHR, 2) yoco_fwd(Args args) {
    extern __shared__ __attribute__((aligned(16))) unsigned char lds_raw[];
    Frame F;
    F.lds = (LAS unsigned char*)lds_raw;
    F.tid = threadIdx.x; F.lane = F.tid & 63; F.wave = __builtin_amdgcn_readfirstlane(F.tid >> 6);
    F.G = gridDim.x; { const int bx = blockIdx.x; F.vcu = (F.G % 8 == 0) ? (bx % 8) * (F.G / 8) + bx / 8 : bx; }
    F.ws = args.ws; F.out = args.out;
    unsigned char* ws = F.ws;
    for (int u = F.tid; u < (LDS_BYTES - LDSCTL_OFF) / 4; u += NTHR) ((LAS unsigned*)(F.lds + LDSCTL_OFF))[u] = 0u;
    __syncthreads();
    XcdBarrier bar = xcd_barrier_post((unsigned*)(ws + WS_CTL) + 4096, (volatile LAS unsigned*)(F.lds + MISC_OFF) + 8);
#define GRID_BAR() xcd_barrier(bar)
    const int G = F.G, bx = blockIdx.x;

#pragma unroll 1
    for (int ph = 0; ph < NPHASE; ++ph) {
        const Phase P = c_prog[ph];
        const int l = P.layer;
        unsigned* qctr = (unsigned*)(ws + WS_CTL) + 8192 + 64 * ph;
        { int t_ = threadIdx.x; asm volatile("" : "+v"(t_)); F.tid = t_; F.lane = t_ & 63; F.wave = __builtin_amdgcn_readfirstlane(t_ >> 6); }
#ifndef PROBE_DUP_MASK
#define PROBE_DUP_MASK 0
#endif
#ifndef PROBE_DUP_EK
#define PROBE_DUP_EK 0
#endif
        const int reps_ = (((PROBE_DUP_MASK >> P.op) & 1) || (P.op == OP_GEMM && ((PROBE_DUP_EK >> P.ekind) & 1))) ? 2 : 1;
#pragma unroll 1
        for (int rep_ = 0; rep_ < reps_; ++rep_) {
        switch (P.op) {
        case OP_PROLOGUE: p0_prologue(F); break;
        case OP_GEMM: {
            pg8::Gemm g{(const bf16_t*)(ws + P.aoff), (const bf16_t*)(ws + P.boff), P.M, P.N, P.K}; pg8::StaticOrder S; S.init(P.M, P.N, G, (bx + P.cshift) % G);
            if (P.ekind == EK_FUSED) {
                const int inst = P.cshift; unsigned* ctl = (unsigned*)(ws + WS_CTL); unsigned long long* xb = WSP(unsigned long long, WS_XCH) + (size_t)inst * 2 * 65536;
                const bool last = inst == 7; bf16_t* H = WSP(bf16_t, WS_H);
                EpiFused E{inst == 0 ? in_ptr(0) : (const float*)nullptr, H, last ? F.out + O_YP : (float*)nullptr, H, last ? (bf16_t*)nullptr : WSP(bf16_t, WS_RS2), in_ptr((inst & 1) ? 21 : 19) + l * D,
                           PanelSq{xb, (unsigned)(inst * 2 + 1), ctl}, PanelSq{xb + 65536, (unsigned)(inst * 2 + 2), ctl}};
                pg8::StaticOrder S2; S2.init(P.M, P.N, G, bx);
                pg8::gemm_phase<true>(F.lds, g, S2, E, F.tid);
            } else { Epi E{P.ekind, l, F.ws, F.out}; pg8::gemm_phase<false>(F.lds, g, S, E, F.tid); }
        } break;
        case OP_MIXA:
            if (F.vcu < HS_UNITS) hgrn_pass1_unit(F, F.vcu);
            else { memattn_wg(F, F.vcu - HS_UNITS, l); memattn_wg(F, F.vcu - HS_UNITS + 64, l); }
            break;
        case OP_H2: hgrn_pass2(F, l); break;
        case OP_H3:
            if (F.vcu < HS_UNITS) hgrn_pass3_unit(F, F.vcu, l);
            else { memattn_wg(F, F.vcu - HS_UNITS + 128, l); memattn_wg(F, F.vcu - HS_UNITS + 192, l); }
            break;
        case OP_MIXB:
            swa_wg(F, F.vcu, l - 2); memattn_wg(F, F.vcu, l);
            break;
        case OP_NORM: norm_phase(F, in_ptr(P.ekind) + l * D, P.M != 0); break;
        default: break;
        }
        if (P.sk != SK_NONE && rep_ == 0) {
            const int sk = P.sk & 15, sl = P.sl, dyn = P.sk >> 4;
            const int nu = sk == SK_INA ? 208 : sk == SK_INB ? (sl == 2 ? 96 : 64) : sk == SK_MIXA ? 256 : sk == SK_MIXB ? 256 : sk == SK_WO ? 64 : sk == SK_UP ? 256 : sk == SK_DOWN ? 256 : 8;
            int i = dyn ? 0 : F.vcu;
            __syncthreads();
            for (;;) { if (dyn) i = q_pull(F, qctr + 32); if (i >= nu) break;
                if (sk == SK_INA || sk == SK_INB || sk == SK_UP) sample_gemm_a(F, i, sk, sl);
                else if (sk == SK_WO || sk == SK_DOWN) sample_gemm_b(F, i, sk, sl);
                else if (sk == SK_MIXA) { if (i < 128) hgrn_sample_bs(F, i, sl); else memattn_sample_bs(F, i - 128, sl); }
                else if (sk == SK_MIXB) { if (i < 128) swa_sample_bs(F, i, sl - 2); else memattn_sample_bs(F, i - 128, sl); }
                else sample_final(F, i);
                if (!dyn) i += G; }
        }
        if (!P.nobar || reps_ > 1) GRID_BAR();
        }
    }
}

extern "C" void kernel_launch(void* const* d_in, const int* in_sizes, int n_in, void* d_out, int out_size, void* d_ws, size_t ws_size, hipStream_t stream) {
    static int grid = 0;
    if (grid == 0) {
        if (n_in != 24 || (size_t)out_size != O_END || ws_size < WS_END) { fprintf(stderr, "kernel_launch: unexpected shapes: n_in %d out %d ws %zu (need %zu)\n", n_in, out_size, ws_size, (size_t)WS_END); grid = -1; return; }
        int dev = 0, cus = 0, per_cu = 0;
        if (hipGetDevice(&dev) != hipSuccess || hipDeviceGetAttribute(&cus, hipDeviceAttributeMultiprocessorCount, dev) != hipSuccess) { grid = -1; return; }
        if (hipFuncSetAttribute((const void*)yoco_fwd, hipFuncAttributeMaxDynamicSharedMemorySize, LDS_BYTES) != hipSuccess) { fprintf(stderr, "kernel_launch: hipFuncSetAttribute failed\n"); grid = -1; return; }
        if (hipOccupancyMaxActiveBlocksPerMultiprocessor(&per_cu, (const void*)yoco_fwd, NTHR, LDS_BYTES) != hipSuccess || per_cu < 1) { fprintf(stderr, "kernel_launch: occupancy query says %d blocks per CU\n", per_cu); (void)hipGetLastError(); grid = -1; return; }
        grid = cus;
    }
    if (grid < 0) return;
    (void)hipMemsetAsync((char*)d_ws + WS_CTL, 0, 65536, stream);
    Args a{};
    for (int i = 0; i < 24; ++i) a.in[i] = (const float*)d_in[i];
    a.out = (float*)d_out; a.ws = (unsigned char*)d_ws;
    void* params[] = {&a};
    hipError_t e = hipLaunchCooperativeKernel((const void*)yoco_fwd, dim3(grid), dim3(NTHR), params, LDS_BYTES, stream);
    if (e != hipSuccess) fprintf(stderr, "kernel_launch: cooperative launch failed: %s (grid %d)\n", hipGetErrorString(e), grid);
}
```
